# Optimizing an MI355X kernel written in HIP

```python
import math
import jax
import jax.numpy as jnp
from jax import lax
import numpy as np

D_MODEL = 1024
BATCH = 2
SEQ = 8192
DEPTH = 4
DEC_BATCH = 1
DEC_SEQ = 16384
PAST_LEN = 128

N_AB_LAYERS = (DEPTH + 1) // 2
N_CD_LAYERS = DEPTH // 2
D_FF = 4 * D_MODEL
MIX_WIDTH = 3 * D_MODEL // 2
NORM_EPS = 1e-5

RWKV_HEAD = 64
RWKV_WIDTH = D_MODEL // 2
RWKV_HEADS = RWKV_WIDTH // RWKV_HEAD
DECAY_LORA = 64
ICLR_LORA = 64
GATE_LORA = 128
RWKV_GN_EPS = 64e-5
A_IN = 3 * RWKV_WIDTH + 2 * DECAY_LORA + 2 * ICLR_LORA + GATE_LORA

SSM_HEAD = 64
SSM_WIDTH = D_MODEL
SSM_HEADS = SSM_WIDTH // SSM_HEAD
SSM_GROUPS = 2
SSM_STATE = 128
SSM_CONV = 4
SSM_CHUNK = 128
SSM_CONV_DIM = SSM_WIDTH + 2 * SSM_GROUPS * SSM_STATE
B_IN = SSM_WIDTH + SSM_CONV_DIM + 2 * SSM_HEADS
AB_IN = A_IN + B_IN

HG_HEADS = 8
HG_KDIM = 128
HG_VDIM = 64
HG_FDIM = HG_HEADS * HG_KDIM
HG_WIDTH = HG_HEADS * HG_VDIM
HG_CHUNK = 16
C_IN = 3 * HG_FDIM + 2 * HG_WIDTH

RET_HEADS = 4
RET_KDIM = 128
RET_VDIM = 256
RET_QK = RET_HEADS * RET_KDIM
RET_WIDTH = RET_HEADS * RET_VDIM
RET_CHUNK = 128
ROPE_BASE = 10000.0
D_IN = 2 * RET_QK + 2 * RET_WIDTH
CD_IN = C_IN + D_IN

kernel_name = "hybrid_bidir_rwkv7_mamba2_hgrn2_retnet_encoder"


def rms_norm(x, g, eps=NORM_EPS):
    xf = x.astype(jnp.float32)
    y = xf * lax.rsqrt(jnp.mean(xf * xf, axis=-1, keepdims=True) + eps)
    return (y * g.astype(jnp.float32)).astype(x.dtype)


def head_rms_norm(x, w, eps):
    xf = x.astype(jnp.float32)
    y = xf * lax.rsqrt(jnp.mean(xf * xf, axis=-1, keepdims=True) + eps)
    y = y.reshape(*x.shape[:-2], -1)
    return (y * w.astype(jnp.float32)).astype(x.dtype)


def head_group_norm(x, w, b, eps):
    xf = x.astype(jnp.float32)
    xc = xf - jnp.mean(xf, axis=-1, keepdims=True)
    y = xc * lax.rsqrt(jnp.mean(xc * xc, axis=-1, keepdims=True) + eps)
    y = y.reshape(*x.shape[:-2], -1)
    return (y * w.astype(jnp.float32) + b.astype(jnp.float32)).astype(x.dtype)


def l2_normalize(x, eps=1e-12):
    xf = x.astype(jnp.float32)
    n = jnp.sqrt(jnp.sum(xf * xf, axis=-1, keepdims=True))
    return (xf / jnp.maximum(n, eps)).astype(x.dtype)


def split_heads(t, n_heads, head_dim):
    return t.reshape(*t.shape[:-1], n_heads, head_dim)


def both_dirs(fwd, bwd):
    return jnp.concatenate([fwd, jnp.flip(bwd, axis=1)], axis=0)


def split_dirs(t):
    return both_dirs(t[:, :, 0], t[:, :, 1])


def merge_dirs(y):
    n = y.shape[0] // 2
    return y[:n] + jnp.flip(y[n:], axis=1)


def shift_prev(x):
    return jnp.pad(x, ((0, 0), (1, 0), (0, 0)))[:, :-1]


def shift_next(x):
    return jnp.pad(x, ((0, 0), (0, 1), (0, 0)))[:, 1:]


def centred_depthwise_conv(x, w, b):
    width = w.shape[0]
    left = width // 2
    T = x.shape[1]
    xp = jnp.pad(x, ((0, 0), (left, width - 1 - left), (0, 0)))
    y = b
    for j in range(width):
        y = y + xp[:, j:j + T] * w[j]
    return y


def rotary(x):
    T, half = x.shape[1], x.shape[-1] // 2
    inv_freq = ROPE_BASE ** (-jnp.arange(half, dtype=jnp.float32) / half)
    ang = jnp.arange(T, dtype=jnp.float32)[:, None] * inv_freq[None, :]
    cos = jnp.cos(ang)[:, None, :]
    sin = jnp.sin(ang)[:, None, :]
    xf = x.astype(jnp.float32)
    x1, x2 = xf[..., :half], xf[..., half:]
    return jnp.concatenate([x1 * cos - x2 * sin, x2 * cos + x1 * sin], axis=-1).astype(x.dtype)


def hgrn_lower_bounds(lb_param):
    p = jax.nn.softmax(lb_param.astype(jnp.float32), axis=1)
    return jnp.cumsum(p, axis=1) - p[:, :1]


def rwkv7_scan(r, w, k, v, kk, a):
    n, _, h, dh = r.shape

    def step(S, inp):
        r_t, w_t, k_t, v_t, kk_t, a_t = (t.astype(jnp.float32) for t in inp)
        sa = jnp.einsum("nhij,nhj->nhi", S, -kk_t)
        S = (S * w_t[:, :, None, :] + sa[:, :, :, None] * (kk_t * a_t)[:, :, None, :]
             + v_t[:, :, :, None] * k_t[:, :, None, :])
        return S, jnp.einsum("nhij,nhj->nhi", S, r_t)

    xs = tuple(jnp.moveaxis(t, 1, 0) for t in (r, w, k, v, kk, a))
    _, o = lax.scan(step, jnp.zeros((n, h, dh, dh), jnp.float32), xs)
    return jnp.moveaxis(o, 0, 1)


def ssd_chunk_scan(x, da, bm, cm):
    n, T, H, P = x.shape
    G, S = bm.shape[2], bm.shape[3]
    E, L = H // G, SSM_CHUNK
    nc = T // L
    x = x.reshape(n, nc, L, G, E, P)
    bm = bm.reshape(n, nc, L, G, S)
    cm = cm.reshape(n, nc, L, G, S)
    a_cs = jnp.cumsum(da.astype(jnp.float32).reshape(n, nc, L, G, E).transpose(0, 1, 3, 4, 2), axis=-1)
    causal = jnp.tril(jnp.ones((L, L), dtype=bool))
    seg = jnp.where(causal, a_cs[..., :, None] - a_cs[..., None, :], -jnp.inf)
    cb = jnp.einsum("nclgs,ncmgs->ncglm", cm, bm)
    y_diag = jnp.einsum("ncgelm,ncmgep->nclgep", cb[:, :, :, None] * jnp.exp(seg), x)
    states = jnp.einsum("nclgs,ncgel,nclgep->ncgeps", bm, jnp.exp(a_cs[..., -1:] - a_cs), x)
    chunk_decay = jnp.exp(a_cs[..., -1])

    def step(h, inp):
        st, dec = inp
        return h * dec[..., None, None] + st.astype(jnp.float32), h

    _, h_prev = lax.scan(step, jnp.zeros((n, G, E, P, S), jnp.float32),
                         (jnp.moveaxis(states, 1, 0), jnp.moveaxis(chunk_decay, 1, 0)))
    y_off = jnp.einsum("nclgs,ncgeps,ncgel->nclgep", cm, jnp.moveaxis(h_prev, 0, 1), jnp.exp(a_cs))
    return (y_diag + y_off).reshape(n, T, H, P)


def gla_chunk_scan(q, k, v, log_f):
    n, T, H, K = q.shape
    V, L = v.shape[-1], HG_CHUNK
    nc = T // L
    q = q.astype(jnp.float32).reshape(n, nc, L, H, K)
    k = k.astype(jnp.float32).reshape(n, nc, L, H, K)
    v = v.reshape(n, nc, L, H, V)
    b = jnp.cumsum(log_f.astype(jnp.float32).reshape(n, nc, L, H, K), axis=2)
    b_ref = b[:, :, L // 2:L // 2 + 1]
    causal = jnp.tril(jnp.ones((L, L), dtype=bool))
    attn = jnp.einsum("nclhk,ncmhk->nchlm", q * jnp.exp(b - b_ref), k * jnp.exp(b_ref - b))
    o_intra = jnp.einsum("nchlm,ncmhv->nclhv", jnp.where(causal, attn, 0.0), v)

    def step(S, inp):
        qc, kc, vc, dec = inp
        o = jnp.einsum("nlhk,nhkv->nlhv", qc, S)
        S = S * dec[..., None] + jnp.einsum("nlhk,nlhv->nhkv", kc, vc.astype(jnp.float32))
        return S, o

    xs = (jnp.moveaxis(q * jnp.exp(b), 1, 0),
          jnp.moveaxis(k * jnp.exp(b[:, :, -1:] - b), 1, 0),
          jnp.moveaxis(v, 1, 0),
          jnp.moveaxis(jnp.exp(b[:, :, -1]), 1, 0))
    _, o_inter = lax.scan(step, jnp.zeros((n, H, K, V), jnp.float32), xs)
    return (o_intra + jnp.moveaxis(o_inter, 0, 1)).reshape(n, T, H, V)


def retention_chunk_scan(q, k, v, log_gamma):
    n, T, H, K = q.shape
    V, L = v.shape[-1], RET_CHUNK
    nc = T // L
    q = q.astype(jnp.float32).reshape(n, nc, L, H, K)
    k = k.astype(jnp.float32).reshape(n, nc, L, H, K)
    v = v.reshape(n, nc, L, H, V)
    pos = jnp.arange(L, dtype=jnp.float32)
    rel = pos[:, None] - pos[None, :]
    intra_decay = jnp.exp(jnp.where(rel >= 0, rel * log_gamma[:, :, None, None], -jnp.inf))
    scores = jnp.einsum("nclhk,ncmhk->nchlm", q, k) * intra_decay[:, None]
    o_intra = jnp.einsum("nchlm,ncmhv->nclhv", scores, v)
    q_dec = q * jnp.exp((pos[:, None] + 1.0) * log_gamma[:, None, :])[:, None, :, :, None]
    k_dec = k * jnp.exp((L - 1.0 - pos)[:, None] * log_gamma[:, None, :])[:, None, :, :, None]
    chunk_decay = jnp.exp(L * log_gamma)

    def step(S, inp):
        qc, kc, vc = inp
        o = jnp.einsum("nlhk,nhkv->nlhv", qc, S)
        S = S * chunk_decay[:, :, None, None] + jnp.einsum("nlhk,nlhv->nhkv", kc, vc.astype(jnp.float32))
        return S, o

    xs = (jnp.moveaxis(q_dec, 1, 0), jnp.moveaxis(k_dec, 1, 0), jnp.moveaxis(v, 1, 0))
    _, o_inter = lax.scan(step, jnp.zeros((n, H, K, V), jnp.float32), xs)
    return (o_intra + jnp.moveaxis(o_inter, 0, 1)).reshape(n, T, H, V)


def rwkv7_mixer(u, mu, w0, w2, a0, a2, g2, k_k, k_a, r_k, gn_w, gn_b):
    bsz, T, _ = u.shape
    W = RWKV_WIDTH
    u = u + mu[0] * (shift_prev(u) - u) + mu[1] * (shift_next(u) - u)
    o1 = 3 * W
    o2 = o1 + 2 * DECAY_LORA
    o3 = o2 + 2 * ICLR_LORA
    r, k, v = u[..., :W], u[..., W:2 * W], u[..., 2 * W:o1]
    w_lo = u[..., o1:o2].reshape(bsz, T, 2, DECAY_LORA)
    a_lo = u[..., o2:o3].reshape(bsz, T, 2, ICLR_LORA)
    g = jax.nn.sigmoid(u[..., o3:]) @ g2
    w_raw = (w0 + jnp.einsum("btdr,drc->btdc", jnp.tanh(w_lo), w2)).astype(jnp.float32)
    decay = jnp.exp(-jnp.exp(-jax.nn.softplus(-w_raw) - 0.5))
    a = jax.nn.sigmoid(a0 + jnp.einsum("btdr,drc->btdc", a_lo, a2))
    kk = l2_normalize(split_heads(k * k_k, RWKV_HEADS, RWKV_HEAD))
    k_dir = k[:, :, None, :] * (1.0 + (a - 1.0) * k_a)
    rh = split_heads(r, RWKV_HEADS, RWKV_HEAD)
    vh = split_heads(v, RWKV_HEADS, RWKV_HEAD)
    o = rwkv7_scan(both_dirs(rh, rh),
                   split_dirs(split_heads(decay, RWKV_HEADS, RWKV_HEAD)),
                   split_dirs(split_heads(k_dir, RWKV_HEADS, RWKV_HEAD)),
                   both_dirs(vh, vh), both_dirs(kk, kk),
                   split_dirs(split_heads(a, RWKV_HEADS, RWKV_HEAD)))
    o = head_group_norm(merge_dirs(o), gn_w, gn_b, RWKV_GN_EPS)
    bonus = jnp.sum(rh * split_heads(k, RWKV_HEADS, RWKV_HEAD) * split_heads(r_k, RWKV_HEADS, RWKV_HEAD),
                    axis=-1, keepdims=True) * vh
    return ((o + bonus.reshape(bsz, T, W).astype(o.dtype)) * g).astype(u.dtype)


def mamba2_mixer(u, conv_w, conv_b, dt_bias, a_log, d_skip, norm_w):
    bsz, T, _ = u.shape
    gs = SSM_GROUPS * SSM_STATE
    z = u[..., :SSM_WIDTH]
    xbc = jax.nn.silu(centred_depthwise_conv(u[..., SSM_WIDTH:SSM_WIDTH + SSM_CONV_DIM], conv_w, conv_b))
    dt = u[..., SSM_WIDTH + SSM_CONV_DIM:].reshape(bsz, T, 2, SSM_HEADS)
    xs = xbc[..., :SSM_WIDTH].reshape(bsz, T, SSM_HEADS, SSM_HEAD)
    bm = xbc[..., SSM_WIDTH:SSM_WIDTH + gs].reshape(bsz, T, SSM_GROUPS, SSM_STATE)
    cm = xbc[..., SSM_WIDTH + gs:].reshape(bsz, T, SSM_GROUPS, SSM_STATE)
    dt = jax.nn.softplus(dt.astype(jnp.float32) + dt_bias.astype(jnp.float32))
    da = -dt * jnp.exp(a_log.astype(jnp.float32))
    y = ssd_chunk_scan(split_dirs(xs[:, :, None] * dt[..., None]), split_dirs(da),
                       both_dirs(bm, bm), both_dirs(cm, cm))
    y = merge_dirs(y) + xs * d_skip[:, None]
    y = y.reshape(bsz, T, SSM_WIDTH) * jax.nn.silu(z)
    return head_rms_norm(y.reshape(bsz, T, SSM_GROUPS, -1), norm_w, 1e-5).astype(u.dtype)


def hgrn2_mixer(u, lower_bound, norm_w):
    bsz, T, _ = u.shape
    F = HG_FDIM
    q = split_heads(u[..., :F], HG_HEADS, HG_KDIM)
    f_logit = u[..., F:3 * F].astype(jnp.float32).reshape(bsz, T, 2, F)
    f = lower_bound + (1.0 - lower_bound) * jax.nn.sigmoid(f_logit)
    i = split_heads(u[..., 3 * F:3 * F + HG_WIDTH], HG_HEADS, HG_VDIM)
    g = u[..., 3 * F + HG_WIDTH:]
    fh = split_heads(f, HG_HEADS, HG_KDIM)
    o = gla_chunk_scan(both_dirs(q, q), split_dirs(1.0 - fh), both_dirs(i, i), split_dirs(jnp.log(fh)))
    o = head_rms_norm(merge_dirs(o), norm_w, 1e-5)
    return (o * jax.nn.sigmoid(g)).astype(u.dtype)


def retention_mixer(u, log_decay, gn_w, gn_b):
    bsz, T, _ = u.shape
    q = rotary(split_heads(u[..., :RET_QK], RET_HEADS, RET_KDIM))
    k = rotary(split_heads(u[..., RET_QK:2 * RET_QK], RET_HEADS, RET_KDIM)) * RET_KDIM ** -0.5
    v = split_heads(u[..., 2 * RET_QK:2 * RET_QK + RET_WIDTH], RET_HEADS, RET_VDIM)
    g = u[..., 2 * RET_QK + RET_WIDTH:]
    log_gamma = jnp.repeat(-jnp.exp(log_decay.astype(jnp.float32)), bsz, axis=0)
    o = retention_chunk_scan(both_dirs(q, q), both_dirs(k, k), both_dirs(v, v), log_gamma)
    o = head_group_norm(merge_dirs(o), gn_w, gn_b, 1e-5)
    return (o * jax.nn.silu(g)).astype(u.dtype)


def setup_inputs(seed: int = 0) -> dict:
    key = jax.random.key(seed)
    keys = jax.random.split(key, 32)

    def nrm(i, shape, scale):
        return scale * jax.random.normal(keys[i], shape, jnp.float32)

    def unif(i, shape, lo, hi):
        return jax.random.uniform(keys[i], shape, jnp.float32, lo, hi)

    na, nc, W = N_AB_LAYERS, N_CD_LAYERS, RWKV_WIDTH
    dt0 = jnp.exp(unif(22, (na, 2, SSM_HEADS), math.log(1e-3), math.log(1e-1)))
    ret_base = jnp.log(-jnp.log(1.0 - 2.0 ** (-5.0 - jnp.arange(RET_HEADS, dtype=jnp.float32))))
    return {
        "x_prompt": nrm(0, (BATCH, SEQ, D_MODEL), 1.0),
        "x_sample": nrm(1, (DEC_BATCH, DEC_SEQ, D_MODEL), 1.0),
        "ln_mix": 1.0 + nrm(2, (DEPTH, D_MODEL), 0.02),
        "ln_ffn": 1.0 + nrm(3, (DEPTH, D_MODEL), 0.02),
        "ln_final": 1.0 + nrm(4, (D_MODEL,), 0.02),
        "w_out": nrm(5, (DEPTH, MIX_WIDTH, D_MODEL), MIX_WIDTH ** -0.5),
        "ffn_w1": nrm(6, (DEPTH, D_MODEL, D_FF), D_MODEL ** -0.5),
        "ffn_w2": nrm(7, (DEPTH, D_FF, D_MODEL), D_FF ** -0.5),
        "ab_w_in": nrm(8, (na, D_MODEL, AB_IN), D_MODEL ** -0.5),
        "rw_mu": unif(9, (na, 2, A_IN), 0.0, 0.5),
        "rw_w0": unif(10, (na, 2, W), -6.0, 1.0),
        "rw_w2": nrm(11, (na, 2, DECAY_LORA, W), 0.1 * DECAY_LORA ** -0.5),
        "rw_a0": nrm(12, (na, 2, W), 0.1),
        "rw_a2": nrm(13, (na, 2, ICLR_LORA, W), 0.5 * ICLR_LORA ** -0.5),
        "rw_g2": nrm(14, (na, GATE_LORA, W), GATE_LORA ** -0.5),
        "rw_k_k": 0.85 + nrm(15, (na, W), 0.05),
        "rw_k_a": 1.0 + nrm(16, (na, W), 0.05),
        "rw_r_k": nrm(17, (na, W), 0.1),
        "rw_gn_w": 1.0 + nrm(18, (na, W), 0.02),
        "rw_gn_b": nrm(19, (na, W), 0.02),
        "ssm_conv_w": nrm(20, (na, SSM_CONV, SSM_CONV_DIM), SSM_CONV ** -0.5),
        "ssm_conv_b": nrm(21, (na, SSM_CONV_DIM), 0.02),
        "ssm_dt_bias": dt0 + jnp.log(-jnp.expm1(-dt0)),
        "ssm_a_log": jnp.log(unif(23, (na, 2, SSM_HEADS), 1.0, 16.0)),
        "ssm_d": 1.0 + nrm(24, (na, SSM_HEADS), 0.1),
        "ssm_norm_w": 1.0 + nrm(25, (na, SSM_WIDTH), 0.02),
        "cd_w_in": nrm(26, (nc, D_MODEL, CD_IN), D_MODEL ** -0.5),
        "hg_lb": nrm(27, (2, nc, HG_FDIM), 1.0),
        "hg_norm_w": 1.0 + nrm(28, (nc, HG_WIDTH), 0.02),
        "ret_log_decay": ret_base + nrm(29, (nc, 2, RET_HEADS), 0.05),
        "ret_gn_w": 1.0 + nrm(30, (nc, RET_WIDTH), 0.02),
        "ret_gn_b": nrm(31, (nc, RET_WIDTH), 0.02),
    }


def reference(x_prompt, x_sample, ln_mix, ln_ffn, ln_final, w_out, ffn_w1, ffn_w2,
              ab_w_in, rw_mu, rw_w0, rw_w2, rw_a0, rw_a2, rw_g2, rw_k_k, rw_k_a, rw_r_k,
              rw_gn_w, rw_gn_b, ssm_conv_w, ssm_conv_b, ssm_dt_bias, ssm_a_log, ssm_d,
              ssm_norm_w, cd_w_in, hg_lb, hg_norm_w, ret_log_decay, ret_gn_w, ret_gn_b):
    lower_bounds = hgrn_lower_bounds(hg_lb)

    def trunk(h):
        for layer in range(DEPTH):
            j = layer // 2
            hn = rms_norm(h, ln_mix[layer])
            if layer % 2 == 0:
                u = hn @ ab_w_in[j]
                mixed = jnp.concatenate([
                    rwkv7_mixer(u[..., :A_IN], rw_mu[j], rw_w0[j], rw_w2[j], rw_a0[j], rw_a2[j],
                                rw_g2[j], rw_k_k[j], rw_k_a[j], rw_r_k[j], rw_gn_w[j], rw_gn_b[j]),
                    mamba2_mixer(u[..., A_IN:], ssm_conv_w[j], ssm_conv_b[j], ssm_dt_bias[j],
                                 ssm_a_log[j], ssm_d[j], ssm_norm_w[j]),
                ], axis=-1)
            else:
                u = hn @ cd_w_in[j]
                mixed = jnp.concatenate([
                    hgrn2_mixer(u[..., :C_IN], lower_bounds[:, j], hg_norm_w[j]),
                    retention_mixer(u[..., C_IN:], ret_log_decay[j], ret_gn_w[j], ret_gn_b[j]),
                ], axis=-1)
            h = h + mixed @ w_out[layer]
            hn = rms_norm(h, ln_ffn[layer])
            h = h + jnp.square(jax.nn.relu(hn @ ffn_w1[layer])) @ ffn_w2[layer]
        return rms_norm(h, ln_final)

    y_prompt = trunk(x_prompt)
    y_sample = trunk(x_sample)
    return (y_prompt, y_sample)
```

```cpp
#include <hip/hip_runtime.h>
#include <hip/hip_cooperative_groups.h>
#include <cstdio>
#include <cstdint>
namespace cg = cooperative_groups;

#define LAS __attribute__((address_space(3)))
typedef _Float16 h16;
typedef _Float16 h16x8 __attribute__((ext_vector_type(8)));
typedef _Float16 h16x4 __attribute__((ext_vector_type(4)));
typedef float f32x4 __attribute__((ext_vector_type(4)));

constexpr int D = 1024, FF = 4096, MIXW = 1536, MG = 16384;
constexpr int A_IN = 1920, B_IN = 2592, AB_IN = 4512, C_IN = 4096, D_IN = 3072, CD_IN = 7168;
constexpr int LDA_ = 2048, LDB_ = 2816, LDC_ = 4096, LDD_ = 3072;
constexpr int CH_R = 128, CH_M = 256, CH_H = 128, CH_T = 256;
constexpr int SUB = 8;
constexpr int NWAVES = 8, NTHR = 512;
constexpr int LDS_BYTES = 147456;
constexpr size_t MiB = 1u << 20;
constexpr size_t WS_ROT = 0, WS_DEC = 8 * MiB, WS_W = 10 * MiB, WS_HN = 43 * MiB, WS_MIX = 75 * MiB, WS_U = 123 * MiB, WS_ST = 251 * MiB, WS_O = 315 * MiB, WS_END = 347 * MiB;
constexpr size_t W_IN1 = WS_W, W_IN2 = WS_W + 8 * MiB, W_OUT = WS_W + 14 * MiB, W_F1 = WS_W + 17 * MiB, W_F2 = WS_W + 25 * MiB;

struct Args { const float* in[32]; float* out; unsigned char* ws; };
enum { I_XP = 0, I_XS, I_LNMIX, I_LNFFN, I_LNFINAL, I_WOUT, I_W1, I_W2, I_ABW, I_MU, I_W0, I_RW2, I_A0, I_A2, I_G2, I_KK, I_KA, I_RK, I_GNW, I_GNB,
       I_CONVW, I_CONVB, I_DTB, I_ALOG, I_SSMD, I_SSMNW, I_CDW, I_HGLB, I_HGNW, I_RETLD, I_RETGW, I_RETGB };

__device__ __forceinline__ float sigm(float x) { return 1.f / (1.f + __expf(-x)); }
__device__ __forceinline__ float silu(float x) { return x / (1.f + __expf(-x)); }
__device__ __forceinline__ float wave_sum(float v) {
#pragma unroll
    for (int o = 1; o < 64; o <<= 1) v += __shfl_xor(v, o);
    return v;
}
#define WAVE_SYNC() do { asm volatile("s_waitcnt lgkmcnt(0)" ::: "memory"); __builtin_amdgcn_wave_barrier(); } while (0)

namespace pg8 {
constexpr int BM = 256, BK = 64, HALF = 128, HTB = HALF * BK * 2, STAGE_BYTES = 8 * HTB, NXCD = 8, WGM = 8;
__host__ __device__ __forceinline__ int lds_byte(int r, int c) { const int st = (r >> 4) * 2 + (c >> 5), rr = r & 15, cc = c & 31, ob = rr * 64 + cc * 2; return st * 1024 + (ob ^ (((ob >> 9) & 1) << 5)); }
__host__ __device__ __forceinline__ void stage_rc(int b, int& R, int& C) { const int st = b / 1024, sb = b % 1024, swz = sb ^ (((sb >> 9) & 1) << 5); R = (st >> 1) * 16 + swz / 64; C = (st & 1) * 32 + (swz % 64) / 2; }
__host__ __device__ __forceinline__ int perm32(int rho) { const int n = rho >> 4, i = rho & 15; return 8 * (i >> 2) + 4 * n + (i & 3); }
struct Unit { int pm, pn; };
struct Gemm { const h16* A; const h16* Bt; int M, N, K; };
struct StaticOrder {
    int nM, nN, nwg, G, c;
    __device__ void init(int M, int N, int G_, int c_) { nM = M / BM; nN = N / BM; nwg = nM * nN; G = G_; c = c_; }
    __device__ bool next(int i, Unit& u) const {
        const long L = (long)i * G + c; if (L >= nwg) return false;
        int wgid = (int)L; { const int q = nwg / NXCD, r = nwg % NXCD, xcd = wgid % NXCD, off = wgid / NXCD; wgid = (xcd < r ? xcd * (q + 1) : r * (q + 1) + (xcd - r) * q) + off; }
        const int nig = WGM * nN, gid = wgid / nig, fm = gid * WGM, gsz = (nM - fm) < WGM ? (nM - fm) : WGM;
        u.pm = fm + ((wgid % nig) % gsz); u.pn = (wgid % nig) / gsz; return true;
    }
};
template <int ACT> struct EpiF16 {
    h16* O; int ldc;
    __device__ __forceinline__ void operator()(const f32x4 (&acc)[2][2][4][2], const Unit& u, int wr, int wc, int fr, int fq) const {
        const int row0 = u.pm * BM + wr * 64 + fr; const int col0 = u.pn * BM + wc * 32 + 8 * fq;
#pragma unroll
        for (int ai = 0; ai < 2; ++ai)
#pragma unroll
            for (int m = 0; m < 4; ++m) { h16* rowp = O + (size_t)(row0 + ai * HALF + m * 16) * ldc + col0;
#pragma unroll
                for (int bj = 0; bj < 2; ++bj) { f32x4 v0 = acc[ai][bj][m][0], v1 = acc[ai][bj][m][1];
                    if (ACT == 1) {
#pragma unroll
                        for (int e = 0; e < 4; ++e) { float a = fmaxf(v0[e], 0.f), b = fmaxf(v1[e], 0.f); v0[e] = a * a; v1[e] = b * b; } }
                    h16x8 w; w[0] = (h16)v0[0]; w[1] = (h16)v0[1]; w[2] = (h16)v0[2]; w[3] = (h16)v0[3]; w[4] = (h16)v1[0]; w[5] = (h16)v1[1]; w[6] = (h16)v1[2]; w[7] = (h16)v1[3];
                    *(h16x8*)(rowp + bj * HALF) = w; } }
    }
};
struct EpiRes {
    const float* src; float* dst; int ldc;
    __device__ __forceinline__ void operator()(const f32x4 (&acc)[2][2][4][2], const Unit& u, int wr, int wc, int fr, int fq) const {
        const int row0 = u.pm * BM + wr * 64 + fr; const int col0 = u.pn * BM + wc * 32 + 8 * fq;
#pragma unroll
        for (int ai = 0; ai < 2; ++ai)
#pragma unroll
            for (int m = 0; m < 4; ++m) { const size_t off = (size_t)(row0 + ai * HALF + m * 16) * ldc + col0;
#pragma unroll
                for (int bj = 0; bj < 2; ++bj) {
                    const f32x4 s0 = *(const f32x4*)(src + off + bj * HALF), s1 = *(const f32x4*)(src + off + bj * HALF + 4);
                    *(f32x4*)(dst + off + bj * HALF) = s0 + acc[ai][bj][m][0]; *(f32x4*)(dst + off + bj * HALF + 4) = s1 + acc[ai][bj][m][1]; } }
    }
};

template <class Epi, class Sched>
__device__ __forceinline__ void gemm_phase(LAS unsigned char* lds, const Gemm g, const Sched& S, const Epi& E, const int tid) {
    const int wid = __builtin_amdgcn_readfirstlane(tid >> 6), lane = tid & 63, wr = wid >> 2, wc = wid & 3, fr = lane & 15, fq = lane >> 4;
    const int K = g.K, nt = K / BK;
    unsigned voffA[2], voffB[2];
#pragma unroll
    for (int i = 0; i < 2; ++i) { int R, C; stage_rc(tid * 16 + i * 8192, R, C); const int Rb = (R & ~31) + perm32(R & 31);
        voffA[i] = (unsigned)(R * K + C) * 2u; voffB[i] = (unsigned)(Rb * K + C) * 2u; }
    const size_t kstep = (size_t)(BK * 2);
    const size_t hstep = (size_t)HALF * K * 2;
    const size_t tstep = 2 * hstep;
    const unsigned ldsw = (unsigned)wid * 1024u;
    const int aoff = lds_byte(wr * 64 + fr, fq * 8), boff = lds_byte(wc * 32 + fr, fq * 8);
#define PG8_SA(b, h) (((b) * 2 + (h)) * HTB)
#define PG8_SB(b, h) ((4 + (b) * 2 + (h)) * HTB)
#define PG8_STAGE(bufoff, gbase, voff) do { _Pragma("unroll") for (int _i = 0; _i < 2; ++_i) \
        __builtin_amdgcn_global_load_lds((const unsigned*)((const char*)(gbase) + (voff)[_i]), (LAS unsigned*)(lds + (bufoff) + ldsw + _i * 8192), 16, 0, 0); } while (0)
#define PG8_LDA(dst, b, h) do { _Pragma("unroll") for (int m = 0; m < 4; ++m) _Pragma("unroll") for (int k = 0; k < 2; ++k) dst[m][k] = *(const LAS h16x8*)(lds + PG8_SA(b, h) + aoff + m * 2048 + k * 1024); } while (0)
#define PG8_LDB(dst, b, h) do { _Pragma("unroll") for (int n = 0; n < 2; ++n) _Pragma("unroll") for (int k = 0; k < 2; ++k) dst[n][k] = *(const LAS h16x8*)(lds + PG8_SB(b, h) + boff + n * 2048 + k * 1024); } while (0)
#define PG8_MMA(ai, bj, At, Bt) do { __builtin_amdgcn_s_setprio(1); _Pragma("unroll") for (int m = 0; m < 4; ++m) _Pragma("unroll") for (int n = 0; n < 2; ++n) _Pragma("unroll") for (int k = 0; k < 2; ++k) \
        acc[ai][bj][m][n] = __builtin_amdgcn_mfma_f32_16x16x32_f16(Bt[n][k], At[m][k], acc[ai][bj][m][n], 0, 0, 0); __builtin_amdgcn_s_setprio(0); } while (0)
#define PG8_WAIT_V(n) asm volatile("s_waitcnt vmcnt(" #n ")" ::: "memory")
#define PG8_WAIT_L(n) asm volatile("s_waitcnt lgkmcnt(" #n ")" ::: "memory")
#define PG8_BAR __builtin_amdgcn_s_barrier()
#define PG8_SCHED __builtin_amdgcn_sched_barrier(0)
    Unit cur, nxt; int ui = 0;
    if (!S.next(0, cur)) return;
    f32x4 acc[2][2][4][2];
#pragma unroll
    for (int a = 0; a < 2; ++a)
#pragma unroll
        for (int b = 0; b < 2; ++b)
#pragma unroll
            for (int m = 0; m < 4; ++m)
#pragma unroll
                for (int n = 0; n < 2; ++n) acc[a][b][m][n] = (f32x4){0.f, 0.f, 0.f, 0.f};
    h16x8 At[4][2], B0[2][2], B1[2][2];
    const char* cA = (const char*)g.A + (size_t)cur.pm * tstep; const char* cB = (const char*)g.Bt + (size_t)cur.pn * tstep;
    PG8_STAGE(PG8_SB(0, 0), cB, voffB); PG8_STAGE(PG8_SB(0, 1), cB + hstep, voffB); PG8_STAGE(PG8_SA(0, 0), cA, voffA); PG8_STAGE(PG8_SA(0, 1), cA + hstep, voffA);
    if (wr == 1) PG8_BAR;
    PG8_WAIT_V(2); PG8_BAR;
    PG8_STAGE(PG8_SB(1, 0), cB + kstep, voffB); PG8_STAGE(PG8_SA(1, 0), cA + kstep, voffA); PG8_STAGE(PG8_SB(1, 1), cB + hstep + kstep, voffB);
    PG8_WAIT_V(6); PG8_BAR;
    for (;;) {
        const bool has_next = S.next(ui + 1, nxt);
        const char* nA = has_next ? (const char*)g.A + (size_t)nxt.pm * tstep : cA; const char* nB = has_next ? (const char*)g.Bt + (size_t)nxt.pn * tstep : cB;
        for (int t = 0; t < nt; t += 2) {
            const bool last = (t == nt - 2);
            const char* a1 = cA + (size_t)(t + 1) * kstep;
            const char* a2 = last ? nA : cA + (size_t)(t + 2) * kstep; const char* b2 = last ? nB : cB + (size_t)(t + 2) * kstep;
            const char* a3 = a2 + kstep; const char* b3 = b2 + kstep;
            PG8_LDB(B0, 0, 0); PG8_LDB(B1, 0, 1); PG8_SCHED; PG8_LDA(At, 0, 0); PG8_STAGE(PG8_SA(1, 1), a1 + hstep, voffA);
            PG8_WAIT_V(8); PG8_WAIT_L(0); PG8_BAR; PG8_MMA(0, 0, At, B0); PG8_MMA(0, 1, At, B1); PG8_BAR; PG8_SCHED;
            PG8_LDA(At, 0, 1); PG8_STAGE(PG8_SB(0, 0), b2, voffB); PG8_STAGE(PG8_SB(0, 1), b2 + hstep, voffB); PG8_STAGE(PG8_SA(0, 0), a2, voffA);
            PG8_WAIT_V(8); PG8_WAIT_L(0); PG8_BAR; PG8_MMA(1, 0, At, B0); PG8_MMA(1, 1, At, B1); PG8_BAR; PG8_SCHED;
            PG8_LDB(B0, 1, 0); PG8_LDB(B1, 1, 1); PG8_SCHED; PG8_LDA(At, 1, 0); PG8_STAGE(PG8_SA(0, 1), a2 + hstep, voffA);
            PG8_WAIT_V(8); PG8_WAIT_L(0); PG8_BAR; PG8_MMA(0, 0, At, B0); PG8_MMA(0, 1, At, B1); PG8_BAR; PG8_SCHED;
            PG8_LDA(At, 1, 1); PG8_STAGE(PG8_SB(1, 0), b3, voffB); PG8_STAGE(PG8_SB(1, 1), b3 + hstep, voffB); PG8_STAGE(PG8_SA(1, 0), a3, voffA);
            PG8_WAIT_V(8); PG8_WAIT_L(0); PG8_BAR; PG8_MMA(1, 0, At, B0); PG8_MMA(1, 1, At, B1); PG8_BAR; PG8_SCHED;
        }
        if (wr == 0) PG8_BAR;
        E(acc, cur, wr, wc, fr, fq);
        if (!has_next) break;
#pragma unroll
        for (int a = 0; a < 2; ++a)
#pragma unroll
            for (int b = 0; b < 2; ++b)
#pragma unroll
                for (int m = 0; m < 4; ++m)
#pragma unroll
                    for (int n = 0; n < 2; ++n) acc[a][b][m][n] = (f32x4){0.f, 0.f, 0.f, 0.f};
        cur = nxt; cA = nA; cB = nB; ++ui;
        if (wr == 1) PG8_BAR;
    }
    PG8_WAIT_V(0);
    PG8_BAR;
#undef PG8_SA
#undef PG8_SB
#undef PG8_STAGE
#undef PG8_LDA
#undef PG8_LDB
#undef PG8_MMA
#undef PG8_WAIT_V
#undef PG8_WAIT_L
#undef PG8_BAR
#undef PG8_SCHED
}
}

struct Ctx {
    const float* in[32]; LAS unsigned char* lds; int tid, lane, wave, gw, ngw, gtid, ngt;
    int layer, j, grp, nseq, T;
    const float* hsrc; float* hdst;
    unsigned char* ws;
};
#define IN(k) (C.in[k])

__device__ __forceinline__ void transpose_item(const float* W, int ldw, int c0, int nvalid, int K, int Npad, h16* WT, LAS float* scr, int item, int lane) {
    const int nblk = Npad / 32, kb = item / nblk, nb = item % nblk, k0 = 64 * kb, n0 = 32 * nb;
    const int n = n0 + (lane & 31);
#pragma unroll 8
    for (int i = 0; i < 32; ++i) { const int kk = 2 * i + (lane >> 5); scr[kk * 33 + (lane & 31)] = (n < nvalid) ? W[(size_t)(k0 + kk) * ldw + c0 + n] : 0.f; }
    WAVE_SYNC();
    const int c = lane & 7;
#pragma unroll
    for (int jj = 0; jj < 4; ++jj) { const int nn = (lane >> 3) + 8 * jj; const LAS float* s = scr + (8 * c) * 33 + nn;
        h16x8 o;
#pragma unroll
        for (int e = 0; e < 8; ++e) o[e] = (h16)s[e * 33];
        *(h16x8*)(WT + (size_t)(n0 + nn) * K + k0 + 8 * c) = o; }
    WAVE_SYNC();
}
__device__ __forceinline__ void phase_weights(Ctx& C) {
    LAS float* scr = (LAS float*)(C.lds + C.wave * 12288);
    const int layer = C.layer, j = C.j;
    const bool ab = (layer & 1) == 0;
    const float* Win = ab ? IN(I_ABW) + (size_t)j * D * AB_IN : IN(I_CDW) + (size_t)j * D * CD_IN;
    const int ldw = ab ? AB_IN : CD_IN;
    const int n1 = ab ? A_IN : C_IN, n1p = ab ? LDA_ : LDC_, n2 = ab ? B_IN : D_IN, n2p = ab ? LDB_ : LDD_;
    const int it1 = (D / 64) * (n1p / 32), it2 = (D / 64) * (n2p / 32), it3 = (MIXW / 64) * (D / 32), it4 = (D / 64) * (FF / 32), it5 = (FF / 64) * (D / 32);
    const int total = it1 + it2 + it3 + it4 + it5;
    for (int it = C.gw; it < total; it += C.ngw) {
        int r = it;
        if (r < it1) { transpose_item(Win, ldw, 0, n1, D, n1p, (h16*)(C.ws + W_IN1), scr, r, C.lane); continue; } r -= it1;
        if (r < it2) { transpose_item(Win, ldw, n1, n2, D, n2p, (h16*)(C.ws + W_IN2), scr, r, C.lane); continue; } r -= it2;
        if (r < it3) { transpose_item(IN(I_WOUT) + (size_t)layer * MIXW * D, D, 0, D, MIXW, D, (h16*)(C.ws + W_OUT), scr, r, C.lane); continue; } r -= it3;
        if (r < it4) { transpose_item(IN(I_W1) + (size_t)layer * D * FF, FF, 0, FF, D, FF, (h16*)(C.ws + W_F1), scr, r, C.lane); continue; } r -= it4;
        transpose_item(IN(I_W2) + (size_t)layer * FF * D, D, 0, D, FF, D, (h16*)(C.ws + W_F2), scr, r, C.lane);
    }
    if (layer == 0) {
        float* rot = (float*)(C.ws + WS_ROT);
        for (int idx = C.gtid; idx < 16384 * 64; idx += C.ngt) { const int t = idx >> 6, i = idx & 63;
            const float invf = exp2f(-(float)i * (13.287712379549449f / 64.f)); const float ang = (float)t * invf;
            rot[t * 128 + i] = cosf(ang); rot[t * 128 + 64 + i] = sinf(ang); }
    }
}
__device__ __forceinline__ void phase_norm(Ctx& C, const float* src, const float* gain, h16* dst) {
    const f32x4 g0 = ((const f32x4*)gain)[C.lane], g1 = ((const f32x4*)gain)[64 + C.lane], g2 = ((const f32x4*)gain)[128 + C.lane], g3 = ((const f32x4*)gain)[192 + C.lane];
    for (int m = C.gw; m < MG; m += C.ngw) {
        const f32x4* xr = (const f32x4*)(src + (size_t)m * D) + C.lane;
        f32x4 v[4]; float s = 0.f;
#pragma unroll
        for (int q = 0; q < 4; ++q) { v[q] = xr[64 * q]; s += (v[q].x * v[q].x + v[q].y * v[q].y) + (v[q].z * v[q].z + v[q].w * v[q].w); }
        const float rstd = rsqrtf(wave_sum(s) * (1.f / D) + 1e-5f);
        v[0] = v[0] * g0 * rstd; v[1] = v[1] * g1 * rstd; v[2] = v[2] * g2 * rstd; v[3] = v[3] * g3 * rstd;
        h16x4* o = (h16x4*)(dst + (size_t)m * D) + C.lane;
#pragma unroll
        for (int q = 0; q < 4; ++q) { h16x4 w; w[0] = (h16)v[q].x; w[1] = (h16)v[q].y; w[2] = (h16)v[q].z; w[3] = (h16)v[q].w; o[64 * q] = w; }
    }
}
__device__ __forceinline__ void phase_final_norm(Ctx& C, float* io, const float* gain) {
    const f32x4 g0 = ((const f32x4*)gain)[C.lane], g1 = ((const f32x4*)gain)[64 + C.lane], g2 = ((const f32x4*)gain)[128 + C.lane], g3 = ((const f32x4*)gain)[192 + C.lane];
    for (int m = C.gw; m < 2 * MG; m += C.ngw) {
        f32x4* xr = (f32x4*)(io + (size_t)m * D) + C.lane;
        f32x4 v[4]; float s = 0.f;
#pragma unroll
        for (int q = 0; q < 4; ++q) { v[q] = xr[64 * q]; s += (v[q].x * v[q].x + v[q].y * v[q].y) + (v[q].z * v[q].z + v[q].w * v[q].w); }
        const float rstd = rsqrtf(wave_sum(s) * (1.f / D) + 1e-5f);
        xr[0] = v[0] * g0 * rstd; xr[64] = v[1] * g1 * rstd; xr[128] = v[2] * g2 * rstd; xr[192] = v[3] * g3 * rstd;
    }
}

template <int KS, int MODE, int NT>
__device__ __forceinline__ void rwkv_lora(Ctx& C, int col0, const float* Wl, const float* bias, h16* outp, int ldo, int noff) {
    const int lane = C.lane, fr = lane & 15, fq = lane >> 4, w = C.wave, T = C.T;
    const h16* U = (const h16*)(C.ws + WS_U);
    const float* mu0p = IN(I_MU) + (size_t)C.j * 2 * A_IN, *mu1p = mu0p + A_IN;
    h16x8 bf[NT][KS];
#pragma unroll
    for (int nt = 0; nt < NT; ++nt)
#pragma unroll
        for (int ks = 0; ks < KS; ++ks)
#pragma unroll
            for (int e = 0; e < 8; ++e) bf[nt][ks][e] = (h16)Wl[(size_t)(ks * 32 + fq * 8 + e) * 512 + w * 64 + noff + nt * 16 + fr];
    float bv[NT];
#pragma unroll
    for (int nt = 0; nt < NT; ++nt) bv[nt] = bias ? bias[w * 64 + noff + nt * 16 + fr] : 0.f;
    for (int tile = blockIdx.x; tile < MG / 16; tile += gridDim.x) {
        f32x4 acc[NT];
#pragma unroll
        for (int nt = 0; nt < NT; ++nt) acc[nt] = (f32x4){0.f, 0.f, 0.f, 0.f};
        const int tok = tile * 16 + fr, t = tok % T;
#pragma unroll
        for (int ks = 0; ks < KS; ++ks) {
            const int c = col0 + ks * 32 + fq * 8;
            const h16* up = U + (size_t)tok * LDA_ + c;
            const h16x8 cur = *(const h16x8*)up;
            h16x8 prv, nxt;
#pragma unroll
            for (int e = 0; e < 8; ++e) { prv[e] = (h16)0.f; nxt[e] = (h16)0.f; }
            if (t > 0) prv = *(const h16x8*)(up - LDA_);
            if (t < T - 1) nxt = *(const h16x8*)(up + LDA_);
            h16x8 af;
#pragma unroll
            for (int e = 0; e < 8; ++e) { const float x = (float)cur[e]; float y = x + mu0p[c + e] * ((float)prv[e] - x) + mu1p[c + e] * ((float)nxt[e] - x);
                if (MODE == 0) y = tanhf(y); else if (MODE == 2) y = sigm(y);
                af[e] = (h16)y; }
#pragma unroll
            for (int nt = 0; nt < NT; ++nt) acc[nt] = __builtin_amdgcn_mfma_f32_16x16x32_f16(af, bf[nt][ks], acc[nt], 0, 0, 0);
        }
#pragma unroll
        for (int nt = 0; nt < NT; ++nt)
#pragma unroll
            for (int e = 0; e < 4; ++e) { const int otok = tile * 16 + fq * 4 + e, n = w * 64 + noff + nt * 16 + fr; float y = acc[nt][e] + bv[nt];
                if (MODE == 0) y = sigm(y) * 0.6065306597126334f; else if (MODE == 1) y = sigm(y);
                outp[(size_t)otok * ldo + n] = (h16)y; }
    }
}
__device__ __forceinline__ void rwkv_pre(Ctx& C) {
    h16* U2 = (h16*)(C.ws + WS_U + 64 * MiB); h16* G = (h16*)(C.ws + WS_MIX) + 512;
    const int j = C.j;
    for (int d = 0; d < 2; ++d) {
        rwkv_lora<2, 0, 4>(C, 1536 + 64 * d, IN(I_RW2) + (size_t)(j * 2 + d) * 64 * 512, IN(I_W0) + (size_t)(j * 2 + d) * 512, U2 + d * 1024, 2048, 0);
        rwkv_lora<2, 1, 4>(C, 1664 + 64 * d, IN(I_A2) + (size_t)(j * 2 + d) * 64 * 512, IN(I_A0) + (size_t)(j * 2 + d) * 512, U2 + d * 1024 + 512, 2048, 0);
    }
    for (int hf = 0; hf < 2; ++hf) rwkv_lora<4, 2, 2>(C, 1792, IN(I_G2) + (size_t)j * 128 * 512, nullptr, G, MIXW, hf * 32);
}
template <int PASS>
__device__ __forceinline__ void rwkv_scan(Ctx& C) {
    const int lane = C.lane, T = C.T, NC = T / CH_R, j = C.j;
    const int nunits = C.nseq * 2 * NC * 8;
    const h16* U = (const h16*)(C.ws + WS_U); const h16* U2 = (const h16*)(C.ws + WS_U + 64 * MiB);
    LAS float* wl = (LAS float*)(C.lds + C.wave * 12288);
    const float* mu0p = IN(I_MU) + (size_t)j * 2 * A_IN, *mu1p = mu0p + A_IN;
    for (int unit = C.gw; unit < nunits; unit += C.ngw) {
        const int hd = unit & 7; int r = unit >> 3; const int c = r % NC; r /= NC; const int dir = r & 1, b = r >> 1;
        const int col = hd * 64 + lane;
        const float m0r = mu0p[col], m1r = mu1p[col], m0k = mu0p[512 + col], m1k = mu1p[512 + col], m0v = mu0p[1024 + col], m1v = mu1p[1024 + col];
        const float kkw = IN(I_KK)[j * 512 + col], kaw = IN(I_KA)[j * 512 + col];
        float* slot = (float*)(C.ws + WS_ST) + (size_t)((((b * 2 + dir) * NC + c) * 8) + hd) * 8192;
        float S[64], P[64];
        if (PASS == 1) {
            int ln = lane; asm volatile("" : "+v"(ln));
#pragma unroll
            for (int q = 0; q < 64; ++q) { S[q] = 0.f; P[q] = (q == ln) ? 1.f : 0.f; }
        } else {
#pragma unroll
            for (int q = 0; q < 16; ++q) { const f32x4 v = *(const f32x4*)(slot + lane * 64 + q * 4); S[4 * q] = v.x; S[4 * q + 1] = v.y; S[4 * q + 2] = v.z; S[4 * q + 3] = v.w; }
        }
        h16* outp = (dir == 0) ? (h16*)(C.ws + WS_MIX) : (h16*)(C.ws + WS_O);
        const int ldo = (dir == 0) ? MIXW : 512;
#pragma unroll 1
        for (int sub = 0; sub < CH_R / SUB; ++sub) {
#pragma unroll 1
            for (int s = 0; s < SUB; ++s) {
                const int p = c * CH_R + sub * SUB + s, t = dir ? T - 1 - p : p; const size_t tok = (size_t)b * T + t;
                const h16* ur = U + tok * LDA_ + col;
                const float rc = (float)ur[0], kc = (float)ur[512], vc = (float)ur[1024];
                float rp = 0.f, kp = 0.f, vp = 0.f, rn = 0.f, kn = 0.f, vn = 0.f;
                if (t > 0) { rp = (float)ur[-LDA_]; kp = (float)ur[512 - LDA_]; vp = (float)ur[1024 - LDA_]; }
                if (t < T - 1) { rn = (float)ur[LDA_]; kn = (float)ur[512 + LDA_]; vn = (float)ur[1024 + LDA_]; }
                const float rr = rc + m0r * (rp - rc) + m1r * (rn - rc), kk_ = kc + m0k * (kp - kc) + m1k * (kn - kc), vv = vc + m0v * (vp - vc) + m1v * (vn - vc);
                const float e = (float)U2[tok * 2048 + dir * 1024 + col], av = (float)U2[tok * 2048 + dir * 1024 + 512 + col];
                const float wdec = __expf(-e);
                const float kx = kk_ * kkw; const float n2 = wave_sum(kx * kx); const float kkn = kx / fmaxf(sqrtf(n2), 1e-12f);
                LAS float* q = wl + s * 384;
                q[lane] = wdec; q[64 + lane] = kkn; q[128 + lane] = kkn * av; q[192 + lane] = kk_ * (1.f + (av - 1.f) * kaw); q[256 + lane] = rr; q[320 + lane] = vv;
            }
            WAVE_SYNC();
#pragma unroll 1
            for (int s = 0; s < SUB; ++s) {
                const LAS f32x4* q = (const LAS f32x4*)(wl + s * 384);
                const float vv = wl[s * 384 + 320 + lane];
                float sa0 = 0.f, sa1 = 0.f, sp0 = 0.f, sp1 = 0.f;
#pragma unroll
                for (int k4 = 0; k4 < 16; ++k4) { const f32x4 kk4 = q[16 + k4];
                    sa0 += S[4 * k4] * kk4.x + S[4 * k4 + 2] * kk4.z; sa1 += S[4 * k4 + 1] * kk4.y + S[4 * k4 + 3] * kk4.w;
                    if (PASS == 1) { sp0 += P[4 * k4] * kk4.x + P[4 * k4 + 2] * kk4.z; sp1 += P[4 * k4 + 1] * kk4.y + P[4 * k4 + 3] * kk4.w; }
                    if ((k4 & 3) == 3) __builtin_amdgcn_sched_barrier(0); }
                const float sa = -(sa0 + sa1), sp = -(sp0 + sp1);
                float o0 = 0.f, o1 = 0.f;
#pragma unroll
                for (int k4 = 0; k4 < 16; ++k4) { const f32x4 w4 = q[k4], b4 = q[32 + k4], d4 = q[48 + k4];
                    S[4 * k4] = S[4 * k4] * w4.x + sa * b4.x + vv * d4.x; S[4 * k4 + 1] = S[4 * k4 + 1] * w4.y + sa * b4.y + vv * d4.y;
                    S[4 * k4 + 2] = S[4 * k4 + 2] * w4.z + sa * b4.z + vv * d4.z; S[4 * k4 + 3] = S[4 * k4 + 3] * w4.w + sa * b4.w + vv * d4.w;
                    if (PASS == 1) { P[4 * k4] = P[4 * k4] * w4.x + sp * b4.x; P[4 * k4 + 1] = P[4 * k4 + 1] * w4.y + sp * b4.y; P[4 * k4 + 2] = P[4 * k4 + 2] * w4.z + sp * b4.z; P[4 * k4 + 3] = P[4 * k4 + 3] * w4.w + sp * b4.w; }
                    else { const f32x4 r4 = q[64 + k4]; o0 += S[4 * k4] * r4.x + S[4 * k4 + 2] * r4.z; o1 += S[4 * k4 + 1] * r4.y + S[4 * k4 + 3] * r4.w; }
                    if ((k4 & 1) == 1) __builtin_amdgcn_sched_barrier(0); }
                if (PASS == 2) { const int p = c * CH_R + sub * SUB + s, t = dir ? T - 1 - p : p; outp[((size_t)b * T + t) * ldo + col] = (h16)(o0 + o1); }
            }
            WAVE_SYNC();
        }
        if (PASS == 1) {
#pragma unroll
            for (int q = 0; q < 16; ++q) { *(f32x4*)(slot + lane * 64 + q * 4) = (f32x4){S[4 * q], S[4 * q + 1], S[4 * q + 2], S[4 * q + 3]};
                *(f32x4*)(slot + 4096 + lane * 64 + q * 4) = (f32x4){P[4 * q], P[4 * q + 1], P[4 * q + 2], P[4 * q + 3]}; }
        }
    }
}
__device__ __forceinline__ void rwkv_cross(Ctx& C) {
    const int T = C.T, NC = T / CH_R, nchains = C.nseq * 16, tid = C.tid;
    LAS float* Cs = (LAS float*)C.lds; LAS float* Ps = Cs + 64 * 65;
    const int i = tid >> 3, jg = tid & 7;
    for (int chain = blockIdx.x; chain < nchains; chain += gridDim.x) {
        const int hd = chain & 7, dir = (chain >> 3) & 1, b = chain >> 4;
        float cr[8];
#pragma unroll
        for (int k = 0; k < 8; ++k) cr[k] = 0.f;
        for (int c = 0; c < NC; ++c) {
            float* base = (float*)(C.ws + WS_ST) + (size_t)((((b * 2 + dir) * NC + c) * 8) + hd) * 8192;
            const f32x4 s0 = *(const f32x4*)(base + i * 64 + jg * 8), s1 = *(const f32x4*)(base + i * 64 + jg * 8 + 4);
            const f32x4 p0 = *(const f32x4*)(base + 4096 + tid * 8), p1 = *(const f32x4*)(base + 4096 + tid * 8 + 4);
            *(LAS f32x4*)(Ps + tid * 8) = p0; *(LAS f32x4*)(Ps + tid * 8 + 4) = p1;
#pragma unroll
            for (int k = 0; k < 8; ++k) Cs[i * 65 + jg * 8 + k] = cr[k];
            *(f32x4*)(base + i * 64 + jg * 8) = (f32x4){cr[0], cr[1], cr[2], cr[3]}; *(f32x4*)(base + i * 64 + jg * 8 + 4) = (f32x4){cr[4], cr[5], cr[6], cr[7]};
            __syncthreads();
            float nr[8] = {s0.x, s0.y, s0.z, s0.w, s1.x, s1.y, s1.z, s1.w};
#pragma unroll 8
            for (int m = 0; m < 64; ++m) { const float cm = Cs[i * 65 + m]; const f32x4 a0 = *(const LAS f32x4*)(Ps + m * 64 + jg * 8), a1 = *(const LAS f32x4*)(Ps + m * 64 + jg * 8 + 4);
                nr[0] += cm * a0.x; nr[1] += cm * a0.y; nr[2] += cm * a0.z; nr[3] += cm * a0.w; nr[4] += cm * a1.x; nr[5] += cm * a1.y; nr[6] += cm * a1.z; nr[7] += cm * a1.w; }
            __syncthreads();
#pragma unroll
            for (int k = 0; k < 8; ++k) cr[k] = nr[k];
        }
    }
}
__device__ __forceinline__ void rwkv_final(Ctx& C) {
    const int lane = C.lane, T = C.T, j = C.j, c0 = lane * 8;
    const h16* U = (const h16*)(C.ws + WS_U); h16* MIX = (h16*)(C.ws + WS_MIX); const h16* O = (const h16*)(C.ws + WS_O);
    const float* mu0p = IN(I_MU) + (size_t)j * 2 * A_IN, *mu1p = mu0p + A_IN;
    for (int tok = C.gw; tok < MG; tok += C.ngw) {
        const int t = tok % T;
        const h16x8 of = *(const h16x8*)(MIX + (size_t)tok * MIXW + c0), ob = *(const h16x8*)(O + (size_t)tok * 512 + c0), gg = *(const h16x8*)(MIX + (size_t)tok * MIXW + 512 + c0);
        float o[8], s = 0.f;
#pragma unroll
        for (int e = 0; e < 8; ++e) { o[e] = (float)of[e] + (float)ob[e]; s += o[e]; }
        s += __shfl_xor(s, 1); s += __shfl_xor(s, 2); s += __shfl_xor(s, 4);
        const float mean = s * (1.f / 64.f); float v2 = 0.f;
#pragma unroll
        for (int e = 0; e < 8; ++e) { o[e] -= mean; v2 += o[e] * o[e]; }
        v2 += __shfl_xor(v2, 1); v2 += __shfl_xor(v2, 2); v2 += __shfl_xor(v2, 4);
        const float rstd = rsqrtf(v2 * (1.f / 64.f) + 64e-5f);
        float rv[3][8];
#pragma unroll
        for (int part = 0; part < 3; ++part) {
            const h16* up = U + (size_t)tok * LDA_ + part * 512 + c0;
            const h16x8 cur = *(const h16x8*)up; h16x8 prv, nxt;
#pragma unroll
            for (int e = 0; e < 8; ++e) { prv[e] = (h16)0.f; nxt[e] = (h16)0.f; }
            if (t > 0) prv = *(const h16x8*)(up - LDA_);
            if (t < T - 1) nxt = *(const h16x8*)(up + LDA_);
#pragma unroll
            for (int e = 0; e < 8; ++e) { const float x = (float)cur[e]; rv[part][e] = x + mu0p[part * 512 + c0 + e] * ((float)prv[e] - x) + mu1p[part * 512 + c0 + e] * ((float)nxt[e] - x); }
        }
        float rk = 0.f;
#pragma unroll
        for (int e = 0; e < 8; ++e) rk += rv[0][e] * rv[1][e] * IN(I_RK)[j * 512 + c0 + e];
        rk += __shfl_xor(rk, 1); rk += __shfl_xor(rk, 2); rk += __shfl_xor(rk, 4);
        h16x8 w;
#pragma unroll
        for (int e = 0; e < 8; ++e) { const float y = o[e] * rstd * IN(I_GNW)[j * 512 + c0 + e] + IN(I_GNB)[j * 512 + c0 + e]; w[e] = (h16)((y + rk * rv[2][e]) * (float)gg[e]); }
        *(h16x8*)(MIX + (size_t)tok * MIXW + c0) = w;
    }
}

enum { MX_MAMBA = 0, MX_HGRN = 1, MX_RET = 2 };
template <int MX> struct MXC;
template <> struct MXC<MX_MAMBA> { static constexpr int CH = CH_M, NH = 16, LDU = LDB_; };
template <> struct MXC<MX_HGRN>  { static constexpr int CH = CH_H, NH = 8,  LDU = LDC_; };
template <> struct MXC<MX_RET>   { static constexpr int CH = CH_T, NH = 16, LDU = LDD_; };

__device__ __forceinline__ float ret_gamma(Ctx& C, int dir, int head) { return __expf(-__expf(IN(I_RETLD)[(C.j * 2 + dir) * 4 + head])); }

__device__ __forceinline__ void mamba_pre(Ctx& C) {
    const int T = C.T, j = C.j;
    const h16* U = (const h16*)(C.ws + WS_U); h16* BC = (h16*)(C.ws + WS_U + 88 * MiB); float* DT = (float*)(C.ws + WS_U + 104 * MiB);
    const float* cw = IN(I_CONVW) + (size_t)j * 4 * 1536; const float* cb = IN(I_CONVB) + (size_t)j * 1536;
    for (int idx = C.gtid; idx < MG * 64; idx += C.ngt) {
        const int tok = idx >> 6, q = idx & 63, t = tok % T, c = 1024 + q * 8;
        float acc[8];
#pragma unroll
        for (int e = 0; e < 8; ++e) acc[e] = cb[c + e];
#pragma unroll
        for (int jj = 0; jj < 4; ++jj) { const int tt = t + jj - 2;
            if (tt >= 0 && tt < T) { const h16x8 x = *(const h16x8*)(U + (size_t)(tok + jj - 2) * LDB_ + 1024 + c);
#pragma unroll
                for (int e = 0; e < 8; ++e) acc[e] += cw[jj * 1536 + c + e] * (float)x[e]; } }
        h16x8 w;
#pragma unroll
        for (int e = 0; e < 8; ++e) w[e] = (h16)silu(acc[e]);
        *(h16x8*)(BC + (size_t)tok * 512 + q * 8) = w;
        if (q < 32) { const float x = (float)U[(size_t)tok * LDB_ + 2560 + q] + IN(I_DTB)[j * 32 + q];
            const float dt = (x > 20.f) ? x : log1pf(expf(x)); const float da = -dt * expf(IN(I_ALOG)[j * 32 + q]);
            DT[(size_t)tok * 64 + q] = dt; DT[(size_t)tok * 64 + 32 + q] = expf(da); }
    }
}

template <int MX, int PASS>
__device__ __forceinline__ void diag_scan(Ctx& C) {
    constexpr int CH = MXC<MX>::CH, NH = MXC<MX>::NH, LDU = MXC<MX>::LDU;
    const int lane = C.lane, T = C.T, NC = T / CH, j = C.j;
    const int nunits = C.nseq * 2 * NC * NH;
    const h16* U = (const h16*)(C.ws + WS_U);
    const h16* BC = (const h16*)(C.ws + WS_U + 88 * MiB); const float* DT = (const float*)(C.ws + WS_U + 104 * MiB);
    const float* ROT = (const float*)(C.ws + WS_ROT);
    float* DEC = (float*)(C.ws + WS_DEC);
    LAS float* wl = (LAS float*)(C.lds + C.wave * 12288);
    for (int unit = C.gw; unit < nunits; unit += C.ngw) {
        const int hd = unit % NH; int r = unit / NH; const int c = r % NC; r /= NC; const int dir = r & 1, b = r >> 1;
        const int slotid = ((b * 2 + dir) * NC + c) * NH + hd;
        float* slot = (float*)(C.ws + WS_ST) + (size_t)slotid * 8192;
        float S[128];
        if (PASS == 1) {
#pragma unroll
            for (int q = 0; q < 128; ++q) S[q] = 0.f;
        } else {
#pragma unroll
            for (int q = 0; q < 128; ++q) S[q] = slot[q * 64 + lane];
        }
        float k0 = 0.f, k1 = 0.f, k2 = 0.f, k3 = 0.f, k4c = 0.f, gam = 1.f, dprod = 1.f, D0 = 1.f, D1 = 1.f;
        h16* outp; int ldo, ocol;
        if (MX == MX_MAMBA) { const int cc = hd * 64 + lane; const float* cw = IN(I_CONVW) + (size_t)j * 4 * 1536; k0 = cw[cc]; k1 = cw[1536 + cc]; k2 = cw[2 * 1536 + cc]; k3 = cw[3 * 1536 + cc]; k4c = IN(I_CONVB)[j * 1536 + cc];
            ocol = hd * 64 + lane; if (dir == 0) { outp = (h16*)(C.ws + WS_MIX) + 512; ldo = MIXW; } else { outp = (h16*)(C.ws + WS_O); ldo = 1024; } }
        else if (MX == MX_HGRN) {
            if (j == 1) { const float* lb = IN(I_HGLB); const int f0 = hd * 128 + lane;
                k0 = sigm(lb[(dir * 2 + 1) * 1024 + f0] - lb[(dir * 2 + 0) * 1024 + f0]); k1 = sigm(lb[(dir * 2 + 1) * 1024 + f0 + 64] - lb[(dir * 2 + 0) * 1024 + f0 + 64]); }
            ocol = hd * 64 + lane; if (dir == 0) { outp = (h16*)(C.ws + WS_MIX); ldo = MIXW; } else { outp = (h16*)(C.ws + WS_O); ldo = 512; } }
        else { gam = ret_gamma(C, dir, hd >> 2);
            ocol = hd * 64 + lane; if (dir == 0) { outp = (h16*)(C.ws + WS_MIX) + 512; ldo = MIXW; } else { outp = (h16*)(C.ws + WS_O); ldo = 1024; } }
#pragma unroll 1
        for (int sub = 0; sub < CH / SUB; ++sub) {
#pragma unroll
            for (int s = 0; s < SUB; ++s) {
                const int p = c * CH + sub * SUB + s, t = dir ? T - 1 - p : p; const size_t tok = (size_t)b * T + t;
                const h16* ur = U + tok * LDU;
                LAS float* q = wl + s * 384;
                if (MX == MX_MAMBA) {
                    const int g = hd >> 3; const h16* bc = BC + tok * 512 + g * 128 + lane;
                    q[lane] = (float)bc[0]; q[64 + lane] = (float)bc[64];
                    if (PASS == 2) { q[128 + lane] = (float)bc[256]; q[192 + lane] = (float)bc[320]; }
                    const h16* xp = ur + 1024 + hd * 64 + lane;
                    float acc = k4c + k2 * (float)xp[0];
                    if (t >= 2) acc += k0 * (float)xp[-2 * LDU];
                    if (t >= 1) acc += k1 * (float)xp[-LDU];
                    if (t < T - 1) acc += k3 * (float)xp[LDU];
                    const float dt = DT[tok * 64 + dir * 16 + hd], dA = DT[tok * 64 + 32 + dir * 16 + hd];
                    q[256 + lane] = silu(acc) * dt; q[320] = dA; dprod *= dA;
                } else if (MX == MX_HGRN) {
                    const h16* fp = ur + 1024 + dir * 1024 + hd * 128 + lane;
                    const float f0 = k0 + (1.f - k0) * sigm((float)fp[0]), f1 = k1 + (1.f - k1) * sigm((float)fp[64]);
                    q[lane] = f0; q[64 + lane] = f1; D0 *= f0; D1 *= f1;
                    if (PASS == 2) { q[128 + lane] = (float)ur[hd * 128 + lane]; q[192 + lane] = (float)ur[hd * 128 + 64 + lane]; }
                    q[256 + lane] = (float)ur[3072 + hd * 64 + lane];
                } else {
                    const int h = hd >> 2; const float cs = ROT[t * 128 + lane], sn = ROT[t * 128 + 64 + lane];
                    const float x1 = (float)ur[512 + h * 128 + lane], x2 = (float)ur[512 + h * 128 + 64 + lane];
                    q[lane] = (x1 * cs - x2 * sn) * 0.08838834764831845f; q[64 + lane] = (x2 * cs + x1 * sn) * 0.08838834764831845f;
                    if (PASS == 2) { const float y1 = (float)ur[h * 128 + lane], y2 = (float)ur[h * 128 + 64 + lane]; q[128 + lane] = y1 * cs - y2 * sn; q[192 + lane] = y2 * cs + y1 * sn; }
                    q[256 + lane] = (float)ur[1024 + hd * 64 + lane];
                }
            }
            WAVE_SYNC();
#pragma unroll 1
            for (int s = 0; s < SUB; ++s) {
                const LAS f32x4* q = (const LAS f32x4*)(wl + s * 384);
                const float vv = wl[s * 384 + 256 + lane];
                const float dec = (MX == MX_MAMBA) ? wl[s * 384 + 320] : gam;
                float o0 = 0.f, o1 = 0.f, o2 = 0.f, o3 = 0.f;
#pragma unroll
                for (int k4 = 0; k4 < 32; ++k4) { const f32x4 a4 = q[k4];
                    if (MX == MX_HGRN) { S[4 * k4] = a4.x * (S[4 * k4] - vv) + vv; S[4 * k4 + 1] = a4.y * (S[4 * k4 + 1] - vv) + vv; S[4 * k4 + 2] = a4.z * (S[4 * k4 + 2] - vv) + vv; S[4 * k4 + 3] = a4.w * (S[4 * k4 + 3] - vv) + vv; }
                    else { S[4 * k4] = S[4 * k4] * dec + a4.x * vv; S[4 * k4 + 1] = S[4 * k4 + 1] * dec + a4.y * vv; S[4 * k4 + 2] = S[4 * k4 + 2] * dec + a4.z * vv; S[4 * k4 + 3] = S[4 * k4 + 3] * dec + a4.w * vv; }
                    if (PASS == 2) { const f32x4 q4 = q[32 + k4]; o0 += S[4 * k4] * q4.x; o1 += S[4 * k4 + 1] * q4.y; o2 += S[4 * k4 + 2] * q4.z; o3 += S[4 * k4 + 3] * q4.w; } }
                if (PASS == 2) { const int p = c * CH + sub * SUB + s, t = dir ? T - 1 - p : p; outp[((size_t)b * T + t) * ldo + ocol] = (h16)((o0 + o1) + (o2 + o3)); }
            }
            WAVE_SYNC();
        }
        if (PASS == 1) {
#pragma unroll
            for (int q = 0; q < 128; ++q) slot[q * 64 + lane] = S[q];
            if (MX == MX_MAMBA) { if (lane == 0) DEC[slotid] = dprod; }
            if (MX == MX_HGRN) { DEC[(size_t)slotid * 128 + lane] = D0; DEC[(size_t)slotid * 128 + 64 + lane] = D1; }
        }
    }
}
template <int MX>
__device__ __forceinline__ void diag_cross(Ctx& C) {
    constexpr int CH = MXC<MX>::CH, NH = MXC<MX>::NH;
    const int T = C.T, NC = T / CH, nchains = C.nseq * 2 * NH;
    const float* DEC = (const float*)(C.ws + WS_DEC);
    for (int idx = C.gtid; idx < nchains * 8192; idx += C.ngt) {
        const int chain = idx >> 13, e = idx & 8191, hd = chain % NH; int r = chain / NH; const int dir = r & 1, b = r >> 1;
        float gch = 1.f;
        if (MX == MX_RET) { const float lg = -__expf(IN(I_RETLD)[(C.j * 2 + dir) * 4 + (hd >> 2)]); gch = __expf(lg * (float)CH); }
        float carry = 0.f;
#pragma unroll 4
        for (int c = 0; c < NC; ++c) {
            const int slotid = ((b * 2 + dir) * NC + c) * NH + hd;
            float* p = (float*)(C.ws + WS_ST) + (size_t)slotid * 8192 + e;
            const float sl = *p; *p = carry;
            const float d = (MX == MX_HGRN) ? DEC[(size_t)slotid * 128 + (e >> 6)] : (MX == MX_MAMBA) ? DEC[slotid] : gch;
            carry = d * carry + sl;
        }
    }
}
__device__ __forceinline__ void mamba_final(Ctx& C) {
    const int lane = C.lane, T = C.T, j = C.j, c0 = lane * 16;
    const h16* U = (const h16*)(C.ws + WS_U); h16* MIX = (h16*)(C.ws + WS_MIX); const h16* O = (const h16*)(C.ws + WS_O);
    const float* cw = IN(I_CONVW) + (size_t)j * 4 * 1536; const float* cb = IN(I_CONVB) + (size_t)j * 1536;
    const float dsk = IN(I_SSMD)[j * 16 + (lane >> 2)];
    for (int tok = C.gw; tok < MG; tok += C.ngw) {
        const int t = tok % T;
        float y[16]; float ss = 0.f;
#pragma unroll
        for (int hf = 0; hf < 2; ++hf) {
            const int c = c0 + hf * 8;
            float acc[8];
#pragma unroll
            for (int e = 0; e < 8; ++e) acc[e] = cb[c + e];
#pragma unroll
            for (int jj = 0; jj < 4; ++jj) { const int tt = t + jj - 2;
                if (tt >= 0 && tt < T) { const h16x8 x = *(const h16x8*)(U + (size_t)(tok + jj - 2) * LDB_ + 1024 + c);
#pragma unroll
                    for (int e = 0; e < 8; ++e) acc[e] += cw[jj * 1536 + c + e] * (float)x[e]; } }
            const h16x8 yf = *(const h16x8*)(MIX + (size_t)tok * MIXW + 512 + c), yb = *(const h16x8*)(O + (size_t)tok * 1024 + c), z = *(const h16x8*)(U + (size_t)tok * LDB_ + c);
#pragma unroll
            for (int e = 0; e < 8; ++e) { const float v = ((float)yf[e] + (float)yb[e] + silu(acc[e]) * dsk) * silu((float)z[e]); y[hf * 8 + e] = v; ss += v * v; }
        }
#pragma unroll
        for (int o = 1; o < 32; o <<= 1) ss += __shfl_xor(ss, o);
        const float rstd = rsqrtf(ss * (1.f / 512.f) + 1e-5f);
#pragma unroll
        for (int hf = 0; hf < 2; ++hf) { h16x8 w;
#pragma unroll
            for (int e = 0; e < 8; ++e) w[e] = (h16)(y[hf * 8 + e] * rstd * IN(I_SSMNW)[j * 1024 + c0 + hf * 8 + e]);
            *(h16x8*)(MIX + (size_t)tok * MIXW + 512 + c0 + hf * 8) = w; }
    }
}
__device__ __forceinline__ void hgrn_final(Ctx& C) {
    const int lane = C.lane, j = C.j, c0 = lane * 8;
    const h16* U = (const h16*)(C.ws + WS_U); h16* MIX = (h16*)(C.ws + WS_MIX); const h16* O = (const h16*)(C.ws + WS_O);
    for (int tok = C.gw; tok < MG; tok += C.ngw) {
        const h16x8 of = *(const h16x8*)(MIX + (size_t)tok * MIXW + c0), ob = *(const h16x8*)(O + (size_t)tok * 512 + c0), gg = *(const h16x8*)(U + (size_t)tok * LDC_ + 3584 + c0);
        float o[8], ss = 0.f;
#pragma unroll
        for (int e = 0; e < 8; ++e) { o[e] = (float)of[e] + (float)ob[e]; ss += o[e] * o[e]; }
        ss += __shfl_xor(ss, 1); ss += __shfl_xor(ss, 2); ss += __shfl_xor(ss, 4);
        const float rstd = rsqrtf(ss * (1.f / 64.f) + 1e-5f);
        h16x8 w;
#pragma unroll
        for (int e = 0; e < 8; ++e) w[e] = (h16)(o[e] * rstd * IN(I_HGNW)[j * 512 + c0 + e] * sigm((float)gg[e]));
        *(h16x8*)(MIX + (size_t)tok * MIXW + c0) = w;
    }
}
__device__ __forceinline__ void ret_final(Ctx& C) {
    const int lane = C.lane, j = C.j, c0 = lane * 16;
    const h16* U = (const h16*)(C.ws + WS_U); h16* MIX = (h16*)(C.ws + WS_MIX); const h16* O = (const h16*)(C.ws + WS_O);
    for (int tok = C.gw; tok < MG; tok += C.ngw) {
        float o[16], s = 0.f;
#pragma unroll
        for (int hf = 0; hf < 2; ++hf) { const h16x8 of = *(const h16x8*)(MIX + (size_t)tok * MIXW + 512 + c0 + hf * 8), ob = *(const h16x8*)(O + (size_t)tok * 1024 + c0 + hf * 8);
#pragma unroll
            for (int e = 0; e < 8; ++e) { o[hf * 8 + e] = (float)of[e] + (float)ob[e]; s += o[hf * 8 + e]; } }
#pragma unroll
        for (int q = 1; q < 16; q <<= 1) s += __shfl_xor(s, q);
        const float mean = s * (1.f / 256.f); float v2 = 0.f;
#pragma unroll
        for (int e = 0; e < 16; ++e) { o[e] -= mean; v2 += o[e] * o[e]; }
#pragma unroll
        for (int q = 1; q < 16; q <<= 1) v2 += __shfl_xor(v2, q);
        const float rstd = rsqrtf(v2 * (1.f / 256.f) + 1e-5f);
#pragma unroll
        for (int hf = 0; hf < 2; ++hf) { const h16x8 gg = *(const h16x8*)(U + (size_t)tok * LDD_ + 2048 + c0 + hf * 8); h16x8 w;
#pragma unroll
            for (int e = 0; e < 8; ++e) { const int cc = c0 + hf * 8 + e; w[e] = (h16)((o[hf * 8 + e] * rstd * IN(I_RETGW)[j * 1024 + cc] + IN(I_RETGB)[j * 1024 + cc]) * silu((float)gg[e])); }
            *(h16x8*)(MIX + (size_t)tok * MIXW + 512 + c0 + hf * 8) = w; }
    }
}

template <class Epi> __device__ __forceinline__ void run_gemm(Ctx& C, const h16* A, const h16* Bt, int N, int K, const Epi& E) {
    pg8::Gemm g{A, Bt, MG, N, K}; pg8::StaticOrder S; S.init(MG, N, (int)gridDim.x, (int)blockIdx.x);
    pg8::gemm_phase<Epi, pg8::StaticOrder>(C.lds, g, S, E, C.tid);
}

__global__ void __launch_bounds__(NTHR, 2) mega(Args args) {
    extern __shared__ __attribute__((aligned(16))) unsigned char lds_raw[];
    cg::grid_group grid = cg::this_grid();
    Ctx C;
#pragma unroll
    for (int i = 0; i < 32; ++i) C.in[i] = args.in[i];
    C.lds = (LAS unsigned char*)lds_raw; C.tid = threadIdx.x; C.lane = C.tid & 63; C.wave = __builtin_amdgcn_readfirstlane(C.tid >> 6);
    C.gw = blockIdx.x * NWAVES + C.wave; C.ngw = gridDim.x * NWAVES; C.gtid = blockIdx.x * NTHR + C.tid; C.ngt = gridDim.x * NTHR; C.ws = args.ws;
    h16* HN = (h16*)(C.ws + WS_HN); h16* MIX = (h16*)(C.ws + WS_MIX); h16* U = (h16*)(C.ws + WS_U);
#define SYNC() grid.sync()
#ifndef PH
#define PH 0xFFFF
#endif
#define P_(b, ...) do { if (PH & (1 << (b))) { int t_ = threadIdx.x; asm volatile("" : "+v"(t_)); C.tid = t_; C.lane = t_ & 63; C.wave = __builtin_amdgcn_readfirstlane(t_ >> 6); C.gw = blockIdx.x * NWAVES + C.wave; C.gtid = blockIdx.x * NTHR + t_; __VA_ARGS__; } } while (0)
#pragma unroll 1
    for (int layer = 0; layer < 4; ++layer) {
        C.layer = layer; C.j = layer >> 1;
        P_(0, phase_weights(C)); SYNC();
#pragma unroll 1
        for (int grp = 0; grp < 2; ++grp) {
            C.grp = grp; C.nseq = grp == 0 ? 2 : 1; C.T = grp == 0 ? 8192 : 16384;
            C.hdst = args.out + (size_t)grp * MG * D; C.hsrc = (layer == 0) ? args.in[grp == 0 ? I_XP : I_XS] : C.hdst;
            P_(1, phase_norm(C, C.hsrc, IN(I_LNMIX) + layer * D, HN)); SYNC();
            if ((layer & 1) == 0) {
                P_(2, run_gemm(C, HN, (const h16*)(C.ws + W_IN1), LDA_, D, pg8::EpiF16<0>{U, LDA_})); SYNC();
                P_(3, rwkv_pre(C)); SYNC();
                P_(4, rwkv_scan<1>(C)); SYNC();
                P_(5, rwkv_cross(C)); SYNC();
                P_(6, rwkv_scan<2>(C)); SYNC();
                P_(7, rwkv_final(C)); SYNC();
                P_(2, run_gemm(C, HN, (const h16*)(C.ws + W_IN2), LDB_, D, pg8::EpiF16<0>{U, LDB_})); SYNC();
                P_(8, mamba_pre(C)); SYNC();
                P_(9, diag_scan<MX_MAMBA, 1>(C)); SYNC();
                P_(9, diag_cross<MX_MAMBA>(C)); SYNC();
                P_(9, diag_scan<MX_MAMBA, 2>(C)); SYNC();
                P_(10, mamba_final(C)); SYNC();
            } else {
                P_(2, run_gemm(C, HN, (const h16*)(C.ws + W_IN1), LDC_, D, pg8::EpiF16<0>{U, LDC_})); SYNC();
                P_(11, diag_scan<MX_HGRN, 1>(C)); SYNC();
                P_(11, diag_cross<MX_HGRN>(C)); SYNC();
                P_(11, diag_scan<MX_HGRN, 2>(C)); SYNC();
                P_(12, hgrn_final(C)); SYNC();
                P_(2, run_gemm(C, HN, (const h16*)(C.ws + W_IN2), LDD_, D, pg8::EpiF16<0>{U, LDD_})); SYNC();
                P_(13, diag_scan<MX_RET, 1>(C)); SYNC();
                P_(13, diag_cross<MX_RET>(C)); SYNC();
                P_(13, diag_scan<MX_RET, 2>(C)); SYNC();
                P_(14, ret_final(C)); SYNC();
            }
            P_(15, run_gemm(C, MIX, (const h16*)(C.ws + W_OUT), D, MIXW, pg8::EpiRes{C.hsrc, C.hdst, D})); SYNC();
            P_(1, phase_norm(C, C.hdst, IN(I_LNFFN) + layer * D, HN)); SYNC();
            P_(15, run_gemm(C, HN, (const h16*)(C.ws + W_F1), FF, D, pg8::EpiF16<1>{U, FF})); SYNC();
            P_(15, run_gemm(C, U, (const h16*)(C.ws + W_F2), D, FF, pg8::EpiRes{C.hdst, C.hdst, D})); SYNC();
        }
    }
    P_(1, phase_final_norm(C, args.out, IN(I_LNFINAL)));
}

extern "C" void kernel_launch(void* const* d_in, const int* in_sizes, int n_in, void* d_out, int out_size, void* d_ws, size_t ws_size, hipStream_t stream) {
    static int grid = 0;
    if (grid == 0) {
        if (n_in != 32 || ws_size < WS_END) { fprintf(stderr, "kernel_launch: unexpected n_in %d or ws_size %zu (< %zu)\n", n_in, ws_size, (size_t)WS_END); grid = -1; return; }
        int dev = 0, cus = 0, per_cu = 0;
        hipGetDevice(&dev); hipDeviceGetAttribute(&cus, hipDeviceAttributeMultiprocessorCount, dev);
        if (hipFuncSetAttribute((const void*)mega, hipFuncAttributeMaxDynamicSharedMemorySize, LDS_BYTES) != hipSuccess) { fprintf(stderr, "kernel_launch: hipFuncSetAttribute failed\n"); grid = -1; return; }
        if (hipOccupancyMaxActiveBlocksPerMultiprocessor(&per_cu, (const void*)mega, NTHR, LDS_BYTES) != hipSuccess || per_cu < 1) { fprintf(stderr, "kernel_launch: occupancy query says %d\n", per_cu); per_cu = 1; }
        (void)hipGetLastError();
        grid = cus * per_cu;
    }
    if (grid < 0) return;
    Args a{};
    for (int i = 0; i < 32; ++i) a.in[i] = (const float*)d_in[i];
    a.out = (float*)d_out; a.ws = (unsigned char*)d_ws;
    void* params[] = {&a};
    hipError_t e = hipLaunchCooperativeKernel((const void*)mega, dim3(grid), dim3(NTHR), params, LDS_BYTES, stream);
    if (e != hipSuccess) fprintf(stderr, "kernel_launch: cooperative launch failed: %s (grid %d)\n", hipGetErrorString(e), grid);
}
```

```cpp
#include <hip/hip_runtime.h>
#include <hip/hip_cooperative_groups.h>
#include <cstdio>
#include <cstdint>
namespace cg = cooperative_groups;

#define LAS __attribute__((address_space(3)))
typedef _Float16 h16;
typedef _Float16 h16x8 __attribute__((ext_vector_type(8)));
typedef _Float16 h16x4 __attribute__((ext_vector_type(4)));
typedef float f32x4 __attribute__((ext_vector_type(4)));

constexpr int D = 1024, FF = 4096, MIXW = 1536, MG = 16384;
constexpr int A_IN = 1920, B_IN = 2592, AB_IN = 4512, C_IN = 4096, D_IN = 3072, CD_IN = 7168;
constexpr int LDA_ = 2048, LDB_ = 2816, LDC_ = 4096, LDD_ = 3072;
constexpr int CH_R = 128, CH_M = 256, CH_H = 128, CH_T = 256;
constexpr int SUB = 8;
constexpr int NWAVES = 8, NTHR = 512;
constexpr int LDS_BYTES = 147456;
constexpr size_t MiB = 1u << 20;
constexpr size_t WS_ROT = 0, WS_DEC = 8 * MiB, WS_W = 10 * MiB, WS_HN = 43 * MiB, WS_MIX = 75 * MiB, WS_U = 123 * MiB, WS_ST = 251 * MiB, WS_O = 315 * MiB, WS_END = 347 * MiB;
constexpr size_t W_IN1 = WS_W, W_IN2 = WS_W + 8 * MiB, W_OUT = WS_W + 14 * MiB, W_F1 = WS_W + 17 * MiB, W_F2 = WS_W + 25 * MiB;

struct Args { const float* in[32]; float* out; unsigned char* ws; };
enum { I_XP = 0, I_XS, I_LNMIX, I_LNFFN, I_LNFINAL, I_WOUT, I_W1, I_W2, I_ABW, I_MU, I_W0, I_RW2, I_A0, I_A2, I_G2, I_KK, I_KA, I_RK, I_GNW, I_GNB,
       I_CONVW, I_CONVB, I_DTB, I_ALOG, I_SSMD, I_SSMNW, I_CDW, I_HGLB, I_HGNW, I_RETLD, I_RETGW, I_RETGB };

__device__ __forceinline__ float sigm(float x) { return 1.f / (1.f + __expf(-x)); }
__device__ __forceinline__ float silu(float x) { return x / (1.f + __expf(-x)); }
__device__ __forceinline__ float wave_sum(float v) {
#pragma unroll
    for (int o = 1; o < 64; o <<= 1) v += __shfl_xor(v, o);
    return v;
}
#define WAVE_SYNC() do { asm volatile("s_waitcnt lgkmcnt(0)" ::: "memory"); __builtin_amdgcn_wave_barrier(); } while (0)

namespace pg8 {
constexpr int BM = 256, BK = 64, HALF = 128, HTB = HALF * BK * 2, STAGE_BYTES = 8 * HTB, NXCD = 8, WGM = 8;
__host__ __device__ __forceinline__ int lds_byte(int r, int c) { const int st = (r >> 4) * 2 + (c >> 5), rr = r & 15, cc = c & 31, ob = rr * 64 + cc * 2; return st * 1024 + (ob ^ (((ob >> 9) & 1) << 5)); }
__host__ __device__ __forceinline__ void stage_rc(int b, int& R, int& C) { const int st = b / 1024, sb = b % 1024, swz = sb ^ (((sb >> 9) & 1) << 5); R = (st >> 1) * 16 + swz / 64; C = (st & 1) * 32 + (swz % 64) / 2; }
__host__ __device__ __forceinline__ int perm32(int rho) { const int n = rho >> 4, i = rho & 15; return 8 * (i >> 2) + 4 * n + (i & 3); }
struct Unit { int pm, pn; };
struct Gemm { const h16* A; const h16* Bt; int M, N, K; };
struct StaticOrder {
    int nM, nN, nwg, G, c;
    __device__ void init(int M, int N, int G_, int c_) { nM = M / BM; nN = N / BM; nwg = nM * nN; G = G_; c = c_; }
    __device__ bool next(int i, Unit& u) const {
        const long L = (long)i * G + c; if (L >= nwg) return false;
        int wgid = (int)L; { const int q = nwg / NXCD, r = nwg % NXCD, xcd = wgid % NXCD, off = wgid / NXCD; wgid = (xcd < r ? xcd * (q + 1) : r * (q + 1) + (xcd - r) * q) + off; }
        const int nig = WGM * nN, gid = wgid / nig, fm = gid * WGM, gsz = (nM - fm) < WGM ? (nM - fm) : WGM;
        u.pm = fm + ((wgid % nig) % gsz); u.pn = (wgid % nig) / gsz; return true;
    }
};
template <int ACT> struct EpiF16 {
    h16* O; int ldc;
    __device__ __forceinline__ void operator()(const f32x4 (&acc)[2][2][4][2], const Unit& u, int wr, int wc, int fr, int fq) const {
        const int row0 = u.pm * BM + wr * 64 + fr; const int col0 = u.pn * BM + wc * 32 + 8 * fq;
#pragma unroll
        for (int ai = 0; ai < 2; ++ai)
#pragma unroll
            for (int m = 0; m < 4; ++m) { h16* rowp = O + (size_t)(row0 + ai * HALF + m * 16) * ldc + col0;
#pragma unroll
                for (int bj = 0; bj < 2; ++bj) { f32x4 v0 = acc[ai][bj][m][0], v1 = acc[ai][bj][m][1];
                    if (ACT == 1) {
#pragma unroll
                        for (int e = 0; e < 4; ++e) { float a = fmaxf(v0[e], 0.f), b = fmaxf(v1[e], 0.f); v0[e] = a * a; v1[e] = b * b; } }
                    h16x8 w; w[0] = (h16)v0[0]; w[1] = (h16)v0[1]; w[2] = (h16)v0[2]; w[3] = (h16)v0[3]; w[4] = (h16)v1[0]; w[5] = (h16)v1[1]; w[6] = (h16)v1[2]; w[7] = (h16)v1[3];
                    *(h16x8*)(rowp + bj * HALF) = w; } }
    }
};
struct EpiRes {
    const float* src; float* dst; int ldc;
    __device__ __forceinline__ void operator()(const f32x4 (&acc)[2][2][4][2], const Unit& u, int wr, int wc, int fr, int fq) const {
        const int row0 = u.pm * BM + wr * 64 + fr; const int col0 = u.pn * BM + wc * 32 + 8 * fq;
#pragma unroll
        for (int ai = 0; ai < 2; ++ai)
#pragma unroll
            for (int m = 0; m < 4; ++m) { const size_t off = (size_t)(row0 + ai * HALF + m * 16) * ldc + col0;
#pragma unroll
                for (int bj = 0; bj < 2; ++bj) {
                    const f32x4 s0 = *(const f32x4*)(src + off + bj * HALF), s1 = *(const f32x4*)(src + off + bj * HALF + 4);
                    *(f32x4*)(dst + off + bj * HALF) = s0 + acc[ai][bj][m][0]; *(f32x4*)(dst + off + bj * HALF + 4) = s1 + acc[ai][bj][m][1]; } }
    }
};

template <class Epi, class Sched>
__device__ __forceinline__ void gemm_phase(LAS unsigned char* lds, const Gemm g, const Sched& S, const Epi& E, const int tid) {
    const int wid = __builtin_amdgcn_readfirstlane(tid >> 6), lane = tid & 63, wr = wid >> 2, wc = wid & 3, fr = lane & 15, fq = lane >> 4;
    const int K = g.K, nt = K / BK;
    unsigned voffA[2], voffB[2];
#pragma unroll
    for (int i = 0; i < 2; ++i) { int R, C; stage_rc(tid * 16 + i * 8192, R, C); const int Rb = (R & ~31) + perm32(R & 31);
        voffA[i] = (unsigned)(R * K + C) * 2u; voffB[i] = (unsigned)(Rb * K + C) * 2u; }
    const size_t kstep = (size_t)(BK * 2);
    const size_t hstep = (size_t)HALF * K * 2;
    const size_t tstep = 2 * hstep;
    const unsigned ldsw = (unsigned)wid * 1024u;
    const int aoff = lds_byte(wr * 64 + fr, fq * 8), boff = lds_byte(wc * 32 + fr, fq * 8);
#define PG8_SA(b, h) (((b) * 2 + (h)) * HTB)
#define PG8_SB(b, h) ((4 + (b) * 2 + (h)) * HTB)
#define PG8_STAGE(bufoff, gbase, voff) do { _Pragma("unroll") for (int _i = 0; _i < 2; ++_i) \
        __builtin_amdgcn_global_load_lds((const unsigned*)((const char*)(gbase) + (voff)[_i]), (LAS unsigned*)(lds + (bufoff) + ldsw + _i * 8192), 16, 0, 0); } while (0)
#define PG8_LDA(dst, b, h) do { _Pragma("unroll") for (int m = 0; m < 4; ++m) _Pragma("unroll") for (int k = 0; k < 2; ++k) dst[m][k] = *(const LAS h16x8*)(lds + PG8_SA(b, h) + aoff + m * 2048 + k * 1024); } while (0)
#define PG8_LDB(dst, b, h) do { _Pragma("unroll") for (int n = 0; n < 2; ++n) _Pragma("unroll") for (int k = 0; k < 2; ++k) dst[n][k] = *(const LAS h16x8*)(lds + PG8_SB(b, h) + boff + n * 2048 + k * 1024); } while (0)
#define PG8_MMA(ai, bj, At, Bt) do { __builtin_amdgcn_s_setprio(1); _Pragma("unroll") for (int m = 0; m < 4; ++m) _Pragma("unroll") for (int n = 0; n < 2; ++n) _Pragma("unroll") for (int k = 0; k < 2; ++k) \
        acc[ai][bj][m][n] = __builtin_amdgcn_mfma_f32_16x16x32_f16(Bt[n][k], At[m][k], acc[ai][bj][m][n], 0, 0, 0); __builtin_amdgcn_s_setprio(0); } while (0)
#define PG8_WAIT_V(n) asm volatile("s_waitcnt vmcnt(" #n ")" ::: "memory")
#define PG8_WAIT_L(n) asm volatile("s_waitcnt lgkmcnt(" #n ")" ::: "memory")
#define PG8_BAR __builtin_amdgcn_s_barrier()
#define PG8_SCHED __builtin_amdgcn_sched_barrier(0)
    Unit cur, nxt; int ui = 0;
    if (!S.next(0, cur)) return;
    f32x4 acc[2][2][4][2];
#pragma unroll
    for (int a = 0; a < 2; ++a)
#pragma unroll
        for (int b = 0; b < 2; ++b)
#pragma unroll
            for (int m = 0; m < 4; ++m)
#pragma unroll
                for (int n = 0; n < 2; ++n) acc[a][b][m][n] = (f32x4){0.f, 0.f, 0.f, 0.f};
    h16x8 At[4][2], B0[2][2], B1[2][2];
    const char* cA = (const char*)g.A + (size_t)cur.pm * tstep; const char* cB = (const char*)g.Bt + (size_t)cur.pn * tstep;
    PG8_STAGE(PG8_SB(0, 0), cB, voffB); PG8_STAGE(PG8_SB(0, 1), cB + hstep, voffB); PG8_STAGE(PG8_SA(0, 0), cA, voffA); PG8_STAGE(PG8_SA(0, 1), cA + hstep, voffA);
    if (wr == 1) PG8_BAR;
    PG8_WAIT_V(2); PG8_BAR;
    PG8_STAGE(PG8_SB(1, 0), cB + kstep, voffB); PG8_STAGE(PG8_SA(1, 0), cA + kstep, voffA); PG8_STAGE(PG8_SB(1, 1), cB + hstep + kstep, voffB);
    PG8_WAIT_V(6); PG8_BAR;
    for (;;) {
        const bool has_next = S.next(ui + 1, nxt);
        const char* nA = has_next ? (const char*)g.A + (size_t)nxt.pm * tstep : cA; const char* nB = has_next ? (const char*)g.Bt + (size_t)nxt.pn * tstep : cB;
        for (int t = 0; t < nt; t += 2) {
            const bool last = (t == nt - 2);
            const char* a1 = cA + (size_t)(t + 1) * kstep;
            const char* a2 = last ? nA : cA + (size_t)(t + 2) * kstep; const char* b2 = last ? nB : cB + (size_t)(t + 2) * kstep;
            const char* a3 = a2 + kstep; const char* b3 = b2 + kstep;
            PG8_LDB(B0, 0, 0); PG8_LDB(B1, 0, 1); PG8_SCHED; PG8_LDA(At, 0, 0); PG8_STAGE(PG8_SA(1, 1), a1 + hstep, voffA);
            PG8_WAIT_V(8); PG8_WAIT_L(0); PG8_BAR; PG8_MMA(0, 0, At, B0); PG8_MMA(0, 1, At, B1); PG8_BAR; PG8_SCHED;
            PG8_LDA(At, 0, 1); PG8_STAGE(PG8_SB(0, 0), b2, voffB); PG8_STAGE(PG8_SB(0, 1), b2 + hstep, voffB); PG8_STAGE(PG8_SA(0, 0), a2, voffA);
            PG8_WAIT_V(8); PG8_WAIT_L(0); PG8_BAR; PG8_MMA(1, 0, At, B0); PG8_MMA(1, 1, At, B1); PG8_BAR; PG8_SCHED;
            PG8_LDB(B0, 1, 0); PG8_LDB(B1, 1, 1); PG8_SCHED; PG8_LDA(At, 1, 0); PG8_STAGE(PG8_SA(0, 1), a2 + hstep, voffA);
            PG8_WAIT_V(8); PG8_WAIT_L(0); PG8_BAR; PG8_MMA(0, 0, At, B0); PG8_MMA(0, 1, At, B1); PG8_BAR; PG8_SCHED;
            PG8_LDA(At, 1, 1); PG8_STAGE(PG8_SB(1, 0), b3, voffB); PG8_STAGE(PG8_SB(1, 1), b3 + hstep, voffB); PG8_STAGE(PG8_SA(1, 0), a3, voffA);
            PG8_WAIT_V(8); PG8_WAIT_L(0); PG8_BAR; PG8_MMA(1, 0, At, B0); PG8_MMA(1, 1, At, B1); PG8_BAR; PG8_SCHED;
        }
        if (wr == 0) PG8_BAR;
        E(acc, cur, wr, wc, fr, fq);
        if (!has_next) break;
#pragma unroll
        for (int a = 0; a < 2; ++a)
#pragma unroll
            for (int b = 0; b < 2; ++b)
#pragma unroll
                for (int m = 0; m < 4; ++m)
#pragma unroll
                    for (int n = 0; n < 2; ++n) acc[a][b][m][n] = (f32x4){0.f, 0.f, 0.f, 0.f};
        cur = nxt; cA = nA; cB = nB; ++ui;
        if (wr == 1) PG8_BAR;
    }
    PG8_WAIT_V(0);
    PG8_BAR;
#undef PG8_SA
#undef PG8_SB
#undef PG8_STAGE
#undef PG8_LDA
#undef PG8_LDB
#undef PG8_MMA
#undef PG8_WAIT_V
#undef PG8_WAIT_L
#undef PG8_BAR
#undef PG8_SCHED
}
}

struct Ctx {
    const float* in[32]; LAS unsigned char* lds; int tid, lane, wave, gw, ngw, gtid, ngt;
    int layer, j, grp, nseq, T;
    const float* hsrc; float* hdst;
    unsigned char* ws;
};
#define IN(k) (C.in[k])

__device__ __forceinline__ void transpose_item(const float* W, int ldw, int c0, int nvalid, int K, int Npad, h16* WT, LAS float* scr, int item, int lane) {
    const int nblk = Npad / 32, kb = item / nblk, nb = item % nblk, k0 = 64 * kb, n0 = 32 * nb;
    const int n = n0 + (lane & 31);
#pragma unroll 8
    for (int i = 0; i < 32; ++i) { const int kk = 2 * i + (lane >> 5); scr[kk * 33 + (lane & 31)] = (n < nvalid) ? W[(size_t)(k0 + kk) * ldw + c0 + n] : 0.f; }
    WAVE_SYNC();
    const int c = lane & 7;
#pragma unroll
    for (int jj = 0; jj < 4; ++jj) { const int nn = (lane >> 3) + 8 * jj; const LAS float* s = scr + (8 * c) * 33 + nn;
        h16x8 o;
#pragma unroll
        for (int e = 0; e < 8; ++e) o[e] = (h16)s[e * 33];
        *(h16x8*)(WT + (size_t)(n0 + nn) * K + k0 + 8 * c) = o; }
    WAVE_SYNC();
}
__device__ __forceinline__ void phase_weights(Ctx& C) {
    LAS float* scr = (LAS float*)(C.lds + C.wave * 12288);
    const int layer = C.layer, j = C.j;
    const bool ab = (layer & 1) == 0;
    const float* Win = ab ? IN(I_ABW) + (size_t)j * D * AB_IN : IN(I_CDW) + (size_t)j * D * CD_IN;
    const int ldw = ab ? AB_IN : CD_IN;
    const int n1 = ab ? A_IN : C_IN, n1p = ab ? LDA_ : LDC_, n2 = ab ? B_IN : D_IN, n2p = ab ? LDB_ : LDD_;
    const int it1 = (D / 64) * (n1p / 32), it2 = (D / 64) * (n2p / 32), it3 = (MIXW / 64) * (D / 32), it4 = (D / 64) * (FF / 32), it5 = (FF / 64) * (D / 32);
    const int total = it1 + it2 + it3 + it4 + it5;
    for (int it = C.gw; it < total; it += C.ngw) {
        int r = it;
        if (r < it1) { transpose_item(Win, ldw, 0, n1, D, n1p, (h16*)(C.ws + W_IN1), scr, r, C.lane); continue; } r -= it1;
        if (r < it2) { transpose_item(Win, ldw, n1, n2, D, n2p, (h16*)(C.ws + W_IN2), scr, r, C.lane); continue; } r -= it2;
        if (r < it3) { transpose_item(IN(I_WOUT) + (size_t)layer * MIXW * D, D, 0, D, MIXW, D, (h16*)(C.ws + W_OUT), scr, r, C.lane); continue; } r -= it3;
        if (r < it4) { transpose_item(IN(I_W1) + (size_t)layer * D * FF, FF, 0, FF, D, FF, (h16*)(C.ws + W_F1), scr, r, C.lane); continue; } r -= it4;
        transpose_item(IN(I_W2) + (size_t)layer * FF * D, D, 0, D, FF, D, (h16*)(C.ws + W_F2), scr, r, C.lane);
    }
    if (layer == 0) {
        float* rot = (float*)(C.ws + WS_ROT);
        for (int idx = C.gtid; idx < 16384 * 64; idx += C.ngt) { const int t = idx >> 6, i = idx & 63;
            const float invf = exp2f(-(float)i * (13.287712379549449f / 64.f)); const float ang = (float)t * invf;
            rot[t * 128 + i] = cosf(ang); rot[t * 128 + 64 + i] = sinf(ang); }
    }
}
__device__ __forceinline__ void phase_norm(Ctx& C, const float* src, const float* gain, h16* dst) {
    const f32x4 g0 = ((const f32x4*)gain)[C.lane], g1 = ((const f32x4*)gain)[64 + C.lane], g2 = ((const f32x4*)gain)[128 + C.lane], g3 = ((const f32x4*)gain)[192 + C.lane];
    for (int m = C.gw; m < MG; m += C.ngw) {
        const f32x4* xr = (const f32x4*)(src + (size_t)m * D) + C.lane;
        f32x4 v[4]; float s = 0.f;
#pragma unroll
        for (int q = 0; q < 4; ++q) { v[q] = xr[64 * q]; s += (v[q].x * v[q].x + v[q].y * v[q].y) + (v[q].z * v[q].z + v[q].w * v[q].w); }
        const float rstd = rsqrtf(wave_sum(s) * (1.f / D) + 1e-5f);
        v[0] = v[0] * g0 * rstd; v[1] = v[1] * g1 * rstd; v[2] = v[2] * g2 * rstd; v[3] = v[3] * g3 * rstd;
        h16x4* o = (h16x4*)(dst + (size_t)m * D) + C.lane;
#pragma unroll
        for (int q = 0; q < 4; ++q) { h16x4 w; w[0] = (h16)v[q].x; w[1] = (h16)v[q].y; w[2] = (h16)v[q].z; w[3] = (h16)v[q].w; o[64 * q] = w; }
    }
}
__device__ __forceinline__ void phase_final_norm(Ctx& C, float* io, const float* gain) {
    const f32x4 g0 = ((const f32x4*)gain)[C.lane], g1 = ((const f32x4*)gain)[64 + C.lane], g2 = ((const f32x4*)gain)[128 + C.lane], g3 = ((const f32x4*)gain)[192 + C.lane];
    for (int m = C.gw; m < 2 * MG; m += C.ngw) {
        f32x4* xr = (f32x4*)(io + (size_t)m * D) + C.lane;
        f32x4 v[4]; float s = 0.f;
#pragma unroll
        for (int q = 0; q < 4; ++q) { v[q] = xr[64 * q]; s += (v[q].x * v[q].x + v[q].y * v[q].y) + (v[q].z * v[q].z + v[q].w * v[q].w); }
        const float rstd = rsqrtf(wave_sum(s) * (1.f / D) + 1e-5f);
        xr[0] = v[0] * g0 * rstd; xr[64] = v[1] * g1 * rstd; xr[128] = v[2] * g2 * rstd; xr[192] = v[3] * g3 * rstd;
    }
}

template <int KS, int MODE, int NT>
__device__ __forceinline__ void rwkv_lora(Ctx& C, int col0, const float* Wl, const float* bias, h16* outp, int ldo, int noff) {
    const int lane = C.lane, fr = lane & 15, fq = lane >> 4, w = C.wave, T = C.T;
    const h16* U = (const h16*)(C.ws + WS_U);
    const float* mu0p = IN(I_MU) + (size_t)C.j * 2 * A_IN, *mu1p = mu0p + A_IN;
    h16x8 bf[NT][KS];
#pragma unroll
    for (int nt = 0; nt < NT; ++nt)
#pragma unroll
        for (int ks = 0; ks < KS; ++ks)
#pragma unroll
            for (int e = 0; e < 8; ++e) bf[nt][ks][e] = (h16)Wl[(size_t)(ks * 32 + fq * 8 + e) * 512 + w * 64 + noff + nt * 16 + fr];
    float bv[NT];
#pragma unroll
    for (int nt = 0; nt < NT; ++nt) bv[nt] = bias ? bias[w * 64 + noff + nt * 16 + fr] : 0.f;
    for (int tile = blockIdx.x; tile < MG / 16; tile += gridDim.x) {
        f32x4 acc[NT];
#pragma unroll
        for (int nt = 0; nt < NT; ++nt) acc[nt] = (f32x4){0.f, 0.f, 0.f, 0.f};
        const int tok = tile * 16 + fr, t = tok % T;
#pragma unroll
        for (int ks = 0; ks < KS; ++ks) {
            const int c = col0 + ks * 32 + fq * 8;
            const h16* up = U + (size_t)tok * LDA_ + c;
            const h16x8 cur = *(const h16x8*)up;
            h16x8 prv, nxt;
#pragma unroll
            for (int e = 0; e < 8; ++e) { prv[e] = (h16)0.f; nxt[e] = (h16)0.f; }
            if (t > 0) prv = *(const h16x8*)(up - LDA_);
            if (t < T - 1) nxt = *(const h16x8*)(up + LDA_);
            h16x8 af;
#pragma unroll
            for (int e = 0; e < 8; ++e) { const float x = (float)cur[e]; float y = x + mu0p[c + e] * ((float)prv[e] - x) + mu1p[c + e] * ((float)nxt[e] - x);
                if (MODE == 0) y = tanhf(y); else if (MODE == 2) y = sigm(y);
                af[e] = (h16)y; }
#pragma unroll
            for (int nt = 0; nt < NT; ++nt) acc[nt] = __builtin_amdgcn_mfma_f32_16x16x32_f16(af, bf[nt][ks], acc[nt], 0, 0, 0);
        }
#pragma unroll
        for (int nt = 0; nt < NT; ++nt)
#pragma unroll
            for (int e = 0; e < 4; ++e) { const int otok = tile * 16 + fq * 4 + e, n = w * 64 + noff + nt * 16 + fr; float y = acc[nt][e] + bv[nt];
                if (MODE == 0) y = sigm(y) * 0.6065306597126334f; else if (MODE == 1) y = sigm(y);
                outp[(size_t)otok * ldo + n] = (h16)y; }
    }
}
__device__ __forceinline__ void rwkv_pre(Ctx& C) {
    h16* U2 = (h16*)(C.ws + WS_U + 64 * MiB); h16* G = (h16*)(C.ws + WS_MIX) + 512;
    const int j = C.j;
    for (int d = 0; d < 2; ++d) {
        rwkv_lora<2, 0, 4>(C, 1536 + 64 * d, IN(I_RW2) + (size_t)(j * 2 + d) * 64 * 512, IN(I_W0) + (size_t)(j * 2 + d) * 512, U2 + d * 1024, 2048, 0);
        rwkv_lora<2, 1, 4>(C, 1664 + 64 * d, IN(I_A2) + (size_t)(j * 2 + d) * 64 * 512, IN(I_A0) + (size_t)(j * 2 + d) * 512, U2 + d * 1024 + 512, 2048, 0);
    }
    for (int hf = 0; hf < 2; ++hf) rwkv_lora<4, 2, 2>(C, 1792, IN(I_G2) + (size_t)j * 128 * 512, nullptr, G, MIXW, hf * 32);
}
template <int PASS>
__device__ __forceinline__ void rwkv_scan(Ctx& C) {
    const int lane = C.lane, T = C.T, NC = T / CH_R, j = C.j;
    const int nunits = C.nseq * 2 * NC * 8;
    const h16* U = (const h16*)(C.ws + WS_U); const h16* U2 = (const h16*)(C.ws + WS_U + 64 * MiB);
    LAS float* wl = (LAS float*)(C.lds + C.wave * 12288);
    const float* mu0p = IN(I_MU) + (size_t)j * 2 * A_IN, *mu1p = mu0p + A_IN;
    for (int unit = C.gw; unit < nunits; unit += C.ngw) {
        const int hd = unit & 7; int r = unit >> 3; const int c = r % NC; r /= NC; const int dir = r & 1, b = r >> 1;
        const int col = hd * 64 + lane;
        const float m0r = mu0p[col], m1r = mu1p[col], m0k = mu0p[512 + col], m1k = mu1p[512 + col], m0v = mu0p[1024 + col], m1v = mu1p[1024 + col];
        const float kkw = IN(I_KK)[j * 512 + col], kaw = IN(I_KA)[j * 512 + col];
        float* slot = (float*)(C.ws + WS_ST) + (size_t)((((b * 2 + dir) * NC + c) * 8) + hd) * 8192;
        float S[64], P[64];
        if (PASS == 1) {
            int ln = lane; asm volatile("" : "+v"(ln));
#pragma unroll
            for (int q = 0; q < 64; ++q) { S[q] = 0.f; P[q] = (q == ln) ? 1.f : 0.f; }
        } else {
#pragma unroll
            for (int q = 0; q < 16; ++q) { const f32x4 v = *(const f32x4*)(slot + lane * 64 + q * 4); S[4 * q] = v.x; S[4 * q + 1] = v.y; S[4 * q + 2] = v.z; S[4 * q + 3] = v.w; }
        }
        h16* outp = (dir == 0) ? (h16*)(C.ws + WS_MIX) : (h16*)(C.ws + WS_O);
        const int ldo = (dir == 0) ? MIXW : 512;
#pragma unroll 1
        for (int sub = 0; sub < CH_R / SUB; ++sub) {
#pragma unroll 1
            for (int s = 0; s < SUB; ++s) {
                const int p = c * CH_R + sub * SUB + s, t = dir ? T - 1 - p : p; const size_t tok = (size_t)b * T + t;
                const h16* ur = U + tok * LDA_ + col;
                const float rc = (float)ur[0], kc = (float)ur[512], vc = (float)ur[1024];
                float rp = 0.f, kp = 0.f, vp = 0.f, rn = 0.f, kn = 0.f, vn = 0.f;
                if (t > 0) { rp = (float)ur[-LDA_]; kp = (float)ur[512 - LDA_]; vp = (float)ur[1024 - LDA_]; }
                if (t < T - 1) { rn = (float)ur[LDA_]; kn = (float)ur[512 + LDA_]; vn = (float)ur[1024 + LDA_]; }
                const float rr = rc + m0r * (rp - rc) + m1r * (rn - rc), kk_ = kc + m0k * (kp - kc) + m1k * (kn - kc), vv = vc + m0v * (vp - vc) + m1v * (vn - vc);
                const float e = (float)U2[tok * 2048 + dir * 1024 + col], av = (float)U2[tok * 2048 + dir * 1024 + 512 + col];
                const float wdec = __expf(-e);
                const float kx = kk_ * kkw; const float n2 = wave_sum(kx * kx); const float kkn = kx / fmaxf(sqrtf(n2), 1e-12f);
                LAS float* q = wl + s * 384;
                q[lane] = wdec; q[64 + lane] = kkn; q[128 + lane] = kkn * av; q[192 + lane] = kk_ * (1.f + (av - 1.f) * kaw); q[256 + lane] = rr; q[320 + lane] = vv;
            }
            WAVE_SYNC();
#pragma unroll 1
            for (int s = 0; s < SUB; ++s) {
                const LAS f32x4* q = (const LAS f32x4*)(wl + s * 384);
                const float vv = wl[s * 384 + 320 + lane];
                float sa0 = 0.f, sa1 = 0.f, sp0 = 0.f, sp1 = 0.f;
#pragma unroll
                for (int k4 = 0; k4 < 16; ++k4) { const f32x4 kk4 = q[16 + k4];
                    sa0 += S[4 * k4] * kk4.x + S[4 * k4 + 2] * kk4.z; sa1 += S[4 * k4 + 1] * kk4.y + S[4 * k4 + 3] * kk4.w;
                    if (PASS == 1) { sp0 += P[4 * k4] * kk4.x + P[4 * k4 + 2] * kk4.z; sp1 += P[4 * k4 + 1] * kk4.y + P[4 * k4 + 3] * kk4.w; }
                    if ((k4 & 3) == 3) __builtin_amdgcn_sched_barrier(0); }
                const float sa = -(sa0 + sa1), sp = -(sp0 + sp1);
                float o0 = 0.f, o1 = 0.f;
#pragma unroll
                for (int k4 = 0; k4 < 16; ++k4) { const f32x4 w4 = q[k4], b4 = q[32 + k4], d4 = q[48 + k4];
                    S[4 * k4] = S[4 * k4] * w4.x + sa * b4.x + vv * d4.x; S[4 * k4 + 1] = S[4 * k4 + 1] * w4.y + sa * b4.y + vv * d4.y;
                    S[4 * k4 + 2] = S[4 * k4 + 2] * w4.z + sa * b4.z + vv * d4.z; S[4 * k4 + 3] = S[4 * k4 + 3] * w4.w + sa * b4.w + vv * d4.w;
                    if (PASS == 1) { P[4 * k4] = P[4 * k4] * w4.x + sp * b4.x; P[4 * k4 + 1] = P[4 * k4 + 1] * w4.y + sp * b4.y; P[4 * k4 + 2] = P[4 * k4 + 2] * w4.z + sp * b4.z; P[4 * k4 + 3] = P[4 * k4 + 3] * w4.w + sp * b4.w; }
                    else { const f32x4 r4 = q[64 + k4]; o0 += S[4 * k4] * r4.x + S[4 * k4 + 2] * r4.z; o1 += S[4 * k4 + 1] * r4.y + S[4 * k4 + 3] * r4.w; }
                    if ((k4 & 1) == 1) __builtin_amdgcn_sched_barrier(0); }
                if (PASS == 2) { const int p = c * CH_R + sub * SUB + s, t = dir ? T - 1 - p : p; outp[((size_t)b * T + t) * ldo + col] = (h16)(o0 + o1); }
            }
            WAVE_SYNC();
        }
        if (PASS == 1) {
#pragma unroll
            for (int q = 0; q < 16; ++q) { *(f32x4*)(slot + lane * 64 + q * 4) = (f32x4){S[4 * q], S[4 * q + 1], S[4 * q + 2], S[4 * q + 3]};
                *(f32x4*)(slot + 4096 + lane * 64 + q * 4) = (f32x4){P[4 * q], P[4 * q + 1], P[4 * q + 2], P[4 * q + 3]}; }
        }
    }
}
__device__ __forceinline__ void rwkv_cross(Ctx& C) {
    const int T = C.T, NC = T / CH_R, nchains = C.nseq * 16, tid = C.tid;
    LAS float* Cs = (LAS float*)C.lds; LAS float* Ps = Cs + 64 * 65;
    const int i = tid >> 3, jg = tid & 7;
    for (int chain = blockIdx.x; chain < nchains; chain += gridDim.x) {
        const int hd = chain & 7, dir = (chain >> 3) & 1, b = chain >> 4;
        float cr[8];
#pragma unroll
        for (int k = 0; k < 8; ++k) cr[k] = 0.f;
        for (int c = 0; c < NC; ++c) {
            float* base = (float*)(C.ws + WS_ST) + (size_t)((((b * 2 + dir) * NC + c) * 8) + hd) * 8192;
            const f32x4 s0 = *(const f32x4*)(base + i * 64 + jg * 8), s1 = *(const f32x4*)(base + i * 64 + jg * 8 + 4);
            const f32x4 p0 = *(const f32x4*)(base + 4096 + tid * 8), p1 = *(const f32x4*)(base + 4096 + tid * 8 + 4);
            *(LAS f32x4*)(Ps + tid * 8) = p0; *(LAS f32x4*)(Ps + tid * 8 + 4) = p1;
#pragma unroll
            for (int k = 0; k < 8; ++k) Cs[i * 65 + jg * 8 + k] = cr[k];
            *(f32x4*)(base + i * 64 + jg * 8) = (f32x4){cr[0], cr[1], cr[2], cr[3]}; *(f32x4*)(base + i * 64 + jg * 8 + 4) = (f32x4){cr[4], cr[5], cr[6], cr[7]};
            __syncthreads();
            float nr[8] = {s0.x, s0.y, s0.z, s0.w, s1.x, s1.y, s1.z, s1.w};
#pragma unroll 8
            for (int m = 0; m < 64; ++m) { const float cm = Cs[i * 65 + m]; const f32x4 a0 = *(const LAS f32x4*)(Ps + m * 64 + jg * 8), a1 = *(const LAS f32x4*)(Ps + m * 64 + jg * 8 + 4);
                nr[0] += cm * a0.x; nr[1] += cm * a0.y; nr[2] += cm * a0.z; nr[3] += cm * a0.w; nr[4] += cm * a1.x; nr[5] += cm * a1.y; nr[6] += cm * a1.z; nr[7] += cm * a1.w; }
            __syncthreads();
#pragma unroll
            for (int k = 0; k < 8; ++k) cr[k] = nr[k];
        }
    }
}
__device__ __forceinline__ void rwkv_final(Ctx& C) {
    const int lane = C.lane, T = C.T, j = C.j, c0 = lane * 8;
    const h16* U = (const h16*)(C.ws + WS_U); h16* MIX = (h16*)(C.ws + WS_MIX); const h16* O = (const h16*)(C.ws + WS_O);
    const float* mu0p = IN(I_MU) + (size_t)j * 2 * A_IN, *mu1p = mu0p + A_IN;
    for (int tok = C.gw; tok < MG; tok += C.ngw) {
        const int t = tok % T;
        const h16x8 of = *(const h16x8*)(MIX + (size_t)tok * MIXW + c0), ob = *(const h16x8*)(O + (size_t)tok * 512 + c0), gg = *(const h16x8*)(MIX + (size_t)tok * MIXW + 512 + c0);
        float o[8], s = 0.f;
#pragma unroll
        for (int e = 0; e < 8; ++e) { o[e] = (float)of[e] + (float)ob[e]; s += o[e]; }
        s += __shfl_xor(s, 1); s += __shfl_xor(s, 2); s += __shfl_xor(s, 4);
        const float mean = s * (1.f / 64.f); float v2 = 0.f;
#pragma unroll
        for (int e = 0; e < 8; ++e) { o[e] -= mean; v2 += o[e] * o[e]; }
        v2 += __shfl_xor(v2, 1); v2 += __shfl_xor(v2, 2); v2 += __shfl_xor(v2, 4);
        const float rstd = rsqrtf(v2 * (1.f / 64.f) + 64e-5f);
        float rv[3][8];
#pragma unroll
        for (int part = 0; part < 3; ++part) {
            const h16* up = U + (size_t)tok * LDA_ + part * 512 + c0;
            const h16x8 cur = *(const h16x8*)up; h16x8 prv, nxt;
#pragma unroll
            for (int e = 0; e < 8; ++e) { prv[e] = (h16)0.f; nxt[e] = (h16)0.f; }
            if (t > 0) prv = *(const h16x8*)(up - LDA_);
            if (t < T - 1) nxt = *(const h16x8*)(up + LDA_);
#pragma unroll
            for (int e = 0; e < 8; ++e) { const float x = (float)cur[e]; rv[part][e] = x + mu0p[part * 512 + c0 + e] * ((float)prv[e] - x) + mu1p[part * 512 + c0 + e] * ((float)nxt[e] - x); }
        }
        float rk = 0.f;
#pragma unroll
        for (int e = 0; e < 8; ++e) rk += rv[0][e] * rv[1][e] * IN(I_RK)[j * 512 + c0 + e];
        rk += __shfl_xor(rk, 1); rk += __shfl_xor(rk, 2); rk += __shfl_xor(rk, 4);
        h16x8 w;
#pragma unroll
        for (int e = 0; e < 8; ++e) { const float y = o[e] * rstd * IN(I_GNW)[j * 512 + c0 + e] + IN(I_GNB)[j * 512 + c0 + e]; w[e] = (h16)((y + rk * rv[2][e]) * (float)gg[e]); }
        *(h16x8*)(MIX + (size_t)tok * MIXW + c0) = w;
    }
}

enum { MX_MAMBA = 0, MX_HGRN = 1, MX_RET = 2 };
template <int MX> struct MXC;
template <> struct MXC<MX_MAMBA> { static constexpr int CH = CH_M, NH = 16, LDU = LDB_; };
template <> struct MXC<MX_HGRN>  { static constexpr int CH = CH_H, NH = 8,  LDU = LDC_; };
template <> struct MXC<MX_RET>   { static constexpr int CH = CH_T, NH = 16, LDU = LDD_; };

__device__ __forceinline__ float ret_gamma(Ctx& C, int dir, int head) { return __expf(-__expf(IN(I_RETLD)[(C.j * 2 + dir) * 4 + head])); }

__device__ __forceinline__ void mamba_pre(Ctx& C) {
    const int T = C.T, j = C.j;
    const h16* U = (const h16*)(C.ws + WS_U); h16* BC = (h16*)(C.ws + WS_U + 88 * MiB); float* DT = (float*)(C.ws + WS_U + 104 * MiB);
    const float* cw = IN(I_CONVW) + (size_t)j * 4 * 1536; const float* cb = IN(I_CONVB) + (size_t)j * 1536;
    for (int idx = C.gtid; idx < MG * 64; idx += C.ngt) {
        const int tok = idx >> 6, q = idx & 63, t = tok % T, c = 1024 + q * 8;
        float acc[8];
#pragma unroll
        for (int e = 0; e < 8; ++e) acc[e] = cb[c + e];
#pragma unroll
        for (int jj = 0; jj < 4; ++jj) { const int tt = t + jj - 2;
            if (tt >= 0 && tt < T) { const h16x8 x = *(const h16x8*)(U + (size_t)(tok + jj - 2) * LDB_ + 1024 + c);
#pragma unroll
                for (int e = 0; e < 8; ++e) acc[e] += cw[jj * 1536 + c + e] * (float)x[e]; } }
        h16x8 w;
#pragma unroll
        for (int e = 0; e < 8; ++e) w[e] = (h16)silu(acc[e]);
        *(h16x8*)(BC + (size_t)tok * 512 + q * 8) = w;
        if (q < 32) { const float x = (float)U[(size_t)tok * LDB_ + 2560 + q] + IN(I_DTB)[j * 32 + q];
            const float dt = (x > 20.f) ? x : log1pf(expf(x)); const float da = -dt * expf(IN(I_ALOG)[j * 32 + q]);
            DT[(size_t)tok * 64 + q] = dt; DT[(size_t)tok * 64 + 32 + q] = expf(da); }
    }
}

template <int MX, int PASS>
__device__ __forceinline__ void diag_scan(Ctx& C) {
    constexpr int CH = MXC<MX>::CH, NH = MXC<MX>::NH, LDU = MXC<MX>::LDU;
    const int lane = C.lane, T = C.T, NC = T / CH, j = C.j;
    const int nunits = C.nseq * 2 * NC * NH;
    const h16* U = (const h16*)(C.ws + WS_U);
    const h16* BC = (const h16*)(C.ws + WS_U + 88 * MiB); const float* DT = (const float*)(C.ws + WS_U + 104 * MiB);
    const float* ROT = (const float*)(C.ws + WS_ROT);
    float* DEC = (float*)(C.ws + WS_DEC);
    LAS float* wl = (LAS float*)(C.lds + C.wave * 12288);
    for (int unit = C.gw; unit < nunits; unit += C.ngw) {
        const int hd = unit % NH; int r = unit / NH; const int c = r % NC; r /= NC; const int dir = r & 1, b = r >> 1;
        const int slotid = ((b * 2 + dir) * NC + c) * NH + hd;
        float* slot = (float*)(C.ws + WS_ST) + (size_t)slotid * 8192;
        float S[128];
        if (PASS == 1) {
#pragma unroll
            for (int q = 0; q < 128; ++q) S[q] = 0.f;
        } else {
#pragma unroll
            for (int q = 0; q < 128; ++q) S[q] = slot[q * 64 + lane];
        }
        float k0 = 0.f, k1 = 0.f, k2 = 0.f, k3 = 0.f, k4c = 0.f, gam = 1.f, dprod = 1.f, D0 = 1.f, D1 = 1.f;
        h16* outp; int ldo, ocol;
        if (MX == MX_MAMBA) { const int cc = hd * 64 + lane; const float* cw = IN(I_CONVW) + (size_t)j * 4 * 1536; k0 = cw[cc]; k1 = cw[1536 + cc]; k2 = cw[2 * 1536 + cc]; k3 = cw[3 * 1536 + cc]; k4c = IN(I_CONVB)[j * 1536 + cc];
            ocol = hd * 64 + lane; if (dir == 0) { outp = (h16*)(C.ws + WS_MIX) + 512; ldo = MIXW; } else { outp = (h16*)(C.ws + WS_O); ldo = 1024; } }
        else if (MX == MX_HGRN) {
            if (j == 1) { const float* lb = IN(I_HGLB); const int f0 = hd * 128 + lane;
                k0 = sigm(lb[(dir * 2 + 1) * 1024 + f0] - lb[(dir * 2 + 0) * 1024 + f0]); k1 = sigm(lb[(dir * 2 + 1) * 1024 + f0 + 64] - lb[(dir * 2 + 0) * 1024 + f0 + 64]); }
            ocol = hd * 64 + lane; if (dir == 0) { outp = (h16*)(C.ws + WS_MIX); ldo = MIXW; } else { outp = (h16*)(C.ws + WS_O); ldo = 512; } }
        else { gam = ret_gamma(C, dir, hd >> 2);
            ocol = hd * 64 + lane; if (dir == 0) { outp = (h16*)(C.ws + WS_MIX) + 512; ldo = MIXW; } else { outp = (h16*)(C.ws + WS_O); ldo = 1024; } }
#pragma unroll 1
        for (int sub = 0; sub < CH / SUB; ++sub) {
#pragma unroll
            for (int s = 0; s < SUB; ++s) {
                const int p = c * CH + sub * SUB + s, t = dir ? T - 1 - p : p; const size_t tok = (size_t)b * T + t;
                const h16* ur = U + tok * LDU;
                LAS float* q = wl + s * 384;
                if (MX == MX_MAMBA) {
                    const int g = hd >> 3; const h16* bc = BC + tok * 512 + g * 128 + lane;
                    q[lane] = (float)bc[0]; q[64 + lane] = (float)bc[64];
                    if (PASS == 2) { q[128 + lane] = (float)bc[256]; q[192 + lane] = (float)bc[320]; }
                    const h16* xp = ur + 1024 + hd * 64 + lane;
                    float acc = k4c + k2 * (float)xp[0];
                    if (t >= 2) acc += k0 * (float)xp[-2 * LDU];
                    if (t >= 1) acc += k1 * (float)xp[-LDU];
                    if (t < T - 1) acc += k3 * (float)xp[LDU];
                    const float dt = DT[tok * 64 + dir * 16 + hd], dA = DT[tok * 64 + 32 + dir * 16 + hd];
                    q[256 + lane] = silu(acc) * dt; q[320] = dA; dprod *= dA;
                } else if (MX == MX_HGRN) {
                    const h16* fp = ur + 1024 + dir * 1024 + hd * 128 + lane;
                    const float f0 = k0 + (1.f - k0) * sigm((float)fp[0]), f1 = k1 + (1.f - k1) * sigm((float)fp[64]);
                    q[lane] = f0; q[64 + lane] = f1; D0 *= f0; D1 *= f1;
                    if (PASS == 2) { q[128 + lane] = (float)ur[hd * 128 + lane]; q[192 + lane] = (float)ur[hd * 128 + 64 + lane]; }
                    q[256 + lane] = (float)ur[3072 + hd * 64 + lane];
                } else {
                    const int h = hd >> 2; const float cs = ROT[t * 128 + lane], sn = ROT[t * 128 + 64 + lane];
                    const float x1 = (float)ur[512 + h * 128 + lane], x2 = (float)ur[512 + h * 128 + 64 + lane];
                    q[lane] = (x1 * cs - x2 * sn) * 0.08838834764831845f; q[64 + lane] = (x2 * cs + x1 * sn) * 0.08838834764831845f;
                    if (PASS == 2) { const float y1 = (float)ur[h * 128 + lane], y2 = (float)ur[h * 128 + 64 + lane]; q[128 + lane] = y1 * cs - y2 * sn; q[192 + lane] = y2 * cs + y1 * sn; }
                    q[256 + lane] = (float)ur[1024 + hd * 64 + lane];
                }
            }
            WAVE_SYNC();
#pragma unroll 1
            for (int s = 0; s < SUB; ++s) {
                const LAS f32x4* q = (const LAS f32x4*)(wl + s * 384);
                const float vv = wl[s * 384 + 256 + lane];
                const float dec = (MX == MX_MAMBA) ? wl[s * 384 + 320] : gam;
                float o0 = 0.f, o1 = 0.f, o2 = 0.f, o3 = 0.f;
#pragma unroll
                for (int k4 = 0; k4 < 32; ++k4) { const f32x4 a4 = q[k4];
                    if (MX == MX_HGRN) { S[4 * k4] = a4.x * (S[4 * k4] - vv) + vv; S[4 * k4 + 1] = a4.y * (S[4 * k4 + 1] - vv) + vv; S[4 * k4 + 2] = a4.z * (S[4 * k4 + 2] - vv) + vv; S[4 * k4 + 3] = a4.w * (S[4 * k4 + 3] - vv) + vv; }
                    else { S[4 * k4] = S[4 * k4] * dec + a4.x * vv; S[4 * k4 + 1] = S[4 * k4 + 1] * dec + a4.y * vv; S[4 * k4 + 2] = S[4 * k4 + 2] * dec + a4.z * vv; S[4 * k4 + 3] = S[4 * k4 + 3] * dec + a4.w * vv; }
                    if (PASS == 2) { const f32x4 q4 = q[32 + k4]; o0 += S[4 * k4] * q4.x; o1 += S[4 * k4 + 1] * q4.y; o2 += S[4 * k4 + 2] * q4.z; o3 += S[4 * k4 + 3] * q4.w; } }
                if (PASS == 2) { const int p = c * CH + sub * SUB + s, t = dir ? T - 1 - p : p; outp[((size_t)b * T + t) * ldo + ocol] = (h16)((o0 + o1) + (o2 + o3)); }
            }
            WAVE_SYNC();
        }
        if (PASS == 1) {
#pragma unroll
            for (int q = 0; q < 128; ++q) slot[q * 64 + lane] = S[q];
            if (MX == MX_MAMBA) { if (lane == 0) DEC[slotid] = dprod; }
            if (MX == MX_HGRN) { DEC[(size_t)slotid * 128 + lane] = D0; DEC[(size_t)slotid * 128 + 64 + lane] = D1; }
        }
    }
}
template <int MX>
__device__ __forceinline__ void diag_cross(Ctx& C) {
    constexpr int CH = MXC<MX>::CH, NH = MXC<MX>::NH;
    const int T = C.T, NC = T / CH, nchains = C.nseq * 2 * NH;
    const float* DEC = (const float*)(C.ws + WS_DEC);
    for (int idx = C.gtid; idx < nchains * 8192; idx += C.ngt) {
        const int chain = idx >> 13, e = idx & 8191, hd = chain % NH; int r = chain / NH; const int dir = r & 1, b = r >> 1;
        float gch = 1.f;
        if (MX == MX_RET) { const float lg = -__expf(IN(I_RETLD)[(C.j * 2 + dir) * 4 + (hd >> 2)]); gch = __expf(lg * (float)CH); }
        float carry = 0.f;
#pragma unroll 4
        for (int c = 0; c < NC; ++c) {
            const int slotid = ((b * 2 + dir) * NC + c) * NH + hd;
            float* p = (float*)(C.ws + WS_ST) + (size_t)slotid * 8192 + e;
            const float sl = *p; *p = carry;
            const float d = (MX == MX_HGRN) ? DEC[(size_t)slotid * 128 + (e >> 6)] : (MX == MX_MAMBA) ? DEC[slotid] : gch;
            carry = d * carry + sl;
        }
    }
}

constexpr int RQ_OFF = 0, RK_OFF = 17408, RV_OFF = 36864, RM_OFF = 73728;
__device__ __forceinline__ void ret_stage_qk(Ctx& C, LAS h16* dst, bool transposed, int colbase, float scale, float lg2, int wbase, int b, int dir, int p0) {
    const int T = C.T, m = C.tid >> 3, i0 = (C.tid & 7) * 8;
    const int p = p0 + m, t = dir ? T - 1 - p : p; const size_t tok = (size_t)b * T + t;
    const h16* U = (const h16*)(C.ws + WS_U); const float* ROT = (const float*)(C.ws + WS_ROT);
    const h16x8 x1 = *(const h16x8*)(U + tok * LDD_ + colbase + i0), x2 = *(const h16x8*)(U + tok * LDD_ + colbase + 64 + i0);
    const f32x4 c0 = *(const f32x4*)(ROT + t * 128 + i0), c1 = *(const f32x4*)(ROT + t * 128 + i0 + 4), s0 = *(const f32x4*)(ROT + t * 128 + 64 + i0), s1 = *(const f32x4*)(ROT + t * 128 + 64 + i0 + 4);
    const float cs[8] = {c0.x, c0.y, c0.z, c0.w, c1.x, c1.y, c1.z, c1.w}, sn[8] = {s0.x, s0.y, s0.z, s0.w, s1.x, s1.y, s1.z, s1.w};
    const float sc = transposed ? scale * exp2f((float)(wbase - m) * lg2) : scale;
    h16x8 y1, y2;
#pragma unroll
    for (int e = 0; e < 8; ++e) { const float a = (float)x1[e], bb = (float)x2[e]; y1[e] = (h16)((a * cs[e] - bb * sn[e]) * sc); y2[e] = (h16)((bb * cs[e] + a * sn[e]) * sc); }
    if (!transposed) { *(LAS h16x8*)(dst + m * 136 + i0) = y1; *(LAS h16x8*)(dst + m * 136 + 64 + i0) = y2; }
    else {
#pragma unroll
        for (int e = 0; e < 8; ++e) { dst[(i0 + e) * 72 + m] = y1[e]; dst[(64 + i0 + e) * 72 + m] = y2[e]; } }
}
__device__ __forceinline__ void ret_stage_vt(Ctx& C, LAS h16* Vt, int h, int b, int dir, int p0) {
    const int T = C.T; const h16* U = (const h16*)(C.ws + WS_U);
#pragma unroll
    for (int q = 0; q < 4; ++q) { const int it = C.tid + 512 * q, m = it >> 5, cb = it & 31;
        const int p = p0 + m, t = dir ? T - 1 - p : p; const size_t tok = (size_t)b * T + t;
        const h16x8 x = *(const h16x8*)(U + tok * LDD_ + 1024 + h * 256 + cb * 8);
#pragma unroll
        for (int e = 0; e < 8; ++e) Vt[(cb * 8 + e) * 72 + m] = x[e]; }
}
__device__ __forceinline__ void ret_mfma_pass1(Ctx& C) {
    const int T = C.T, NCH = T / 256, nunits = C.nseq * 2 * NCH * 4, lane = C.lane, w = C.wave, fr = lane & 15, fq = lane >> 4;
    LAS h16* Kt = (LAS h16*)(C.lds + RK_OFF); LAS h16* Vt = (LAS h16*)(C.lds + RV_OFF);
    for (int unit = blockIdx.x; unit < nunits; unit += gridDim.x) {
        const int h = unit & 3; int r = unit >> 2; const int c = r % NCH; r /= NCH; const int dir = r & 1, b = r >> 1;
        const float lg2 = -__expf(IN(I_RETLD)[(C.j * 2 + dir) * 4 + h]) * 1.4426950408889634f;
        f32x4 acc[8][2];
#pragma unroll
        for (int mt = 0; mt < 8; ++mt) { acc[mt][0] = (f32x4){0.f, 0.f, 0.f, 0.f}; acc[mt][1] = (f32x4){0.f, 0.f, 0.f, 0.f}; }
#pragma unroll 1
        for (int jb = 0; jb < 4; ++jb) {
            __syncthreads();
            ret_stage_qk(C, Kt, true, 512 + h * 128, 0.08838834764831845f, lg2, 255 - 64 * jb, b, dir, c * 256 + 64 * jb);
            ret_stage_vt(C, Vt, h, b, dir, c * 256 + 64 * jb);
            __syncthreads();
#pragma unroll
            for (int ks = 0; ks < 2; ++ks) {
                const h16x8 b0 = *(const LAS h16x8*)(Vt + (32 * w + fr) * 72 + ks * 32 + fq * 8), b1 = *(const LAS h16x8*)(Vt + (32 * w + 16 + fr) * 72 + ks * 32 + fq * 8);
#pragma unroll
                for (int mt = 0; mt < 8; ++mt) { const h16x8 a = *(const LAS h16x8*)(Kt + (16 * mt + fr) * 72 + ks * 32 + fq * 8);
                    acc[mt][0] = __builtin_amdgcn_mfma_f32_16x16x32_f16(a, b0, acc[mt][0], 0, 0, 0); acc[mt][1] = __builtin_amdgcn_mfma_f32_16x16x32_f16(a, b1, acc[mt][1], 0, 0, 0); }
            }
        }
        float* Sg = (float*)(C.ws + WS_ST) + (size_t)unit * 32768;
#pragma unroll
        for (int mt = 0; mt < 8; ++mt)
#pragma unroll
            for (int nt = 0; nt < 2; ++nt) *(f32x4*)(Sg + (size_t)(32 * w + 16 * nt + fr) * 128 + 16 * mt + fq * 4) = acc[mt][nt];
    }
}
__device__ __forceinline__ void ret_mfma_cross(Ctx& C) {
    const int T = C.T, NCH = T / 256, nchains = C.nseq * 2 * 4;
    for (int idx = C.gtid; idx < nchains * 32768; idx += C.ngt) {
        const int chain = idx >> 15, e = idx & 32767, h = chain & 3, dir = (chain >> 2) & 1, b = chain >> 3;
        const float gch = __expf(-__expf(IN(I_RETLD)[(C.j * 2 + dir) * 4 + h]) * 256.f);
        float carry = 0.f;
#pragma unroll 4
        for (int c = 0; c < NCH; ++c) { float* p = (float*)(C.ws + WS_ST) + (size_t)((((b * 2 + dir) * NCH + c) * 4) + h) * 32768 + e; const float sl = *p; *p = carry; carry = gch * carry + sl; }
    }
}
__device__ __forceinline__ void ret_mfma_pass2(Ctx& C) {
    const int T = C.T, NCH = T / 256, nunits = C.nseq * 2 * NCH * 4, lane = C.lane, w = C.wave, fr = lane & 15, fq = lane >> 4;
    LAS h16* Qs = (LAS h16*)(C.lds + RQ_OFF); LAS h16* Ks = (LAS h16*)(C.lds + RK_OFF); LAS h16* Vt = (LAS h16*)(C.lds + RV_OFF); LAS h16* Ms = (LAS h16*)(C.lds + RM_OFF);
    for (int unit = blockIdx.x; unit < nunits; unit += gridDim.x) {
        const int h = unit & 3; int r = unit >> 2; const int c = r % NCH; r /= NCH; const int dir = r & 1, b = r >> 1;
        const float lg2 = -__expf(IN(I_RETLD)[(C.j * 2 + dir) * 4 + h]) * 1.4426950408889634f;
        const float* Sg = (const float*)(C.ws + WS_ST) + (size_t)unit * 32768;
        h16x8 sf[2][4];
#pragma unroll
        for (int nt = 0; nt < 2; ++nt)
#pragma unroll
            for (int ks = 0; ks < 4; ++ks) { const float* p = Sg + (size_t)(32 * w + 16 * nt + fr) * 128 + ks * 32 + fq * 8; const f32x4 a = *(const f32x4*)p, bb = *(const f32x4*)(p + 4);
                sf[nt][ks][0] = (h16)a.x; sf[nt][ks][1] = (h16)a.y; sf[nt][ks][2] = (h16)a.z; sf[nt][ks][3] = (h16)a.w; sf[nt][ks][4] = (h16)bb.x; sf[nt][ks][5] = (h16)bb.y; sf[nt][ks][6] = (h16)bb.z; sf[nt][ks][7] = (h16)bb.w; }
        h16* outp; int ldo; if (dir == 0) { outp = (h16*)(C.ws + WS_MIX) + 512; ldo = MIXW; } else { outp = (h16*)(C.ws + WS_O); ldo = 1024; }
#pragma unroll 1
        for (int ib = 0; ib < 4; ++ib) {
            f32x4 acc[4][2];
#pragma unroll
            for (int mt = 0; mt < 4; ++mt) { acc[mt][0] = (f32x4){0.f, 0.f, 0.f, 0.f}; acc[mt][1] = (f32x4){0.f, 0.f, 0.f, 0.f}; }
#pragma unroll 1
            for (int jb = 0; jb <= ib; ++jb) {
                __syncthreads();
                if (jb == 0) ret_stage_qk(C, Qs, false, h * 128, 1.f, lg2, 0, b, dir, c * 256 + 64 * ib);
                ret_stage_qk(C, Ks, false, 512 + h * 128, 0.08838834764831845f, lg2, 0, b, dir, c * 256 + 64 * jb);
                ret_stage_vt(C, Vt, h, b, dir, c * 256 + 64 * jb);
                __syncthreads();
                {
                    const int gm = w >> 1, gn = w & 1;
                    f32x4 g0 = (f32x4){0.f, 0.f, 0.f, 0.f}, g1 = (f32x4){0.f, 0.f, 0.f, 0.f};
#pragma unroll
                    for (int ks = 0; ks < 4; ++ks) { const h16x8 a = *(const LAS h16x8*)(Qs + (16 * gm + fr) * 136 + ks * 32 + fq * 8);
                        const h16x8 k0 = *(const LAS h16x8*)(Ks + (32 * gn + fr) * 136 + ks * 32 + fq * 8), k1 = *(const LAS h16x8*)(Ks + (32 * gn + 16 + fr) * 136 + ks * 32 + fq * 8);
                        g0 = __builtin_amdgcn_mfma_f32_16x16x32_f16(a, k0, g0, 0, 0, 0); g1 = __builtin_amdgcn_mfma_f32_16x16x32_f16(a, k1, g1, 0, 0, 0); }
#pragma unroll
                    for (int jj = 0; jj < 4; ++jj) { const int l = 16 * gm + fq * 4 + jj, Lg = 64 * ib + l;
                        const int m0 = 32 * gn + fr, M0 = 64 * jb + m0, M1 = M0 + 16;
                        Ms[l * 72 + m0] = (h16)((M0 <= Lg) ? g0[jj] * exp2f((float)(Lg - M0) * lg2) : 0.f);
                        Ms[l * 72 + m0 + 16] = (h16)((M1 <= Lg) ? g1[jj] * exp2f((float)(Lg - M1) * lg2) : 0.f); }
                }
                __syncthreads();
#pragma unroll
                for (int ks = 0; ks < 2; ++ks) {
                    const h16x8 b0 = *(const LAS h16x8*)(Vt + (32 * w + fr) * 72 + ks * 32 + fq * 8), b1 = *(const LAS h16x8*)(Vt + (32 * w + 16 + fr) * 72 + ks * 32 + fq * 8);
#pragma unroll
                    for (int mt = 0; mt < 4; ++mt) { const h16x8 a = *(const LAS h16x8*)(Ms + (16 * mt + fr) * 72 + ks * 32 + fq * 8);
                        acc[mt][0] = __builtin_amdgcn_mfma_f32_16x16x32_f16(a, b0, acc[mt][0], 0, 0, 0); acc[mt][1] = __builtin_amdgcn_mfma_f32_16x16x32_f16(a, b1, acc[mt][1], 0, 0, 0); }
                }
            }
            f32x4 ac2[4][2];
#pragma unroll
            for (int mt = 0; mt < 4; ++mt) { ac2[mt][0] = (f32x4){0.f, 0.f, 0.f, 0.f}; ac2[mt][1] = (f32x4){0.f, 0.f, 0.f, 0.f}; }
#pragma unroll
            for (int ks = 0; ks < 4; ++ks)
#pragma unroll
                for (int mt = 0; mt < 4; ++mt) { const h16x8 a = *(const LAS h16x8*)(Qs + (16 * mt + fr) * 136 + ks * 32 + fq * 8);
                    ac2[mt][0] = __builtin_amdgcn_mfma_f32_16x16x32_f16(a, sf[0][ks], ac2[mt][0], 0, 0, 0); ac2[mt][1] = __builtin_amdgcn_mfma_f32_16x16x32_f16(a, sf[1][ks], ac2[mt][1], 0, 0, 0); }
#pragma unroll
            for (int mt = 0; mt < 4; ++mt)
#pragma unroll
                for (int jj = 0; jj < 4; ++jj) { const int Lg = 64 * ib + 16 * mt + fq * 4 + jj; const float rs = exp2f((float)(Lg + 1) * lg2);
                    const int p = c * 256 + Lg, t = dir ? T - 1 - p : p; h16* op = outp + ((size_t)b * T + t) * ldo + h * 256 + 32 * w + fr;
                    op[0] = (h16)(acc[mt][0][jj] + ac2[mt][0][jj] * rs); op[16] = (h16)(acc[mt][1][jj] + ac2[mt][1][jj] * rs); }
        }
    }
}
__device__ __forceinline__ void mamba_final(Ctx& C) {
    const int lane = C.lane, T = C.T, j = C.j, c0 = lane * 16;
    const h16* U = (const h16*)(C.ws + WS_U); h16* MIX = (h16*)(C.ws + WS_MIX); const h16* O = (const h16*)(C.ws + WS_O);
    const float* cw = IN(I_CONVW) + (size_t)j * 4 * 1536; const float* cb = IN(I_CONVB) + (size_t)j * 1536;
    const float dsk = IN(I_SSMD)[j * 16 + (lane >> 2)];
    for (int tok = C.gw; tok < MG; tok += C.ngw) {
        const int t = tok % T;
        float y[16]; float ss = 0.f;
#pragma unroll
        for (int hf = 0; hf < 2; ++hf) {
            const int c = c0 + hf * 8;
            float acc[8];
#pragma unroll
            for (int e = 0; e < 8; ++e) acc[e] = cb[c + e];
#pragma unroll
            for (int jj = 0; jj < 4; ++jj) { const int tt = t + jj - 2;
                if (tt >= 0 && tt < T) { const h16x8 x = *(const h16x8*)(U + (size_t)(tok + jj - 2) * LDB_ + 1024 + c);
#pragma unroll
                    for (int e = 0; e < 8; ++e) acc[e] += cw[jj * 1536 + c + e] * (float)x[e]; } }
            const h16x8 yf = *(const h16x8*)(MIX + (size_t)tok * MIXW + 512 + c), yb = *(const h16x8*)(O + (size_t)tok * 1024 + c), z = *(const h16x8*)(U + (size_t)tok * LDB_ + c);
#pragma unroll
            for (int e = 0; e < 8; ++e) { const float v = ((float)yf[e] + (float)yb[e] + silu(acc[e]) * dsk) * silu((float)z[e]); y[hf * 8 + e] = v; ss += v * v; }
        }
#pragma unroll
        for (int o = 1; o < 32; o <<= 1) ss += __shfl_xor(ss, o);
        const float rstd = rsqrtf(ss * (1.f / 512.f) + 1e-5f);
#pragma unroll
        for (int hf = 0; hf < 2; ++hf) { h16x8 w;
#pragma unroll
            for (int e = 0; e < 8; ++e) w[e] = (h16)(y[hf * 8 + e] * rstd * IN(I_SSMNW)[j * 1024 + c0 + hf * 8 + e]);
            *(h16x8*)(MIX + (size_t)tok * MIXW + 512 + c0 + hf * 8) = w; }
    }
}
__device__ __forceinline__ void hgrn_final(Ctx& C) {
    const int lane = C.lane, j = C.j, c0 = lane * 8;
    const h16* U = (const h16*)(C.ws + WS_U); h16* MIX = (h16*)(C.ws + WS_MIX); const h16* O = (const h16*)(C.ws + WS_O);
    for (int tok = C.gw; tok < MG; tok += C.ngw) {
        const h16x8 of = *(const h16x8*)(MIX + (size_t)tok * MIXW + c0), ob = *(const h16x8*)(O + (size_t)tok * 512 + c0), gg = *(const h16x8*)(U + (size_t)tok * LDC_ + 3584 + c0);
        float o[8], ss = 0.f;
#pragma unroll
        for (int e = 0; e < 8; ++e) { o[e] = (float)of[e] + (float)ob[e]; ss += o[e] * o[e]; }
        ss += __shfl_xor(ss, 1); ss += __shfl_xor(ss, 2); ss += __shfl_xor(ss, 4);
        const float rstd = rsqrtf(ss * (1.f / 64.f) + 1e-5f);
        h16x8 w;
#pragma unroll
        for (int e = 0; e < 8; ++e) w[e] = (h16)(o[e] * rstd * IN(I_HGNW)[j * 512 + c0 + e] * sigm((float)gg[e]));
        *(h16x8*)(MIX + (size_t)tok * MIXW + c0) = w;
    }
}
__device__ __forceinline__ void ret_final(Ctx& C) {
    const int lane = C.lane, j = C.j, c0 = lane * 16;
    const h16* U = (const h16*)(C.ws + WS_U); h16* MIX = (h16*)(C.ws + WS_MIX); const h16* O = (const h16*)(C.ws + WS_O);
    for (int tok = C.gw; tok < MG; tok += C.ngw) {
        float o[16], s = 0.f;
#pragma unroll
        for (int hf = 0; hf < 2; ++hf) { const h16x8 of = *(const h16x8*)(MIX + (size_t)tok * MIXW + 512 + c0 + hf * 8), ob = *(const h16x8*)(O + (size_t)tok * 1024 + c0 + hf * 8);
#pragma unroll
            for (int e = 0; e < 8; ++e) { o[hf * 8 + e] = (float)of[e] + (float)ob[e]; s += o[hf * 8 + e]; } }
#pragma unroll
        for (int q = 1; q < 16; q <<= 1) s += __shfl_xor(s, q);
        const float mean = s * (1.f / 256.f); float v2 = 0.f;
#pragma unroll
        for (int e = 0; e < 16; ++e) { o[e] -= mean; v2 += o[e] * o[e]; }
#pragma unroll
        for (int q = 1; q < 16; q <<= 1) v2 += __shfl_xor(v2, q);
        const float rstd = rsqrtf(v2 * (1.f / 256.f) + 1e-5f);
#pragma unroll
        for (int hf = 0; hf < 2; ++hf) { const h16x8 gg = *(const h16x8*)(U + (size_t)tok * LDD_ + 2048 + c0 + hf * 8); h16x8 w;
#pragma unroll
            for (int e = 0; e < 8; ++e) { const int cc = c0 + hf * 8 + e; w[e] = (h16)((o[hf * 8 + e] * rstd * IN(I_RETGW)[j * 1024 + cc] + IN(I_RETGB)[j * 1024 + cc]) * silu((float)gg[e])); }
            *(h16x8*)(MIX + (size_t)tok * MIXW + 512 + c0 + hf * 8) = w; }
    }
}

template <class Epi> __device__ __forceinline__ void run_gemm(Ctx& C, const h16* A, const h16* Bt, int N, int K, const Epi& E) {
    pg8::Gemm g{A, Bt, MG, N, K}; pg8::StaticOrder S; S.init(MG, N, (int)gridDim.x, (int)blockIdx.x);
    pg8::gemm_phase<Epi, pg8::StaticOrder>(C.lds, g, S, E, C.tid);
}

__global__ void __launch_bounds__(NTHR, 2) mega(Args args) {
    extern __shared__ __attribute__((aligned(16))) unsigned char lds_raw[];
    cg::grid_group grid = cg::this_grid();
    Ctx C;
#pragma unroll
    for (int i = 0; i < 32; ++i) C.in[i] = args.in[i];
    C.lds = (LAS unsigned char*)lds_raw; C.tid = threadIdx.x; C.lane = C.tid & 63; C.wave = __builtin_amdgcn_readfirstlane(C.tid >> 6);
    C.gw = blockIdx.x * NWAVES + C.wave; C.ngw = gridDim.x * NWAVES; C.gtid = blockIdx.x * NTHR + C.tid; C.ngt = gridDim.x * NTHR; C.ws = args.ws;
    h16* HN = (h16*)(C.ws + WS_HN); h16* MIX = (h16*)(C.ws + WS_MIX); h16* U = (h16*)(C.ws + WS_U);
#define SYNC() grid.sync()
#ifndef PH
#define PH 0xFFFF
#endif
#ifndef DUP
#define DUP 0
#endif
#define P_(b, ...) do { for (int rep_ = 0; rep_ < 1 + ((DUP >> (b)) & 1); ++rep_) if (PH & (1 << (b))) { int t_ = threadIdx.x; asm volatile("" : "+v"(t_)); C.tid = t_; C.lane = t_ & 63; C.wave = __builtin_amdgcn_readfirstlane(t_ >> 6); C.gw = blockIdx.x * NWAVES + C.wave; C.gtid = blockIdx.x * NTHR + t_; __VA_ARGS__; } } while (0)
#pragma unroll 1
    for (int layer = 0; layer < 4; ++layer) {
        C.layer = layer; C.j = layer >> 1;
        P_(0, phase_weights(C)); SYNC();
#pragma unroll 1
        for (int grp = 0; grp < 2; ++grp) {
            C.grp = grp; C.nseq = grp == 0 ? 2 : 1; C.T = grp == 0 ? 8192 : 16384;
            C.hdst = args.out + (size_t)grp * MG * D; C.hsrc = (layer == 0) ? args.in[grp == 0 ? I_XP : I_XS] : C.hdst;
            P_(1, phase_norm(C, C.hsrc, IN(I_LNMIX) + layer * D, HN)); SYNC();
            if ((layer & 1) == 0) {
                P_(2, run_gemm(C, HN, (const h16*)(C.ws + W_IN1), LDA_, D, pg8::EpiF16<0>{U, LDA_})); SYNC();
                P_(3, rwkv_pre(C)); SYNC();
                P_(4, rwkv_scan<1>(C)); SYNC();
                P_(5, rwkv_cross(C)); SYNC();
                P_(6, rwkv_scan<2>(C)); SYNC();
                P_(7, rwkv_final(C)); SYNC();
                P_(2, run_gemm(C, HN, (const h16*)(C.ws + W_IN2), LDB_, D, pg8::EpiF16<0>{U, LDB_})); SYNC();
                P_(8, mamba_pre(C)); SYNC();
                P_(9, diag_scan<MX_MAMBA, 1>(C)); SYNC();
                P_(5, diag_cross<MX_MAMBA>(C)); SYNC();
                P_(9, diag_scan<MX_MAMBA, 2>(C)); SYNC();
                P_(10, mamba_final(C)); SYNC();
            } else {
                P_(2, run_gemm(C, HN, (const h16*)(C.ws + W_IN1), LDC_, D, pg8::EpiF16<0>{U, LDC_})); SYNC();
                P_(11, diag_scan<MX_HGRN, 1>(C)); SYNC();
                P_(5, diag_cross<MX_HGRN>(C)); SYNC();
                P_(11, diag_scan<MX_HGRN, 2>(C)); SYNC();
                P_(12, hgrn_final(C)); SYNC();
                P_(2, run_gemm(C, HN, (const h16*)(C.ws + W_IN2), LDD_, D, pg8::EpiF16<0>{U, LDD_})); SYNC();
                P_(13, ret_mfma_pass1(C)); SYNC();
                P_(5, ret_mfma_cross(C)); SYNC();
                P_(13, ret_mfma_pass2(C)); SYNC();
                P_(14, ret_final(C)); SYNC();
            }
            P_(15, run_gemm(C, MIX, (const h16*)(C.ws + W_OUT), D, MIXW, pg8::EpiRes{C.hsrc, C.hdst, D})); SYNC();
            P_(1, phase_norm(C, C.hdst, IN(I_LNFFN) + layer * D, HN)); SYNC();
            P_(2, run_gemm(C, HN, (const h16*)(C.ws + W_F1), FF, D, pg8::EpiF16<1>{U, FF})); SYNC();
            P_(15, run_gemm(C, U, (const h16*)(C.ws + W_F2), D, FF, pg8::EpiRes{C.hdst, C.hdst, D})); SYNC();
        }
    }
    P_(1, phase_final_norm(C, args.out, IN(I_LNFINAL)));
}

extern "C" void kernel_launch(void* const* d_in, const int* in_sizes, int n_in, void* d_out, int out_size, void* d_ws, size_t ws_size, hipStream_t stream) {
    static int grid = 0;
    if (grid == 0) {
        if (n_in != 32 || ws_size < WS_END) { fprintf(stderr, "kernel_launch: unexpected n_in %d or ws_size %zu (< %zu)\n", n_in, ws_size, (size_t)WS_END); grid = -1; return; }
        int dev = 0, cus = 0, per_cu = 0;
        hipGetDevice(&dev); hipDeviceGetAttribute(&cus, hipDeviceAttributeMultiprocessorCount, dev);
        if (hipFuncSetAttribute((const void*)mega, hipFuncAttributeMaxDynamicSharedMemorySize, LDS_BYTES) != hipSuccess) { fprintf(stderr, "kernel_launch: hipFuncSetAttribute failed\n"); grid = -1; return; }
        if (hipOccupancyMaxActiveBlocksPerMultiprocessor(&per_cu, (const void*)mega, NTHR, LDS_BYTES) != hipSuccess || per_cu < 1) { fprintf(stderr, "kernel_launch: occupancy query says %d\n", per_cu); per_cu = 1; }
        (void)hipGetLastError();
        grid = cus * per_cu;
    }
    if (grid < 0) return;
    Args a{};
    for (int i = 0; i < 32; ++i) a.in[i] = (const float*)d_in[i];
    a.out = (float*)d_out; a.ws = (unsigned char*)d_ws;
    void* params[] = {&a};
    hipError_t e = hipLaunchCooperativeKernel((const void*)mega, dim3(grid), dim3(NTHR), params, LDS_BYTES, stream);
    if (e != hipSuccess) fprintf(stderr, "kernel_launch: cooperative launch failed: %s (grid %d)\n", hipGetErrorString(e), grid);
}
```

```cpp
#include <hip/hip_runtime.h>
#include <hip/hip_cooperative_groups.h>
#include <cstdio>
#include <cstdint>
namespace cg = cooperative_groups;

#define LAS __attribute__((address_space(3)))
typedef _Float16 h16;
typedef _Float16 h16x8 __attribute__((ext_vector_type(8)));
typedef _Float16 h16x4 __attribute__((ext_vector_type(4)));
typedef float f32x4 __attribute__((ext_vector_type(4)));

constexpr int D = 1024, FF = 4096, MIXW = 1536, MG = 16384;
constexpr int A_IN = 1920, B_IN = 2592, AB_IN = 4512, C_IN = 4096, D_IN = 3072, CD_IN = 7168;
constexpr int LDA_ = 2048, LDB_ = 2816, LDC_ = 4096, LDD_ = 3072;
constexpr int CH_R = 128, CH_M = 256, CH_H = 128, CH_T = 256;
constexpr int SUB = 8;
constexpr int NWAVES = 8, NTHR = 512;
constexpr int LDS_BYTES = 147456;
constexpr size_t MiB = 1u << 20;
constexpr size_t WS_ROT = 0, WS_DEC = 8 * MiB, WS_W = 10 * MiB, WS_HN = 43 * MiB, WS_MIX = 75 * MiB, WS_U = 123 * MiB, WS_ST = 251 * MiB, WS_O = 315 * MiB, WS_END = 347 * MiB;
constexpr size_t W_IN1 = WS_W, W_IN2 = WS_W + 8 * MiB, W_OUT = WS_W + 14 * MiB, W_F1 = WS_W + 17 * MiB, W_F2 = WS_W + 25 * MiB;

struct Args { const float* in[32]; float* out; unsigned char* ws; };
enum { I_XP = 0, I_XS, I_LNMIX, I_LNFFN, I_LNFINAL, I_WOUT, I_W1, I_W2, I_ABW, I_MU, I_W0, I_RW2, I_A0, I_A2, I_G2, I_KK, I_KA, I_RK, I_GNW, I_GNB,
       I_CONVW, I_CONVB, I_DTB, I_ALOG, I_SSMD, I_SSMNW, I_CDW, I_HGLB, I_HGNW, I_RETLD, I_RETGW, I_RETGB };

__device__ __forceinline__ float sigm(float x) { return 1.f / (1.f + __expf(-x)); }
__device__ __forceinline__ float silu(float x) { return x / (1.f + __expf(-x)); }
__device__ __forceinline__ float wave_sum(float v) {
#pragma unroll
    for (int o = 1; o < 64; o <<= 1) v += __shfl_xor(v, o);
    return v;
}
#define WAVE_SYNC() do { asm volatile("s_waitcnt lgkmcnt(0)" ::: "memory"); __builtin_amdgcn_wave_barrier(); } while (0)

namespace pg8 {
constexpr int BM = 256, BK = 64, HALF = 128, HTB = HALF * BK * 2, STAGE_BYTES = 8 * HTB, NXCD = 8, WGM = 8;
__host__ __device__ __forceinline__ int lds_byte(int r, int c) { const int st = (r >> 4) * 2 + (c >> 5), rr = r & 15, cc = c & 31, ob = rr * 64 + cc * 2; return st * 1024 + (ob ^ (((ob >> 9) & 1) << 5)); }
__host__ __device__ __forceinline__ void stage_rc(int b, int& R, int& C) { const int st = b / 1024, sb = b % 1024, swz = sb ^ (((sb >> 9) & 1) << 5); R = (st >> 1) * 16 + swz / 64; C = (st & 1) * 32 + (swz % 64) / 2; }
__host__ __device__ __forceinline__ int perm32(int rho) { const int n = rho >> 4, i = rho & 15; return 8 * (i >> 2) + 4 * n + (i & 3); }
struct Unit { int pm, pn; };
struct Gemm { const h16* A; const h16* Bt; int M, N, K; };
struct StaticOrder {
    int nM, nN, nwg, G, c;
    __device__ void init(int M, int N, int G_, int c_) { nM = M / BM; nN = N / BM; nwg = nM * nN; G = G_; c = c_; }
    __device__ bool next(int i, Unit& u) const {
        const long L = (long)i * G + c; if (L >= nwg) return false;
        int wgid = (int)L; { const int q = nwg / NXCD, r = nwg % NXCD, xcd = wgid % NXCD, off = wgid / NXCD; wgid = (xcd < r ? xcd * (q + 1) : r * (q + 1) + (xcd - r) * q) + off; }
        const int nig = WGM * nN, gid = wgid / nig, fm = gid * WGM, gsz = (nM - fm) < WGM ? (nM - fm) : WGM;
        u.pm = fm + ((wgid % nig) % gsz); u.pn = (wgid % nig) / gsz; return true;
    }
};
template <int ACT> struct EpiF16 {
    h16* O; int ldc;
    __device__ __forceinline__ void operator()(const f32x4 (&acc)[2][2][4][2], const Unit& u, int wr, int wc, int fr, int fq) const {
        const int row0 = u.pm * BM + wr * 64 + fr; const int col0 = u.pn * BM + wc * 32 + 8 * fq;
#pragma unroll
        for (int ai = 0; ai < 2; ++ai)
#pragma unroll
            for (int m = 0; m < 4; ++m) { h16* rowp = O + (size_t)(row0 + ai * HALF + m * 16) * ldc + col0;
#pragma unroll
                for (int bj = 0; bj < 2; ++bj) { f32x4 v0 = acc[ai][bj][m][0], v1 = acc[ai][bj][m][1];
                    if (ACT == 1) {
#pragma unroll
                        for (int e = 0; e < 4; ++e) { float a = fmaxf(v0[e], 0.f), b = fmaxf(v1[e], 0.f); v0[e] = a * a; v1[e] = b * b; } }
                    h16x8 w; w[0] = (h16)v0[0]; w[1] = (h16)v0[1]; w[2] = (h16)v0[2]; w[3] = (h16)v0[3]; w[4] = (h16)v1[0]; w[5] = (h16)v1[1]; w[6] = (h16)v1[2]; w[7] = (h16)v1[3];
                    *(h16x8*)(rowp + bj * HALF) = w; } }
    }
};
struct EpiRes {
    const float* src; float* dst; int ldc;
    __device__ __forceinline__ void operator()(const f32x4 (&acc)[2][2][4][2], const Unit& u, int wr, int wc, int fr, int fq) const {
        const int row0 = u.pm * BM + wr * 64 + fr; const int col0 = u.pn * BM + wc * 32 + 8 * fq;
#pragma unroll
        for (int ai = 0; ai < 2; ++ai)
#pragma unroll
            for (int m = 0; m < 4; ++m) { const size_t off = (size_t)(row0 + ai * HALF + m * 16) * ldc + col0;
#pragma unroll
                for (int bj = 0; bj < 2; ++bj) {
                    const f32x4 s0 = *(const f32x4*)(src + off + bj * HALF), s1 = *(const f32x4*)(src + off + bj * HALF + 4);
                    *(f32x4*)(dst + off + bj * HALF) = s0 + acc[ai][bj][m][0]; *(f32x4*)(dst + off + bj * HALF + 4) = s1 + acc[ai][bj][m][1]; } }
    }
};

template <class Epi, class Sched>
__device__ __forceinline__ void gemm_phase(LAS unsigned char* lds, const Gemm g, const Sched& S, const Epi& E, const int tid) {
    const int wid = __builtin_amdgcn_readfirstlane(tid >> 6), lane = tid & 63, wr = wid >> 2, wc = wid & 3, fr = lane & 15, fq = lane >> 4;
    const int K = g.K, nt = K / BK;
    unsigned voffA[2], voffB[2];
#pragma unroll
    for (int i = 0; i < 2; ++i) { int R, C; stage_rc(tid * 16 + i * 8192, R, C); const int Rb = (R & ~31) + perm32(R & 31);
        voffA[i] = (unsigned)(R * K + C) * 2u; voffB[i] = (unsigned)(Rb * K + C) * 2u; }
    const size_t kstep = (size_t)(BK * 2);
    const size_t hstep = (size_t)HALF * K * 2;
    const size_t tstep = 2 * hstep;
    const unsigned ldsw = (unsigned)wid * 1024u;
    const int aoff = lds_byte(wr * 64 + fr, fq * 8), boff = lds_byte(wc * 32 + fr, fq * 8);
#define PG8_SA(b, h) (((b) * 2 + (h)) * HTB)
#define PG8_SB(b, h) ((4 + (b) * 2 + (h)) * HTB)
#define PG8_STAGE(bufoff, gbase, voff) do { _Pragma("unroll") for (int _i = 0; _i < 2; ++_i) \
        __builtin_amdgcn_global_load_lds((const unsigned*)((const char*)(gbase) + (voff)[_i]), (LAS unsigned*)(lds + (bufoff) + ldsw + _i * 8192), 16, 0, 0); } while (0)
#define PG8_LDA(dst, b, h) do { _Pragma("unroll") for (int m = 0; m < 4; ++m) _Pragma("unroll") for (int k = 0; k < 2; ++k) dst[m][k] = *(const LAS h16x8*)(lds + PG8_SA(b, h) + aoff + m * 2048 + k * 1024); } while (0)
#define PG8_LDB(dst, b, h) do { _Pragma("unroll") for (int n = 0; n < 2; ++n) _Pragma("unroll") for (int k = 0; k < 2; ++k) dst[n][k] = *(const LAS h16x8*)(lds + PG8_SB(b, h) + boff + n * 2048 + k * 1024); } while (0)
#define PG8_MMA(ai, bj, At, Bt) do { __builtin_amdgcn_s_setprio(1); _Pragma("unroll") for (int m = 0; m < 4; ++m) _Pragma("unroll") for (int n = 0; n < 2; ++n) _Pragma("unroll") for (int k = 0; k < 2; ++k) \
        acc[ai][bj][m][n] = __builtin_amdgcn_mfma_f32_16x16x32_f16(Bt[n][k], At[m][k], acc[ai][bj][m][n], 0, 0, 0); __builtin_amdgcn_s_setprio(0); } while (0)
#define PG8_WAIT_V(n) asm volatile("s_waitcnt vmcnt(" #n ")" ::: "memory")
#define PG8_WAIT_L(n) asm volatile("s_waitcnt lgkmcnt(" #n ")" ::: "memory")
#define PG8_BAR __builtin_amdgcn_s_barrier()
#define PG8_SCHED __builtin_amdgcn_sched_barrier(0)
    Unit cur, nxt; int ui = 0;
    if (!S.next(0, cur)) return;
    f32x4 acc[2][2][4][2];
#pragma unroll
    for (int a = 0; a < 2; ++a)
#pragma unroll
        for (int b = 0; b < 2; ++b)
#pragma unroll
            for (int m = 0; m < 4; ++m)
#pragma unroll
                for (int n = 0; n < 2; ++n) acc[a][b][m][n] = (f32x4){0.f, 0.f, 0.f, 0.f};
    h16x8 At[4][2], B0[2][2], B1[2][2];
    const char* cA = (const char*)g.A + (size_t)cur.pm * tstep; const char* cB = (const char*)g.Bt + (size_t)cur.pn * tstep;
    PG8_STAGE(PG8_SB(0, 0), cB, voffB); PG8_STAGE(PG8_SB(0, 1), cB + hstep, voffB); PG8_STAGE(PG8_SA(0, 0), cA, voffA); PG8_STAGE(PG8_SA(0, 1), cA + hstep, voffA);
    if (wr == 1) PG8_BAR;
    PG8_WAIT_V(2); PG8_BAR;
    PG8_STAGE(PG8_SB(1, 0), cB + kstep, voffB); PG8_STAGE(PG8_SA(1, 0), cA + kstep, voffA); PG8_STAGE(PG8_SB(1, 1), cB + hstep + kstep, voffB);
    PG8_WAIT_V(6); PG8_BAR;
    for (;;) {
        const bool has_next = S.next(ui + 1, nxt);
        const char* nA = has_next ? (const char*)g.A + (size_t)nxt.pm * tstep : cA; const char* nB = has_next ? (const char*)g.Bt + (size_t)nxt.pn * tstep : cB;
        for (int t = 0; t < nt; t += 2) {
            const bool last = (t == nt - 2);
            const char* a1 = cA + (size_t)(t + 1) * kstep;
            const char* a2 = last ? nA : cA + (size_t)(t + 2) * kstep; const char* b2 = last ? nB : cB + (size_t)(t + 2) * kstep;
            const char* a3 = a2 + kstep; const char* b3 = b2 + kstep;
            PG8_LDB(B0, 0, 0); PG8_LDB(B1, 0, 1); PG8_SCHED; PG8_LDA(At, 0, 0); PG8_STAGE(PG8_SA(1, 1), a1 + hstep, voffA);
            PG8_WAIT_V(8); PG8_WAIT_L(0); PG8_BAR; PG8_MMA(0, 0, At, B0); PG8_MMA(0, 1, At, B1); PG8_BAR; PG8_SCHED;
            PG8_LDA(At, 0, 1); PG8_STAGE(PG8_SB(0, 0), b2, voffB); PG8_STAGE(PG8_SB(0, 1), b2 + hstep, voffB); PG8_STAGE(PG8_SA(0, 0), a2, voffA);
            PG8_WAIT_V(8); PG8_WAIT_L(0); PG8_BAR; PG8_MMA(1, 0, At, B0); PG8_MMA(1, 1, At, B1); PG8_BAR; PG8_SCHED;
            PG8_LDB(B0, 1, 0); PG8_LDB(B1, 1, 1); PG8_SCHED; PG8_LDA(At, 1, 0); PG8_STAGE(PG8_SA(0, 1), a2 + hstep, voffA);
            PG8_WAIT_V(8); PG8_WAIT_L(0); PG8_BAR; PG8_MMA(0, 0, At, B0); PG8_MMA(0, 1, At, B1); PG8_BAR; PG8_SCHED;
            PG8_LDA(At, 1, 1); PG8_STAGE(PG8_SB(1, 0), b3, voffB); PG8_STAGE(PG8_SB(1, 1), b3 + hstep, voffB); PG8_STAGE(PG8_SA(1, 0), a3, voffA);
            PG8_WAIT_V(8); PG8_WAIT_L(0); PG8_BAR; PG8_MMA(1, 0, At, B0); PG8_MMA(1, 1, At, B1); PG8_BAR; PG8_SCHED;
        }
        if (wr == 0) PG8_BAR;
        E(acc, cur, wr, wc, fr, fq);
        if (!has_next) break;
#pragma unroll
        for (int a = 0; a < 2; ++a)
#pragma unroll
            for (int b = 0; b < 2; ++b)
#pragma unroll
                for (int m = 0; m < 4; ++m)
#pragma unroll
                    for (int n = 0; n < 2; ++n) acc[a][b][m][n] = (f32x4){0.f, 0.f, 0.f, 0.f};
        cur = nxt; cA = nA; cB = nB; ++ui;
        if (wr == 1) PG8_BAR;
    }
    PG8_WAIT_V(0);
    PG8_BAR;
#undef PG8_SA
#undef PG8_SB
#undef PG8_STAGE
#undef PG8_LDA
#undef PG8_LDB
#undef PG8_MMA
#undef PG8_WAIT_V
#undef PG8_WAIT_L
#undef PG8_BAR
#undef PG8_SCHED
}
}

struct Ctx {
    const float* in[32]; LAS unsigned char* lds; int tid, lane, wave, gw, ngw, gtid, ngt;
    int layer, j, grp, nseq, T;
    const float* hsrc; float* hdst;
    unsigned char* ws;
};
#define IN(k) (C.in[k])

__device__ __forceinline__ void transpose_item(const float* W, int ldw, int c0, int nvalid, int K, int Npad, h16* WT, LAS float* scr, int item, int lane) {
    const int nblk = Npad / 32, kb = item / nblk, nb = item % nblk, k0 = 64 * kb, n0 = 32 * nb;
    const int n = n0 + (lane & 31);
#pragma unroll 8
    for (int i = 0; i < 32; ++i) { const int kk = 2 * i + (lane >> 5); scr[kk * 33 + (lane & 31)] = (n < nvalid) ? W[(size_t)(k0 + kk) * ldw + c0 + n] : 0.f; }
    WAVE_SYNC();
    const int c = lane & 7;
#pragma unroll
    for (int jj = 0; jj < 4; ++jj) { const int nn = (lane >> 3) + 8 * jj; const LAS float* s = scr + (8 * c) * 33 + nn;
        h16x8 o;
#pragma unroll
        for (int e = 0; e < 8; ++e) o[e] = (h16)s[e * 33];
        *(h16x8*)(WT + (size_t)(n0 + nn) * K + k0 + 8 * c) = o; }
    WAVE_SYNC();
}
__device__ __forceinline__ void phase_weights(Ctx& C) {
    LAS float* scr = (LAS float*)(C.lds + C.wave * 12288);
    const int layer = C.layer, j = C.j;
    const bool ab = (layer & 1) == 0;
    const float* Win = ab ? IN(I_ABW) + (size_t)j * D * AB_IN : IN(I_CDW) + (size_t)j * D * CD_IN;
    const int ldw = ab ? AB_IN : CD_IN;
    const int n1 = ab ? A_IN : C_IN, n1p = ab ? LDA_ : LDC_, n2 = ab ? B_IN : D_IN, n2p = ab ? LDB_ : LDD_;
    const int it1 = (D / 64) * (n1p / 32), it2 = (D / 64) * (n2p / 32), it3 = (MIXW / 64) * (D / 32), it4 = (D / 64) * (FF / 32), it5 = (FF / 64) * (D / 32);
    const int total = it1 + it2 + it3 + it4 + it5;
    for (int it = C.gw; it < total; it += C.ngw) {
        int r = it;
        if (r < it1) { transpose_item(Win, ldw, 0, n1, D, n1p, (h16*)(C.ws + W_IN1), scr, r, C.lane); continue; } r -= it1;
        if (r < it2) { transpose_item(Win, ldw, n1, n2, D, n2p, (h16*)(C.ws + W_IN2), scr, r, C.lane); continue; } r -= it2;
        if (r < it3) { transpose_item(IN(I_WOUT) + (size_t)layer * MIXW * D, D, 0, D, MIXW, D, (h16*)(C.ws + W_OUT), scr, r, C.lane); continue; } r -= it3;
        if (r < it4) { transpose_item(IN(I_W1) + (size_t)layer * D * FF, FF, 0, FF, D, FF, (h16*)(C.ws + W_F1), scr, r, C.lane); continue; } r -= it4;
        transpose_item(IN(I_W2) + (size_t)layer * FF * D, D, 0, D, FF, D, (h16*)(C.ws + W_F2), scr, r, C.lane);
    }
    if (layer == 0) {
        float* rot = (float*)(C.ws + WS_ROT);
        for (int idx = C.gtid; idx < 16384 * 64; idx += C.ngt) { const int t = idx >> 6, i = idx & 63;
            const float invf = exp2f(-(float)i * (13.287712379549449f / 64.f)); const float ang = (float)t * invf;
            rot[t * 128 + i] = cosf(ang); rot[t * 128 + 64 + i] = sinf(ang); }
    }
}
__device__ __forceinline__ void phase_norm(Ctx& C, const float* src, const float* gain, h16* dst) {
    const f32x4 g0 = ((const f32x4*)gain)[C.lane], g1 = ((const f32x4*)gain)[64 + C.lane], g2 = ((const f32x4*)gain)[128 + C.lane], g3 = ((const f32x4*)gain)[192 + C.lane];
    for (int m = C.gw; m < MG; m += C.ngw) {
        const f32x4* xr = (const f32x4*)(src + (size_t)m * D) + C.lane;
        f32x4 v[4]; float s = 0.f;
#pragma unroll
        for (int q = 0; q < 4; ++q) { v[q] = xr[64 * q]; s += (v[q].x * v[q].x + v[q].y * v[q].y) + (v[q].z * v[q].z + v[q].w * v[q].w); }
        const float rstd = rsqrtf(wave_sum(s) * (1.f / D) + 1e-5f);
        v[0] = v[0] * g0 * rstd; v[1] = v[1] * g1 * rstd; v[2] = v[2] * g2 * rstd; v[3] = v[3] * g3 * rstd;
        h16x4* o = (h16x4*)(dst + (size_t)m * D) + C.lane;
#pragma unroll
        for (int q = 0; q < 4; ++q) { h16x4 w; w[0] = (h16)v[q].x; w[1] = (h16)v[q].y; w[2] = (h16)v[q].z; w[3] = (h16)v[q].w; o[64 * q] = w; }
    }
}
__device__ __forceinline__ void phase_final_norm(Ctx& C, float* io, const float* gain) {
    const f32x4 g0 = ((const f32x4*)gain)[C.lane], g1 = ((const f32x4*)gain)[64 + C.lane], g2 = ((const f32x4*)gain)[128 + C.lane], g3 = ((const f32x4*)gain)[192 + C.lane];
    for (int m = C.gw; m < 2 * MG; m += C.ngw) {
        f32x4* xr = (f32x4*)(io + (size_t)m * D) + C.lane;
        f32x4 v[4]; float s = 0.f;
#pragma unroll
        for (int q = 0; q < 4; ++q) { v[q] = xr[64 * q]; s += (v[q].x * v[q].x + v[q].y * v[q].y) + (v[q].z * v[q].z + v[q].w * v[q].w); }
        const float rstd = rsqrtf(wave_sum(s) * (1.f / D) + 1e-5f);
        xr[0] = v[0] * g0 * rstd; xr[64] = v[1] * g1 * rstd; xr[128] = v[2] * g2 * rstd; xr[192] = v[3] * g3 * rstd;
    }
}

template <int KS, int MODE, int NT>
__device__ __forceinline__ void rwkv_lora(Ctx& C, int col0, const float* Wl, const float* bias, h16* outp, int ldo, int noff) {
    const int lane = C.lane, fr = lane & 15, fq = lane >> 4, w = C.wave, T = C.T;
    const h16* U = (const h16*)(C.ws + WS_U);
    const float* mu0p = IN(I_MU) + (size_t)C.j * 2 * A_IN, *mu1p = mu0p + A_IN;
    h16x8 bf[NT][KS];
#pragma unroll
    for (int nt = 0; nt < NT; ++nt)
#pragma unroll
        for (int ks = 0; ks < KS; ++ks)
#pragma unroll
            for (int e = 0; e < 8; ++e) bf[nt][ks][e] = (h16)Wl[(size_t)(ks * 32 + fq * 8 + e) * 512 + w * 64 + noff + nt * 16 + fr];
    float bv[NT];
#pragma unroll
    for (int nt = 0; nt < NT; ++nt) bv[nt] = bias ? bias[w * 64 + noff + nt * 16 + fr] : 0.f;
    for (int tile = blockIdx.x; tile < MG / 16; tile += gridDim.x) {
        f32x4 acc[NT];
#pragma unroll
        for (int nt = 0; nt < NT; ++nt) acc[nt] = (f32x4){0.f, 0.f, 0.f, 0.f};
        const int tok = tile * 16 + fr, t = tok % T;
#pragma unroll
        for (int ks = 0; ks < KS; ++ks) {
            const int c = col0 + ks * 32 + fq * 8;
            const h16* up = U + (size_t)tok * LDA_ + c;
            const h16x8 cur = *(const h16x8*)up;
            h16x8 prv, nxt;
#pragma unroll
            for (int e = 0; e < 8; ++e) { prv[e] = (h16)0.f; nxt[e] = (h16)0.f; }
            if (t > 0) prv = *(const h16x8*)(up - LDA_);
            if (t < T - 1) nxt = *(const h16x8*)(up + LDA_);
            h16x8 af;
#pragma unroll
            for (int e = 0; e < 8; ++e) { const float x = (float)cur[e]; float y = x + mu0p[c + e] * ((float)prv[e] - x) + mu1p[c + e] * ((float)nxt[e] - x);
                if (MODE == 0) y = tanhf(y); else if (MODE == 2) y = sigm(y);
                af[e] = (h16)y; }
#pragma unroll
            for (int nt = 0; nt < NT; ++nt) acc[nt] = __builtin_amdgcn_mfma_f32_16x16x32_f16(af, bf[nt][ks], acc[nt], 0, 0, 0);
        }
#pragma unroll
        for (int nt = 0; nt < NT; ++nt)
#pragma unroll
            for (int e = 0; e < 4; ++e) { const int otok = tile * 16 + fq * 4 + e, n = w * 64 + noff + nt * 16 + fr; float y = acc[nt][e] + bv[nt];
                if (MODE == 0) y = sigm(y) * 0.6065306597126334f; else if (MODE == 1) y = sigm(y);
                outp[(size_t)otok * ldo + n] = (h16)y; }
    }
}
__device__ __forceinline__ void rwkv_pre(Ctx& C) {
    h16* U2 = (h16*)(C.ws + WS_U + 64 * MiB); h16* G = (h16*)(C.ws + WS_MIX) + 512;
    const int j = C.j;
    for (int d = 0; d < 2; ++d) {
        rwkv_lora<2, 0, 4>(C, 1536 + 64 * d, IN(I_RW2) + (size_t)(j * 2 + d) * 64 * 512, IN(I_W0) + (size_t)(j * 2 + d) * 512, U2 + d * 1024, 2048, 0);
        rwkv_lora<2, 1, 4>(C, 1664 + 64 * d, IN(I_A2) + (size_t)(j * 2 + d) * 64 * 512, IN(I_A0) + (size_t)(j * 2 + d) * 512, U2 + d * 1024 + 512, 2048, 0);
    }
    for (int hf = 0; hf < 2; ++hf) rwkv_lora<4, 2, 2>(C, 1792, IN(I_G2) + (size_t)j * 128 * 512, nullptr, G, MIXW, hf * 32);
}
template <int PASS>
__device__ __forceinline__ void rwkv_scan(Ctx& C) {
    const int lane = C.lane, T = C.T, NC = T / CH_R, j = C.j;
    const int nunits = C.nseq * 2 * NC * 8;
    const h16* U = (const h16*)(C.ws + WS_U); const h16* U2 = (const h16*)(C.ws + WS_U + 64 * MiB);
    LAS float* wl = (LAS float*)(C.lds + C.wave * 12288);
    const float* mu0p = IN(I_MU) + (size_t)j * 2 * A_IN, *mu1p = mu0p + A_IN;
    for (int unit = C.gw; unit < nunits; unit += C.ngw) {
        const int hd = unit & 7; int r = unit >> 3; const int c = r % NC; r /= NC; const int dir = r & 1, b = r >> 1;
        const int col = hd * 64 + lane;
        const float m0r = mu0p[col], m1r = mu1p[col], m0k = mu0p[512 + col], m1k = mu1p[512 + col], m0v = mu0p[1024 + col], m1v = mu1p[1024 + col];
        const float kkw = IN(I_KK)[j * 512 + col], kaw = IN(I_KA)[j * 512 + col];
        float* slot = (float*)(C.ws + WS_ST) + (size_t)((((b * 2 + dir) * NC + c) * 8) + hd) * 8192;
        float S[64], P[64];
        if (PASS == 1) {
            int ln = lane; asm volatile("" : "+v"(ln));
#pragma unroll
            for (int q = 0; q < 64; ++q) { S[q] = 0.f; P[q] = (q == ln) ? 1.f : 0.f; }
        } else {
#pragma unroll
            for (int q = 0; q < 16; ++q) { const f32x4 v = *(const f32x4*)(slot + lane * 64 + q * 4); S[4 * q] = v.x; S[4 * q + 1] = v.y; S[4 * q + 2] = v.z; S[4 * q + 3] = v.w; }
        }
        h16* outp = (dir == 0) ? (h16*)(C.ws + WS_MIX) : (h16*)(C.ws + WS_O);
        const int ldo = (dir == 0) ? MIXW : 512;
#pragma unroll 1
        for (int sub = 0; sub < CH_R / SUB; ++sub) {
#pragma unroll 1
            for (int s = 0; s < SUB; ++s) {
                const int p = c * CH_R + sub * SUB + s, t = dir ? T - 1 - p : p; const size_t tok = (size_t)b * T + t;
                const h16* ur = U + tok * LDA_ + col;
                const float rc = (float)ur[0], kc = (float)ur[512], vc = (float)ur[1024];
                float rp = 0.f, kp = 0.f, vp = 0.f, rn = 0.f, kn = 0.f, vn = 0.f;
                if (t > 0) { rp = (float)ur[-LDA_]; kp = (float)ur[512 - LDA_]; vp = (float)ur[1024 - LDA_]; }
                if (t < T - 1) { rn = (float)ur[LDA_]; kn = (float)ur[512 + LDA_]; vn = (float)ur[1024 + LDA_]; }
                const float rr = rc + m0r * (rp - rc) + m1r * (rn - rc), kk_ = kc + m0k * (kp - kc) + m1k * (kn - kc), vv = vc + m0v * (vp - vc) + m1v * (vn - vc);
                const float e = (float)U2[tok * 2048 + dir * 1024 + col], av = (float)U2[tok * 2048 + dir * 1024 + 512 + col];
                const float wdec = __expf(-e);
                const float kx = kk_ * kkw; const float n2 = wave_sum(kx * kx); const float kkn = kx / fmaxf(sqrtf(n2), 1e-12f);
                LAS float* q = wl + s * 384;
                q[lane] = wdec; q[64 + lane] = kkn; q[128 + lane] = kkn * av; q[192 + lane] = kk_ * (1.f + (av - 1.f) * kaw); q[256 + lane] = rr; q[320 + lane] = vv;
            }
            WAVE_SYNC();
#pragma unroll 1
            for (int s = 0; s < SUB; ++s) {
                const LAS f32x4* q = (const LAS f32x4*)(wl + s * 384);
                const float vv = wl[s * 384 + 320 + lane];
                float sa0 = 0.f, sa1 = 0.f, sp0 = 0.f, sp1 = 0.f;
#pragma unroll
                for (int k4 = 0; k4 < 16; ++k4) { const f32x4 kk4 = q[16 + k4];
                    sa0 += S[4 * k4] * kk4.x + S[4 * k4 + 2] * kk4.z; sa1 += S[4 * k4 + 1] * kk4.y + S[4 * k4 + 3] * kk4.w;
                    if (PASS == 1) { sp0 += P[4 * k4] * kk4.x + P[4 * k4 + 2] * kk4.z; sp1 += P[4 * k4 + 1] * kk4.y + P[4 * k4 + 3] * kk4.w; }
                    if ((k4 & 3) == 3) __builtin_amdgcn_sched_barrier(0); }
                const float sa = -(sa0 + sa1), sp = -(sp0 + sp1);
                float o0 = 0.f, o1 = 0.f;
#pragma unroll
                for (int k4 = 0; k4 < 16; ++k4) { const f32x4 w4 = q[k4], b4 = q[32 + k4], d4 = q[48 + k4];
                    S[4 * k4] = S[4 * k4] * w4.x + sa * b4.x + vv * d4.x; S[4 * k4 + 1] = S[4 * k4 + 1] * w4.y + sa * b4.y + vv * d4.y;
                    S[4 * k4 + 2] = S[4 * k4 + 2] * w4.z + sa * b4.z + vv * d4.z; S[4 * k4 + 3] = S[4 * k4 + 3] * w4.w + sa * b4.w + vv * d4.w;
                    if (PASS == 1) { P[4 * k4] = P[4 * k4] * w4.x + sp * b4.x; P[4 * k4 + 1] = P[4 * k4 + 1] * w4.y + sp * b4.y; P[4 * k4 + 2] = P[4 * k4 + 2] * w4.z + sp * b4.z; P[4 * k4 + 3] = P[4 * k4 + 3] * w4.w + sp * b4.w; }
                    else { const f32x4 r4 = q[64 + k4]; o0 += S[4 * k4] * r4.x + S[4 * k4 + 2] * r4.z; o1 += S[4 * k4 + 1] * r4.y + S[4 * k4 + 3] * r4.w; }
                    if ((k4 & 1) == 1) __builtin_amdgcn_sched_barrier(0); }
                if (PASS == 2) { const int p = c * CH_R + sub * SUB + s, t = dir ? T - 1 - p : p; outp[((size_t)b * T + t) * ldo + col] = (h16)(o0 + o1); }
            }
            WAVE_SYNC();
        }
        if (PASS == 1) {
#pragma unroll
            for (int q = 0; q < 16; ++q) { *(f32x4*)(slot + lane * 64 + q * 4) = (f32x4){S[4 * q], S[4 * q + 1], S[4 * q + 2], S[4 * q + 3]};
                *(f32x4*)(slot + 4096 + lane * 64 + q * 4) = (f32x4){P[4 * q], P[4 * q + 1], P[4 * q + 2], P[4 * q + 3]}; }
        }
    }
}
__device__ __forceinline__ void rwkv_cross(Ctx& C) {
    const int T = C.T, NC = T / CH_R, nchains = C.nseq * 16, tid = C.tid;
    LAS float* Cs = (LAS float*)C.lds; LAS float* Ps = Cs + 64 * 65;
    const int i = tid >> 3, jg = tid & 7;
    for (int chain = blockIdx.x; chain < nchains; chain += gridDim.x) {
        const int hd = chain & 7, dir = (chain >> 3) & 1, b = chain >> 4;
        float cr[8];
#pragma unroll
        for (int k = 0; k < 8; ++k) cr[k] = 0.f;
        for (int c = 0; c < NC; ++c) {
            float* base = (float*)(C.ws + WS_ST) + (size_t)((((b * 2 + dir) * NC + c) * 8) + hd) * 8192;
            const f32x4 s0 = *(const f32x4*)(base + i * 64 + jg * 8), s1 = *(const f32x4*)(base + i * 64 + jg * 8 + 4);
            const f32x4 p0 = *(const f32x4*)(base + 4096 + tid * 8), p1 = *(const f32x4*)(base + 4096 + tid * 8 + 4);
            *(LAS f32x4*)(Ps + tid * 8) = p0; *(LAS f32x4*)(Ps + tid * 8 + 4) = p1;
#pragma unroll
            for (int k = 0; k < 8; ++k) Cs[i * 65 + jg * 8 + k] = cr[k];
            *(f32x4*)(base + i * 64 + jg * 8) = (f32x4){cr[0], cr[1], cr[2], cr[3]}; *(f32x4*)(base + i * 64 + jg * 8 + 4) = (f32x4){cr[4], cr[5], cr[6], cr[7]};
            __syncthreads();
            float nr[8] = {s0.x, s0.y, s0.z, s0.w, s1.x, s1.y, s1.z, s1.w};
#pragma unroll 8
            for (int m = 0; m < 64; ++m) { const float cm = Cs[i * 65 + m]; const f32x4 a0 = *(const LAS f32x4*)(Ps + m * 64 + jg * 8), a1 = *(const LAS f32x4*)(Ps + m * 64 + jg * 8 + 4);
                nr[0] += cm * a0.x; nr[1] += cm * a0.y; nr[2] += cm * a0.z; nr[3] += cm * a0.w; nr[4] += cm * a1.x; nr[5] += cm * a1.y; nr[6] += cm * a1.z; nr[7] += cm * a1.w; }
            __syncthreads();
#pragma unroll
            for (int k = 0; k < 8; ++k) cr[k] = nr[k];
        }
    }
}
__device__ __forceinline__ void rwkv_final(Ctx& C) {
    const int lane = C.lane, T = C.T, j = C.j, c0 = lane * 8;
    const h16* U = (const h16*)(C.ws + WS_U); h16* MIX = (h16*)(C.ws + WS_MIX); const h16* O = (const h16*)(C.ws + WS_O);
    const float* mu0p = IN(I_MU) + (size_t)j * 2 * A_IN, *mu1p = mu0p + A_IN;
    for (int tok = C.gw; tok < MG; tok += C.ngw) {
        const int t = tok % T;
        const h16x8 of = *(const h16x8*)(MIX + (size_t)tok * MIXW + c0), ob = *(const h16x8*)(O + (size_t)tok * 512 + c0), gg = *(const h16x8*)(MIX + (size_t)tok * MIXW + 512 + c0);
        float o[8], s = 0.f;
#pragma unroll
        for (int e = 0; e < 8; ++e) { o[e] = (float)of[e] + (float)ob[e]; s += o[e]; }
        s += __shfl_xor(s, 1); s += __shfl_xor(s, 2); s += __shfl_xor(s, 4);
        const float mean = s * (1.f / 64.f); float v2 = 0.f;
#pragma unroll
        for (int e = 0; e < 8; ++e) { o[e] -= mean; v2 += o[e] * o[e]; }
        v2 += __shfl_xor(v2, 1); v2 += __shfl_xor(v2, 2); v2 += __shfl_xor(v2, 4);
        const float rstd = rsqrtf(v2 * (1.f / 64.f) + 64e-5f);
        float rv[3][8];
#pragma unroll
        for (int part = 0; part < 3; ++part) {
            const h16* up = U + (size_t)tok * LDA_ + part * 512 + c0;
            const h16x8 cur = *(const h16x8*)up; h16x8 prv, nxt;
#pragma unroll
            for (int e = 0; e < 8; ++e) { prv[e] = (h16)0.f; nxt[e] = (h16)0.f; }
            if (t > 0) prv = *(const h16x8*)(up - LDA_);
            if (t < T - 1) nxt = *(const h16x8*)(up + LDA_);
#pragma unroll
            for (int e = 0; e < 8; ++e) { const float x = (float)cur[e]; rv[part][e] = x + mu0p[part * 512 + c0 + e] * ((float)prv[e] - x) + mu1p[part * 512 + c0 + e] * ((float)nxt[e] - x); }
        }
        float rk = 0.f;
#pragma unroll
        for (int e = 0; e < 8; ++e) rk += rv[0][e] * rv[1][e] * IN(I_RK)[j * 512 + c0 + e];
        rk += __shfl_xor(rk, 1); rk += __shfl_xor(rk, 2); rk += __shfl_xor(rk, 4);
        h16x8 w;
#pragma unroll
        for (int e = 0; e < 8; ++e) { const float y = o[e] * rstd * IN(I_GNW)[j * 512 + c0 + e] + IN(I_GNB)[j * 512 + c0 + e]; w[e] = (h16)((y + rk * rv[2][e]) * (float)gg[e]); }
        *(h16x8*)(MIX + (size_t)tok * MIXW + c0) = w;
    }
}

enum { MX_MAMBA = 0, MX_HGRN = 1, MX_RET = 2 };
template <int MX> struct MXC;
template <> struct MXC<MX_MAMBA> { static constexpr int CH = CH_M, NH = 16, LDU = LDB_; };
template <> struct MXC<MX_HGRN>  { static constexpr int CH = CH_H, NH = 8,  LDU = LDC_; };
template <> struct MXC<MX_RET>   { static constexpr int CH = CH_T, NH = 16, LDU = LDD_; };

__device__ __forceinline__ float ret_gamma(Ctx& C, int dir, int head) { return __expf(-__expf(IN(I_RETLD)[(C.j * 2 + dir) * 4 + head])); }

__device__ __forceinline__ void mamba_pre(Ctx& C) {
    const int T = C.T, j = C.j;
    const h16* U = (const h16*)(C.ws + WS_U); h16* BC = (h16*)(C.ws + WS_U + 88 * MiB); float* DT = (float*)(C.ws + WS_U + 104 * MiB); h16* XS = (h16*)(C.ws + WS_ST + 32 * MiB);
    const float* cw = IN(I_CONVW) + (size_t)j * 4 * 1536; const float* cb = IN(I_CONVB) + (size_t)j * 1536;
    for (int idx = C.gtid; idx < MG * 192; idx += C.ngt) {
        const int tok = idx / 192, q = idx - tok * 192, t = tok % T, c = q * 8;
        float acc[8];
#pragma unroll
        for (int e = 0; e < 8; ++e) acc[e] = cb[c + e];
#pragma unroll
        for (int jj = 0; jj < 4; ++jj) { const int tt = t + jj - 2;
            if (tt >= 0 && tt < T) { const h16x8 x = *(const h16x8*)(U + (size_t)(tok + jj - 2) * LDB_ + 1024 + c);
#pragma unroll
                for (int e = 0; e < 8; ++e) acc[e] += cw[jj * 1536 + c + e] * (float)x[e]; } }
        h16x8 w;
#pragma unroll
        for (int e = 0; e < 8; ++e) w[e] = (h16)silu(acc[e]);
        if (c < 1024) *(h16x8*)(XS + (size_t)tok * 1024 + c) = w; else *(h16x8*)(BC + (size_t)tok * 512 + (c - 1024)) = w;
    }
    for (int idx = C.gtid; idx < MG * 32; idx += C.ngt) { const int tok = idx >> 5, q = idx & 31;
        const float x = (float)U[(size_t)tok * LDB_ + 2560 + q] + IN(I_DTB)[j * 32 + q];
        const float dt = (x > 20.f) ? x : log1pf(expf(x)); const float da = -dt * expf(IN(I_ALOG)[j * 32 + q]);
        DT[(size_t)tok * 64 + q] = dt; DT[(size_t)tok * 64 + 32 + q] = da; }
}

constexpr int MC_OFF = 0, MB_OFF = 17408, MX_OFF = 36864, MG_OFF = 110592, MA_OFF = 119808;
__device__ __forceinline__ void mamba_stage_bc(Ctx& C, LAS h16* dst, bool transposed, int colbase, int b, int dir, int p0) {
    const int T = C.T, m = C.tid >> 3, i0 = (C.tid & 7) * 16;
    const int p = p0 + m, t = dir ? T - 1 - p : p; const size_t tok = (size_t)b * T + t;
    const h16* BC = (const h16*)(C.ws + WS_U + 88 * MiB);
    const h16x8 x1 = *(const h16x8*)(BC + tok * 512 + colbase + i0), x2 = *(const h16x8*)(BC + tok * 512 + colbase + i0 + 8);
    if (!transposed) { *(LAS h16x8*)(dst + m * 136 + i0) = x1; *(LAS h16x8*)(dst + m * 136 + i0 + 8) = x2; }
    else {
#pragma unroll
        for (int e = 0; e < 8; ++e) { dst[(i0 + e) * 72 + m] = x1[e]; dst[(i0 + 8 + e) * 72 + m] = x2[e]; } }
}
template <bool WEIGHTED>
__device__ __forceinline__ void mamba_stage_xt(Ctx& C, LAS h16* Xt, const LAS float* As, int g, int b, int dir, int p0, int lbase) {
    const int T = C.T; const h16* XS = (const h16*)(C.ws + WS_ST + 32 * MiB); const float* DT = (const float*)(C.ws + WS_U + 104 * MiB);
#pragma unroll 2
    for (int q = 0; q < 8; ++q) { const int it = C.tid + 512 * q, m = it >> 6, cb = it & 63, hl = cb >> 3;
        const int p = p0 + m, t = dir ? T - 1 - p : p; const size_t tok = (size_t)b * T + t;
        const h16x8 x = *(const h16x8*)(XS + tok * 1024 + g * 512 + cb * 8);
        float sc = DT[tok * 64 + dir * 16 + g * 8 + hl];
        if (WEIGHTED) sc *= __expf(As[hl * 256 + 255] - As[hl * 256 + lbase + m]);
#pragma unroll
        for (int e = 0; e < 8; ++e) Xt[(cb * 8 + e) * 72 + m] = (h16)((float)x[e] * sc); }
}
__device__ __forceinline__ void mamba_cum_decay(Ctx& C, LAS float* As, int g, int b, int dir, int c) {
    const int T = C.T, lane = C.lane, w = C.wave; const float* DT = (const float*)(C.ws + WS_U + 104 * MiB);
    float d[4]; float s = 0.f;
#pragma unroll
    for (int i = 0; i < 4; ++i) { const int p = c * 256 + 4 * lane + i, t = dir ? T - 1 - p : p; d[i] = DT[((size_t)b * T + t) * 64 + 32 + dir * 16 + g * 8 + w]; s += d[i]; d[i] = s; }
    float inc = s;
#pragma unroll
    for (int off = 1; off < 64; off <<= 1) { const float tv = __shfl_up(inc, off); if (lane >= off) inc += tv; }
    const float ex = inc - s;
#pragma unroll
    for (int i = 0; i < 4; ++i) As[w * 256 + 4 * lane + i] = ex + d[i];
}
__device__ __forceinline__ void mamba_mfma_pass1(Ctx& C) {
    const int T = C.T, NCH = T / 256, nunits = C.nseq * 2 * NCH * 2, lane = C.lane, w = C.wave, fr = lane & 15, fq = lane >> 4;
    LAS h16* Bt = (LAS h16*)(C.lds + MB_OFF); LAS h16* Xt = (LAS h16*)(C.lds + MX_OFF); LAS float* As = (LAS float*)(C.lds + MA_OFF);
    for (int unit = blockIdx.x; unit < nunits; unit += gridDim.x) {
        const int g = unit & 1; int r = unit >> 1; const int c = r % NCH; r /= NCH; const int dir = r & 1, b = r >> 1;
        __syncthreads();
        mamba_cum_decay(C, As, g, b, dir, c);
        f32x4 acc[8][4];
#pragma unroll
        for (int mt = 0; mt < 8; ++mt)
#pragma unroll
            for (int nt = 0; nt < 4; ++nt) acc[mt][nt] = (f32x4){0.f, 0.f, 0.f, 0.f};
#pragma unroll 1
        for (int jb = 0; jb < 4; ++jb) {
            __syncthreads();
            mamba_stage_bc(C, Bt, true, g * 128, b, dir, c * 256 + 64 * jb);
            mamba_stage_xt<true>(C, Xt, As, g, b, dir, c * 256 + 64 * jb, 64 * jb);
            __syncthreads();
#pragma unroll
            for (int ks = 0; ks < 2; ++ks) {
                h16x8 bx[4];
#pragma unroll
                for (int nt = 0; nt < 4; ++nt) bx[nt] = *(const LAS h16x8*)(Xt + (64 * w + 16 * nt + fr) * 72 + ks * 32 + fq * 8);
#pragma unroll
                for (int mt = 0; mt < 8; ++mt) { const h16x8 a = *(const LAS h16x8*)(Bt + (16 * mt + fr) * 72 + ks * 32 + fq * 8);
#pragma unroll
                    for (int nt = 0; nt < 4; ++nt) acc[mt][nt] = __builtin_amdgcn_mfma_f32_16x16x32_f16(a, bx[nt], acc[mt][nt], 0, 0, 0); }
            }
        }
        const int slot = (((b * 2 + dir) * NCH + c) * 16) + g * 8 + w;
        h16* Hg = (h16*)(C.ws + WS_ST) + (size_t)slot * 8192;
#pragma unroll
        for (int mt = 0; mt < 8; ++mt)
#pragma unroll
            for (int nt = 0; nt < 4; ++nt) { h16x4 v; v[0] = (h16)acc[mt][nt][0]; v[1] = (h16)acc[mt][nt][1]; v[2] = (h16)acc[mt][nt][2]; v[3] = (h16)acc[mt][nt][3];
                *(h16x4*)(Hg + (size_t)(16 * nt + fr) * 128 + 16 * mt + fq * 4) = v; }
        if (lane == 0) ((float*)(C.ws + WS_DEC))[slot] = __expf(As[w * 256 + 255]);
    }
}
__device__ __forceinline__ void mamba_mfma_cross(Ctx& C) {
    const int T = C.T, NCH = T / 256, nchains = C.nseq * 2 * 16;
    const float* DEC = (const float*)(C.ws + WS_DEC);
    for (int idx = C.gtid; idx < nchains * 1024; idx += C.ngt) {
        const int chain = idx >> 10, e8 = (idx & 1023) * 8, hd = chain & 15, dir = (chain >> 4) & 1, b = chain >> 5;
        float carry[8];
#pragma unroll
        for (int e = 0; e < 8; ++e) carry[e] = 0.f;
#pragma unroll 2
        for (int c = 0; c < NCH; ++c) { const int slot = (((b * 2 + dir) * NCH + c) * 16) + hd; h16* p = (h16*)(C.ws + WS_ST) + (size_t)slot * 8192 + e8;
            const h16x8 sl = *(const h16x8*)p; const float d = DEC[slot]; h16x8 o;
#pragma unroll
            for (int e = 0; e < 8; ++e) { o[e] = (h16)carry[e]; carry[e] = d * carry[e] + (float)sl[e]; }
            *(h16x8*)p = o; }
    }
}
__device__ __forceinline__ void mamba_mfma_pass2(Ctx& C) {
    const int T = C.T, NCH = T / 256, nunits = C.nseq * 2 * NCH * 2, lane = C.lane, w = C.wave, fr = lane & 15, fq = lane >> 4;
    LAS h16* Cs = (LAS h16*)(C.lds + MC_OFF); LAS h16* Bs = (LAS h16*)(C.lds + MB_OFF); LAS h16* Xt = (LAS h16*)(C.lds + MX_OFF); LAS h16* Gs = (LAS h16*)(C.lds + MG_OFF); LAS float* As = (LAS float*)(C.lds + MA_OFF);
    for (int unit = blockIdx.x; unit < nunits; unit += gridDim.x) {
        const int g = unit & 1; int r = unit >> 1; const int c = r % NCH; r /= NCH; const int dir = r & 1, b = r >> 1;
        const int hd = g * 8 + w;
        __syncthreads();
        mamba_cum_decay(C, As, g, b, dir, c);
        const int slot = (((b * 2 + dir) * NCH + c) * 16) + hd;
        const h16* Hg = (const h16*)(C.ws + WS_ST) + (size_t)slot * 8192;
        h16* outp; int ldo; if (dir == 0) { outp = (h16*)(C.ws + WS_MIX) + 512; ldo = MIXW; } else { outp = (h16*)(C.ws + WS_O); ldo = 1024; }
#pragma unroll 1
        for (int ib = 0; ib < 4; ++ib) {
            f32x4 acc[4][4];
#pragma unroll
            for (int mt = 0; mt < 4; ++mt)
#pragma unroll
                for (int nt = 0; nt < 4; ++nt) acc[mt][nt] = (f32x4){0.f, 0.f, 0.f, 0.f};
#pragma unroll 1
            for (int jb = 0; jb <= ib; ++jb) {
                __syncthreads();
                if (jb == 0) mamba_stage_bc(C, Cs, false, 256 + g * 128, b, dir, c * 256 + 64 * ib);
                mamba_stage_bc(C, Bs, false, g * 128, b, dir, c * 256 + 64 * jb);
                mamba_stage_xt<false>(C, Xt, As, g, b, dir, c * 256 + 64 * jb, 0);
                __syncthreads();
                if (jb == 0) {
#pragma unroll
                    for (int ks = 0; ks < 4; ++ks) { h16x8 hf[4];
#pragma unroll
                        for (int nt = 0; nt < 4; ++nt) hf[nt] = *(const h16x8*)(Hg + (size_t)(16 * nt + fr) * 128 + ks * 32 + fq * 8);
#pragma unroll
                        for (int mt = 0; mt < 4; ++mt) { const h16x8 a = *(const LAS h16x8*)(Cs + (16 * mt + fr) * 136 + ks * 32 + fq * 8);
#pragma unroll
                            for (int nt = 0; nt < 4; ++nt) acc[mt][nt] = __builtin_amdgcn_mfma_f32_16x16x32_f16(a, hf[nt], acc[mt][nt], 0, 0, 0); } }
#pragma unroll
                    for (int mt = 0; mt < 4; ++mt)
#pragma unroll
                        for (int jj = 0; jj < 4; ++jj) { const float rs = __expf(As[w * 256 + 64 * ib + 16 * mt + fq * 4 + jj]);
#pragma unroll
                            for (int nt = 0; nt < 4; ++nt) acc[mt][nt][jj] *= rs; }
                }
                {
                    const int gm = w >> 1, gn = w & 1;
                    f32x4 g0 = (f32x4){0.f, 0.f, 0.f, 0.f}, g1 = (f32x4){0.f, 0.f, 0.f, 0.f};
#pragma unroll
                    for (int ks = 0; ks < 4; ++ks) { const h16x8 a = *(const LAS h16x8*)(Cs + (16 * gm + fr) * 136 + ks * 32 + fq * 8);
                        const h16x8 k0 = *(const LAS h16x8*)(Bs + (32 * gn + fr) * 136 + ks * 32 + fq * 8), k1 = *(const LAS h16x8*)(Bs + (32 * gn + 16 + fr) * 136 + ks * 32 + fq * 8);
                        g0 = __builtin_amdgcn_mfma_f32_16x16x32_f16(a, k0, g0, 0, 0, 0); g1 = __builtin_amdgcn_mfma_f32_16x16x32_f16(a, k1, g1, 0, 0, 0); }
#pragma unroll
                    for (int jj = 0; jj < 4; ++jj) { const int l = 16 * gm + fq * 4 + jj; Gs[l * 72 + 32 * gn + fr] = (h16)g0[jj]; Gs[l * 72 + 32 * gn + 16 + fr] = (h16)g1[jj]; }
                }
                __syncthreads();
#pragma unroll
                for (int ks = 0; ks < 2; ++ks) {
                    h16x8 bx[4];
#pragma unroll
                    for (int nt = 0; nt < 4; ++nt) bx[nt] = *(const LAS h16x8*)(Xt + (64 * w + 16 * nt + fr) * 72 + ks * 32 + fq * 8);
                    const LAS float* Am = As + w * 256 + 64 * jb + ks * 32 + fq * 8;
                    const f32x4 am0 = *(const LAS f32x4*)Am, am1 = *(const LAS f32x4*)(Am + 4);
                    const float am[8] = {am0.x, am0.y, am0.z, am0.w, am1.x, am1.y, am1.z, am1.w};
                    const int Mb = 64 * jb + ks * 32 + fq * 8;
#pragma unroll
                    for (int mt = 0; mt < 4; ++mt) { const int l = 16 * mt + fr, Lg = 64 * ib + l; const float Al = As[w * 256 + Lg];
                        const h16x8 gr = *(const LAS h16x8*)(Gs + l * 72 + ks * 32 + fq * 8); h16x8 a;
#pragma unroll
                        for (int e = 0; e < 8; ++e) a[e] = (h16)((Mb + e <= Lg) ? (float)gr[e] * __expf(Al - am[e]) : 0.f);
#pragma unroll
                        for (int nt = 0; nt < 4; ++nt) acc[mt][nt] = __builtin_amdgcn_mfma_f32_16x16x32_f16(a, bx[nt], acc[mt][nt], 0, 0, 0); }
                }
            }
#pragma unroll
            for (int mt = 0; mt < 4; ++mt)
#pragma unroll
                for (int jj = 0; jj < 4; ++jj) { const int Lg = 64 * ib + 16 * mt + fq * 4 + jj; const int p = c * 256 + Lg, t = dir ? T - 1 - p : p; h16* op = outp + ((size_t)b * T + t) * ldo + hd * 64 + fr;
#pragma unroll
                    for (int nt = 0; nt < 4; ++nt) op[16 * nt] = (h16)acc[mt][nt][jj]; }
        }
    }
}

template <int MX, int PASS>
__device__ __forceinline__ void diag_scan(Ctx& C) {
    constexpr int CH = MXC<MX>::CH, NH = MXC<MX>::NH, LDU = MXC<MX>::LDU;
    const int lane = C.lane, T = C.T, NC = T / CH, j = C.j;
    const int nunits = C.nseq * 2 * NC * NH;
    const h16* U = (const h16*)(C.ws + WS_U);
    const h16* BC = (const h16*)(C.ws + WS_U + 88 * MiB); const float* DT = (const float*)(C.ws + WS_U + 104 * MiB);
    const float* ROT = (const float*)(C.ws + WS_ROT);
    float* DEC = (float*)(C.ws + WS_DEC);
    LAS float* wl = (LAS float*)(C.lds + C.wave * 12288);
    for (int unit = C.gw; unit < nunits; unit += C.ngw) {
        const int hd = unit % NH; int r = unit / NH; const int c = r % NC; r /= NC; const int dir = r & 1, b = r >> 1;
        const int slotid = ((b * 2 + dir) * NC + c) * NH + hd;
        float* slot = (float*)(C.ws + WS_ST) + (size_t)slotid * 8192;
        float S[128];
        if (PASS == 1) {
#pragma unroll
            for (int q = 0; q < 128; ++q) S[q] = 0.f;
        } else {
#pragma unroll
            for (int q = 0; q < 128; ++q) S[q] = slot[q * 64 + lane];
        }
        float k0 = 0.f, k1 = 0.f, k2 = 0.f, k3 = 0.f, k4c = 0.f, gam = 1.f, dprod = 1.f, D0 = 1.f, D1 = 1.f;
        h16* outp; int ldo, ocol;
        if (MX == MX_MAMBA) { const int cc = hd * 64 + lane; const float* cw = IN(I_CONVW) + (size_t)j * 4 * 1536; k0 = cw[cc]; k1 = cw[1536 + cc]; k2 = cw[2 * 1536 + cc]; k3 = cw[3 * 1536 + cc]; k4c = IN(I_CONVB)[j * 1536 + cc];
            ocol = hd * 64 + lane; if (dir == 0) { outp = (h16*)(C.ws + WS_MIX) + 512; ldo = MIXW; } else { outp = (h16*)(C.ws + WS_O); ldo = 1024; } }
        else if (MX == MX_HGRN) {
            if (j == 1) { const float* lb = IN(I_HGLB); const int f0 = hd * 128 + lane;
                k0 = sigm(lb[(dir * 2 + 1) * 1024 + f0] - lb[(dir * 2 + 0) * 1024 + f0]); k1 = sigm(lb[(dir * 2 + 1) * 1024 + f0 + 64] - lb[(dir * 2 + 0) * 1024 + f0 + 64]); }
            ocol = hd * 64 + lane; if (dir == 0) { outp = (h16*)(C.ws + WS_MIX); ldo = MIXW; } else { outp = (h16*)(C.ws + WS_O); ldo = 512; } }
        else { gam = ret_gamma(C, dir, hd >> 2);
            ocol = hd * 64 + lane; if (dir == 0) { outp = (h16*)(C.ws + WS_MIX) + 512; ldo = MIXW; } else { outp = (h16*)(C.ws + WS_O); ldo = 1024; } }
#pragma unroll 1
        for (int sub = 0; sub < CH / SUB; ++sub) {
#pragma unroll
            for (int s = 0; s < SUB; ++s) {
                const int p = c * CH + sub * SUB + s, t = dir ? T - 1 - p : p; const size_t tok = (size_t)b * T + t;
                const h16* ur = U + tok * LDU;
                LAS float* q = wl + s * 384;
                if (MX == MX_MAMBA) {
                    const int g = hd >> 3; const h16* bc = BC + tok * 512 + g * 128 + lane;
                    q[lane] = (float)bc[0]; q[64 + lane] = (float)bc[64];
                    if (PASS == 2) { q[128 + lane] = (float)bc[256]; q[192 + lane] = (float)bc[320]; }
                    const h16* xp = ur + 1024 + hd * 64 + lane;
                    float acc = k4c + k2 * (float)xp[0];
                    if (t >= 2) acc += k0 * (float)xp[-2 * LDU];
                    if (t >= 1) acc += k1 * (float)xp[-LDU];
                    if (t < T - 1) acc += k3 * (float)xp[LDU];
                    const float dt = DT[tok * 64 + dir * 16 + hd], dA = DT[tok * 64 + 32 + dir * 16 + hd];
                    q[256 + lane] = silu(acc) * dt; q[320] = dA; dprod *= dA;
                } else if (MX == MX_HGRN) {
                    const h16* fp = ur + 1024 + dir * 1024 + hd * 128 + lane;
                    const float f0 = k0 + (1.f - k0) * sigm((float)fp[0]), f1 = k1 + (1.f - k1) * sigm((float)fp[64]);
                    q[lane] = f0; q[64 + lane] = f1; D0 *= f0; D1 *= f1;
                    if (PASS == 2) { q[128 + lane] = (float)ur[hd * 128 + lane]; q[192 + lane] = (float)ur[hd * 128 + 64 + lane]; }
                    q[256 + lane] = (float)ur[3072 + hd * 64 + lane];
                } else {
                    const int h = hd >> 2; const float cs = ROT[t * 128 + lane], sn = ROT[t * 128 + 64 + lane];
                    const float x1 = (float)ur[512 + h * 128 + lane], x2 = (float)ur[512 + h * 128 + 64 + lane];
                    q[lane] = (x1 * cs - x2 * sn) * 0.08838834764831845f; q[64 + lane] = (x2 * cs + x1 * sn) * 0.08838834764831845f;
                    if (PASS == 2) { const float y1 = (float)ur[h * 128 + lane], y2 = (float)ur[h * 128 + 64 + lane]; q[128 + lane] = y1 * cs - y2 * sn; q[192 + lane] = y2 * cs + y1 * sn; }
                    q[256 + lane] = (float)ur[1024 + hd * 64 + lane];
                }
            }
            WAVE_SYNC();
#pragma unroll 1
            for (int s = 0; s < SUB; ++s) {
                const LAS f32x4* q = (const LAS f32x4*)(wl + s * 384);
                const float vv = wl[s * 384 + 256 + lane];
                const float dec = (MX == MX_MAMBA) ? wl[s * 384 + 320] : gam;
                float o0 = 0.f, o1 = 0.f, o2 = 0.f, o3 = 0.f;
#pragma unroll
                for (int k4 = 0; k4 < 32; ++k4) { const f32x4 a4 = q[k4];
                    if (MX == MX_HGRN) { S[4 * k4] = a4.x * (S[4 * k4] - vv) + vv; S[4 * k4 + 1] = a4.y * (S[4 * k4 + 1] - vv) + vv; S[4 * k4 + 2] = a4.z * (S[4 * k4 + 2] - vv) + vv; S[4 * k4 + 3] = a4.w * (S[4 * k4 + 3] - vv) + vv; }
                    else { S[4 * k4] = S[4 * k4] * dec + a4.x * vv; S[4 * k4 + 1] = S[4 * k4 + 1] * dec + a4.y * vv; S[4 * k4 + 2] = S[4 * k4 + 2] * dec + a4.z * vv; S[4 * k4 + 3] = S[4 * k4 + 3] * dec + a4.w * vv; }
                    if (PASS == 2) { const f32x4 q4 = q[32 + k4]; o0 += S[4 * k4] * q4.x; o1 += S[4 * k4 + 1] * q4.y; o2 += S[4 * k4 + 2] * q4.z; o3 += S[4 * k4 + 3] * q4.w; } }
                if (PASS == 2) { const int p = c * CH + sub * SUB + s, t = dir ? T - 1 - p : p; outp[((size_t)b * T + t) * ldo + ocol] = (h16)((o0 + o1) + (o2 + o3)); }
            }
            WAVE_SYNC();
        }
        if (PASS == 1) {
#pragma unroll
            for (int q = 0; q < 128; ++q) slot[q * 64 + lane] = S[q];
            if (MX == MX_MAMBA) { if (lane == 0) DEC[slotid] = dprod; }
            if (MX == MX_HGRN) { DEC[(size_t)slotid * 128 + lane] = D0; DEC[(size_t)slotid * 128 + 64 + lane] = D1; }
        }
    }
}
template <int MX>
__device__ __forceinline__ void diag_cross(Ctx& C) {
    constexpr int CH = MXC<MX>::CH, NH = MXC<MX>::NH;
    const int T = C.T, NC = T / CH, nchains = C.nseq * 2 * NH;
    const float* DEC = (const float*)(C.ws + WS_DEC);
    for (int idx = C.gtid; idx < nchains * 8192; idx += C.ngt) {
        const int chain = idx >> 13, e = idx & 8191, hd = chain % NH; int r = chain / NH; const int dir = r & 1, b = r >> 1;
        float gch = 1.f;
        if (MX == MX_RET) { const float lg = -__expf(IN(I_RETLD)[(C.j * 2 + dir) * 4 + (hd >> 2)]); gch = __expf(lg * (float)CH); }
        float carry = 0.f;
#pragma unroll 4
        for (int c = 0; c < NC; ++c) {
            const int slotid = ((b * 2 + dir) * NC + c) * NH + hd;
            float* p = (float*)(C.ws + WS_ST) + (size_t)slotid * 8192 + e;
            const float sl = *p; *p = carry;
            const float d = (MX == MX_HGRN) ? DEC[(size_t)slotid * 128 + (e >> 6)] : (MX == MX_MAMBA) ? DEC[slotid] : gch;
            carry = d * carry + sl;
        }
    }
}

constexpr int RQ_OFF = 0, RK_OFF = 17408, RV_OFF = 36864, RM_OFF = 73728;
__device__ __forceinline__ void ret_stage_qk(Ctx& C, LAS h16* dst, bool transposed, int colbase, float scale, float lg2, int wbase, int b, int dir, int p0) {
    const int T = C.T, m = C.tid >> 3, i0 = (C.tid & 7) * 8;
    const int p = p0 + m, t = dir ? T - 1 - p : p; const size_t tok = (size_t)b * T + t;
    const h16* U = (const h16*)(C.ws + WS_U); const float* ROT = (const float*)(C.ws + WS_ROT);
    const h16x8 x1 = *(const h16x8*)(U + tok * LDD_ + colbase + i0), x2 = *(const h16x8*)(U + tok * LDD_ + colbase + 64 + i0);
    const f32x4 c0 = *(const f32x4*)(ROT + t * 128 + i0), c1 = *(const f32x4*)(ROT + t * 128 + i0 + 4), s0 = *(const f32x4*)(ROT + t * 128 + 64 + i0), s1 = *(const f32x4*)(ROT + t * 128 + 64 + i0 + 4);
    const float cs[8] = {c0.x, c0.y, c0.z, c0.w, c1.x, c1.y, c1.z, c1.w}, sn[8] = {s0.x, s0.y, s0.z, s0.w, s1.x, s1.y, s1.z, s1.w};
    const float sc = transposed ? scale * exp2f((float)(wbase - m) * lg2) : scale;
    h16x8 y1, y2;
#pragma unroll
    for (int e = 0; e < 8; ++e) { const float a = (float)x1[e], bb = (float)x2[e]; y1[e] = (h16)((a * cs[e] - bb * sn[e]) * sc); y2[e] = (h16)((bb * cs[e] + a * sn[e]) * sc); }
    if (!transposed) { *(LAS h16x8*)(dst + m * 136 + i0) = y1; *(LAS h16x8*)(dst + m * 136 + 64 + i0) = y2; }
    else {
#pragma unroll
        for (int e = 0; e < 8; ++e) { dst[(i0 + e) * 72 + m] = y1[e]; dst[(64 + i0 + e) * 72 + m] = y2[e]; } }
}
__device__ __forceinline__ void ret_stage_vt(Ctx& C, LAS h16* Vt, int h, int b, int dir, int p0) {
    const int T = C.T; const h16* U = (const h16*)(C.ws + WS_U);
#pragma unroll
    for (int q = 0; q < 4; ++q) { const int it = C.tid + 512 * q, m = it >> 5, cb = it & 31;
        const int p = p0 + m, t = dir ? T - 1 - p : p; const size_t tok = (size_t)b * T + t;
        const h16x8 x = *(const h16x8*)(U + tok * LDD_ + 1024 + h * 256 + cb * 8);
#pragma unroll
        for (int e = 0; e < 8; ++e) Vt[(cb * 8 + e) * 72 + m] = x[e]; }
}
__device__ __forceinline__ void ret_mfma_pass1(Ctx& C) {
    const int T = C.T, NCH = T / 256, nunits = C.nseq * 2 * NCH * 4, lane = C.lane, w = C.wave, fr = lane & 15, fq = lane >> 4;
    LAS h16* Kt = (LAS h16*)(C.lds + RK_OFF); LAS h16* Vt = (LAS h16*)(C.lds + RV_OFF);
    for (int unit = blockIdx.x; unit < nunits; unit += gridDim.x) {
        const int h = unit & 3; int r = unit >> 2; const int c = r % NCH; r /= NCH; const int dir = r & 1, b = r >> 1;
        const float lg2 = -__expf(IN(I_RETLD)[(C.j * 2 + dir) * 4 + h]) * 1.4426950408889634f;
        f32x4 acc[8][2];
#pragma unroll
        for (int mt = 0; mt < 8; ++mt) { acc[mt][0] = (f32x4){0.f, 0.f, 0.f, 0.f}; acc[mt][1] = (f32x4){0.f, 0.f, 0.f, 0.f}; }
#pragma unroll 1
        for (int jb = 0; jb < 4; ++jb) {
            __syncthreads();
            ret_stage_qk(C, Kt, true, 512 + h * 128, 0.08838834764831845f, lg2, 255 - 64 * jb, b, dir, c * 256 + 64 * jb);
            ret_stage_vt(C, Vt, h, b, dir, c * 256 + 64 * jb);
            __syncthreads();
#pragma unroll
            for (int ks = 0; ks < 2; ++ks) {
                const h16x8 b0 = *(const LAS h16x8*)(Vt + (32 * w + fr) * 72 + ks * 32 + fq * 8), b1 = *(const LAS h16x8*)(Vt + (32 * w + 16 + fr) * 72 + ks * 32 + fq * 8);
#pragma unroll
                for (int mt = 0; mt < 8; ++mt) { const h16x8 a = *(const LAS h16x8*)(Kt + (16 * mt + fr) * 72 + ks * 32 + fq * 8);
                    acc[mt][0] = __builtin_amdgcn_mfma_f32_16x16x32_f16(a, b0, acc[mt][0], 0, 0, 0); acc[mt][1] = __builtin_amdgcn_mfma_f32_16x16x32_f16(a, b1, acc[mt][1], 0, 0, 0); }
            }
        }
        float* Sg = (float*)(C.ws + WS_ST) + (size_t)unit * 32768;
#pragma unroll
        for (int mt = 0; mt < 8; ++mt)
#pragma unroll
            for (int nt = 0; nt < 2; ++nt) *(f32x4*)(Sg + (size_t)(32 * w + 16 * nt + fr) * 128 + 16 * mt + fq * 4) = acc[mt][nt];
    }
}
__device__ __forceinline__ void ret_mfma_cross(Ctx& C) {
    const int T = C.T, NCH = T / 256, nchains = C.nseq * 2 * 4;
    for (int idx = C.gtid; idx < nchains * 32768; idx += C.ngt) {
        const int chain = idx >> 15, e = idx & 32767, h = chain & 3, dir = (chain >> 2) & 1, b = chain >> 3;
        const float gch = __expf(-__expf(IN(I_RETLD)[(C.j * 2 + dir) * 4 + h]) * 256.f);
        float carry = 0.f;
#pragma unroll 4
        for (int c = 0; c < NCH; ++c) { float* p = (float*)(C.ws + WS_ST) + (size_t)((((b * 2 + dir) * NCH + c) * 4) + h) * 32768 + e; const float sl = *p; *p = carry; carry = gch * carry + sl; }
    }
}
__device__ __forceinline__ void ret_mfma_pass2(Ctx& C) {
    const int T = C.T, NCH = T / 256, nunits = C.nseq * 2 * NCH * 4, lane = C.lane, w = C.wave, fr = lane & 15, fq = lane >> 4;
    LAS h16* Qs = (LAS h16*)(C.lds + RQ_OFF); LAS h16* Ks = (LAS h16*)(C.lds + RK_OFF); LAS h16* Vt = (LAS h16*)(C.lds + RV_OFF); LAS h16* Ms = (LAS h16*)(C.lds + RM_OFF);
    for (int unit = blockIdx.x; unit < nunits; unit += gridDim.x) {
        const int h = unit & 3; int r = unit >> 2; const int c = r % NCH; r /= NCH; const int dir = r & 1, b = r >> 1;
        const float lg2 = -__expf(IN(I_RETLD)[(C.j * 2 + dir) * 4 + h]) * 1.4426950408889634f;
        const float* Sg = (const float*)(C.ws + WS_ST) + (size_t)unit * 32768;
        h16x8 sf[2][4];
#pragma unroll
        for (int nt = 0; nt < 2; ++nt)
#pragma unroll
            for (int ks = 0; ks < 4; ++ks) { const float* p = Sg + (size_t)(32 * w + 16 * nt + fr) * 128 + ks * 32 + fq * 8; const f32x4 a = *(const f32x4*)p, bb = *(const f32x4*)(p + 4);
                sf[nt][ks][0] = (h16)a.x; sf[nt][ks][1] = (h16)a.y; sf[nt][ks][2] = (h16)a.z; sf[nt][ks][3] = (h16)a.w; sf[nt][ks][4] = (h16)bb.x; sf[nt][ks][5] = (h16)bb.y; sf[nt][ks][6] = (h16)bb.z; sf[nt][ks][7] = (h16)bb.w; }
        h16* outp; int ldo; if (dir == 0) { outp = (h16*)(C.ws + WS_MIX) + 512; ldo = MIXW; } else { outp = (h16*)(C.ws + WS_O); ldo = 1024; }
#pragma unroll 1
        for (int ib = 0; ib < 4; ++ib) {
            f32x4 acc[4][2];
#pragma unroll
            for (int mt = 0; mt < 4; ++mt) { acc[mt][0] = (f32x4){0.f, 0.f, 0.f, 0.f}; acc[mt][1] = (f32x4){0.f, 0.f, 0.f, 0.f}; }
#pragma unroll 1
            for (int jb = 0; jb <= ib; ++jb) {
                __syncthreads();
                if (jb == 0) ret_stage_qk(C, Qs, false, h * 128, 1.f, lg2, 0, b, dir, c * 256 + 64 * ib);
                ret_stage_qk(C, Ks, false, 512 + h * 128, 0.08838834764831845f, lg2, 0, b, dir, c * 256 + 64 * jb);
                ret_stage_vt(C, Vt, h, b, dir, c * 256 + 64 * jb);
                __syncthreads();
                {
                    const int gm = w >> 1, gn = w & 1;
                    f32x4 g0 = (f32x4){0.f, 0.f, 0.f, 0.f}, g1 = (f32x4){0.f, 0.f, 0.f, 0.f};
#pragma unroll
                    for (int ks = 0; ks < 4; ++ks) { const h16x8 a = *(const LAS h16x8*)(Qs + (16 * gm + fr) * 136 + ks * 32 + fq * 8);
                        const h16x8 k0 = *(const LAS h16x8*)(Ks + (32 * gn + fr) * 136 + ks * 32 + fq * 8), k1 = *(const LAS h16x8*)(Ks + (32 * gn + 16 + fr) * 136 + ks * 32 + fq * 8);
                        g0 = __builtin_amdgcn_mfma_f32_16x16x32_f16(a, k0, g0, 0, 0, 0); g1 = __builtin_amdgcn_mfma_f32_16x16x32_f16(a, k1, g1, 0, 0, 0); }
#pragma unroll
                    for (int jj = 0; jj < 4; ++jj) { const int l = 16 * gm + fq * 4 + jj, Lg = 64 * ib + l;
                        const int m0 = 32 * gn + fr, M0 = 64 * jb + m0, M1 = M0 + 16;
                        Ms[l * 72 + m0] = (h16)((M0 <= Lg) ? g0[jj] * exp2f((float)(Lg - M0) * lg2) : 0.f);
                        Ms[l * 72 + m0 + 16] = (h16)((M1 <= Lg) ? g1[jj] * exp2f((float)(Lg - M1) * lg2) : 0.f); }
                }
                __syncthreads();
#pragma unroll
                for (int ks = 0; ks < 2; ++ks) {
                    const h16x8 b0 = *(const LAS h16x8*)(Vt + (32 * w + fr) * 72 + ks * 32 + fq * 8), b1 = *(const LAS h16x8*)(Vt + (32 * w + 16 + fr) * 72 + ks * 32 + fq * 8);
#pragma unroll
                    for (int mt = 0; mt < 4; ++mt) { const h16x8 a = *(const LAS h16x8*)(Ms + (16 * mt + fr) * 72 + ks * 32 + fq * 8);
                        acc[mt][0] = __builtin_amdgcn_mfma_f32_16x16x32_f16(a, b0, acc[mt][0], 0, 0, 0); acc[mt][1] = __builtin_amdgcn_mfma_f32_16x16x32_f16(a, b1, acc[mt][1], 0, 0, 0); }
                }
            }
            f32x4 ac2[4][2];
#pragma unroll
            for (int mt = 0; mt < 4; ++mt) { ac2[mt][0] = (f32x4){0.f, 0.f, 0.f, 0.f}; ac2[mt][1] = (f32x4){0.f, 0.f, 0.f, 0.f}; }
#pragma unroll
            for (int ks = 0; ks < 4; ++ks)
#pragma unroll
                for (int mt = 0; mt < 4; ++mt) { const h16x8 a = *(const LAS h16x8*)(Qs + (16 * mt + fr) * 136 + ks * 32 + fq * 8);
                    ac2[mt][0] = __builtin_amdgcn_mfma_f32_16x16x32_f16(a, sf[0][ks], ac2[mt][0], 0, 0, 0); ac2[mt][1] = __builtin_amdgcn_mfma_f32_16x16x32_f16(a, sf[1][ks], ac2[mt][1], 0, 0, 0); }
#pragma unroll
            for (int mt = 0; mt < 4; ++mt)
#pragma unroll
                for (int jj = 0; jj < 4; ++jj) { const int Lg = 64 * ib + 16 * mt + fq * 4 + jj; const float rs = exp2f((float)(Lg + 1) * lg2);
                    const int p = c * 256 + Lg, t = dir ? T - 1 - p : p; h16* op = outp + ((size_t)b * T + t) * ldo + h * 256 + 32 * w + fr;
                    op[0] = (h16)(acc[mt][0][jj] + ac2[mt][0][jj] * rs); op[16] = (h16)(acc[mt][1][jj] + ac2[mt][1][jj] * rs); }
        }
    }
}
__device__ __forceinline__ void mamba_final(Ctx& C) {
    const int lane = C.lane, j = C.j, c0 = lane * 16;
    const h16* U = (const h16*)(C.ws + WS_U); h16* MIX = (h16*)(C.ws + WS_MIX); const h16* O = (const h16*)(C.ws + WS_O); const h16* XS = (const h16*)(C.ws + WS_ST + 32 * MiB);
    const float dsk = IN(I_SSMD)[j * 16 + (lane >> 2)];
    for (int tok = C.gw; tok < MG; tok += C.ngw) {
        float y[16]; float ss = 0.f;
#pragma unroll
        for (int hf = 0; hf < 2; ++hf) {
            const int c = c0 + hf * 8;
            const h16x8 xs = *(const h16x8*)(XS + (size_t)tok * 1024 + c), yf = *(const h16x8*)(MIX + (size_t)tok * MIXW + 512 + c), yb = *(const h16x8*)(O + (size_t)tok * 1024 + c), z = *(const h16x8*)(U + (size_t)tok * LDB_ + c);
#pragma unroll
            for (int e = 0; e < 8; ++e) { const float v = ((float)yf[e] + (float)yb[e] + (float)xs[e] * dsk) * silu((float)z[e]); y[hf * 8 + e] = v; ss += v * v; }
        }
#pragma unroll
        for (int o = 1; o < 32; o <<= 1) ss += __shfl_xor(ss, o);
        const float rstd = rsqrtf(ss * (1.f / 512.f) + 1e-5f);
#pragma unroll
        for (int hf = 0; hf < 2; ++hf) { h16x8 w;
#pragma unroll
            for (int e = 0; e < 8; ++e) w[e] = (h16)(y[hf * 8 + e] * rstd * IN(I_SSMNW)[j * 1024 + c0 + hf * 8 + e]);
            *(h16x8*)(MIX + (size_t)tok * MIXW + 512 + c0 + hf * 8) = w; }
    }
}
__device__ __forceinline__ void hgrn_final(Ctx& C) {
    const int lane = C.lane, j = C.j, c0 = lane * 8;
    const h16* U = (const h16*)(C.ws + WS_U); h16* MIX = (h16*)(C.ws + WS_MIX); const h16* O = (const h16*)(C.ws + WS_O);
    for (int tok = C.gw; tok < MG; tok += C.ngw) {
        const h16x8 of = *(const h16x8*)(MIX + (size_t)tok * MIXW + c0), ob = *(const h16x8*)(O + (size_t)tok * 512 + c0), gg = *(const h16x8*)(U + (size_t)tok * LDC_ + 3584 + c0);
        float o[8], ss = 0.f;
#pragma unroll
        for (int e = 0; e < 8; ++e) { o[e] = (float)of[e] + (float)ob[e]; ss += o[e] * o[e]; }
        ss += __shfl_xor(ss, 1); ss += __shfl_xor(ss, 2); ss += __shfl_xor(ss, 4);
        const float rstd = rsqrtf(ss * (1.f / 64.f) + 1e-5f);
        h16x8 w;
#pragma unroll
        for (int e = 0; e < 8; ++e) w[e] = (h16)(o[e] * rstd * IN(I_HGNW)[j * 512 + c0 + e] * sigm((float)gg[e]));
        *(h16x8*)(MIX + (size_t)tok * MIXW + c0) = w;
    }
}
__device__ __forceinline__ void ret_final(Ctx& C) {
    const int lane = C.lane, j = C.j, c0 = lane * 16;
    const h16* U = (const h16*)(C.ws + WS_U); h16* MIX = (h16*)(C.ws + WS_MIX); const h16* O = (const h16*)(C.ws + WS_O);
    for (int tok = C.gw; tok < MG; tok += C.ngw) {
        float o[16], s = 0.f;
#pragma unroll
        for (int hf = 0; hf < 2; ++hf) { const h16x8 of = *(const h16x8*)(MIX + (size_t)tok * MIXW + 512 + c0 + hf * 8), ob = *(const h16x8*)(O + (size_t)tok * 1024 + c0 + hf * 8);
#pragma unroll
            for (int e = 0; e < 8; ++e) { o[hf * 8 + e] = (float)of[e] + (float)ob[e]; s += o[hf * 8 + e]; } }
#pragma unroll
        for (int q = 1; q < 16; q <<= 1) s += __shfl_xor(s, q);
        const float mean = s * (1.f / 256.f); float v2 = 0.f;
#pragma unroll
        for (int e = 0; e < 16; ++e) { o[e] -= mean; v2 += o[e] * o[e]; }
#pragma unroll
        for (int q = 1; q < 16; q <<= 1) v2 += __shfl_xor(v2, q);
        const float rstd = rsqrtf(v2 * (1.f / 256.f) + 1e-5f);
#pragma unroll
        for (int hf = 0; hf < 2; ++hf) { const h16x8 gg = *(const h16x8*)(U + (size_t)tok * LDD_ + 2048 + c0 + hf * 8); h16x8 w;
#pragma unroll
            for (int e = 0; e < 8; ++e) { const int cc = c0 + hf * 8 + e; w[e] = (h16)((o[hf * 8 + e] * rstd * IN(I_RETGW)[j * 1024 + cc] + IN(I_RETGB)[j * 1024 + cc]) * silu((float)gg[e])); }
            *(h16x8*)(MIX + (size_t)tok * MIXW + 512 + c0 + hf * 8) = w; }
    }
}

template <class Epi> __device__ __forceinline__ void run_gemm(Ctx& C, const h16* A, const h16* Bt, int N, int K, const Epi& E) {
    pg8::Gemm g{A, Bt, MG, N, K}; pg8::StaticOrder S; S.init(MG, N, (int)gridDim.x, (int)blockIdx.x);
    pg8::gemm_phase<Epi, pg8::StaticOrder>(C.lds, g, S, E, C.tid);
}

__global__ void __launch_bounds__(NTHR, 2) mega(Args args) {
    extern __shared__ __attribute__((aligned(16))) unsigned char lds_raw[];
    cg::grid_group grid = cg::this_grid();
    Ctx C;
#pragma unroll
    for (int i = 0; i < 32; ++i) C.in[i] = args.in[i];
    C.lds = (LAS unsigned char*)lds_raw; C.tid = threadIdx.x; C.lane = C.tid & 63; C.wave = __builtin_amdgcn_readfirstlane(C.tid >> 6);
    C.gw = blockIdx.x * NWAVES + C.wave; C.ngw = gridDim.x * NWAVES; C.gtid = blockIdx.x * NTHR + C.tid; C.ngt = gridDim.x * NTHR; C.ws = args.ws;
    h16* HN = (h16*)(C.ws + WS_HN); h16* MIX = (h16*)(C.ws + WS_MIX); h16* U = (h16*)(C.ws + WS_U);
#define SYNC() grid.sync()
#ifndef PH
#define PH 0xFFFF
#endif
#ifndef DUP
#define DUP 0
#endif
#define P_(b, ...) do { for (int rep_ = 0; rep_ < 1 + ((DUP >> (b)) & 1); ++rep_) if (PH & (1 << (b))) { int t_ = threadIdx.x; asm volatile("" : "+v"(t_)); C.tid = t_; C.lane = t_ & 63; C.wave = __builtin_amdgcn_readfirstlane(t_ >> 6); C.gw = blockIdx.x * NWAVES + C.wave; C.gtid = blockIdx.x * NTHR + t_; __VA_ARGS__; } } while (0)
#pragma unroll 1
    for (int layer = 0; layer < 4; ++layer) {
        C.layer = layer; C.j = layer >> 1;
        P_(0, phase_weights(C)); SYNC();
#pragma unroll 1
        for (int grp = 0; grp < 2; ++grp) {
            C.grp = grp; C.nseq = grp == 0 ? 2 : 1; C.T = grp == 0 ? 8192 : 16384;
            C.hdst = args.out + (size_t)grp * MG * D; C.hsrc = (layer == 0) ? args.in[grp == 0 ? I_XP : I_XS] : C.hdst;
            P_(1, phase_norm(C, C.hsrc, IN(I_LNMIX) + layer * D, HN)); SYNC();
            if ((layer & 1) == 0) {
                P_(2, run_gemm(C, HN, (const h16*)(C.ws + W_IN1), LDA_, D, pg8::EpiF16<0>{U, LDA_})); SYNC();
                P_(3, rwkv_pre(C)); SYNC();
                P_(4, rwkv_scan<1>(C)); SYNC();
                P_(5, rwkv_cross(C)); SYNC();
                P_(6, rwkv_scan<2>(C)); SYNC();
                P_(7, rwkv_final(C)); SYNC();
                P_(2, run_gemm(C, HN, (const h16*)(C.ws + W_IN2), LDB_, D, pg8::EpiF16<0>{U, LDB_})); SYNC();
                P_(8, mamba_pre(C)); SYNC();
                P_(9, mamba_mfma_pass1(C)); SYNC();
                P_(5, mamba_mfma_cross(C)); SYNC();
                P_(9, mamba_mfma_pass2(C)); SYNC();
                P_(10, mamba_final(C)); SYNC();
            } else {
                P_(2, run_gemm(C, HN, (const h16*)(C.ws + W_IN1), LDC_, D, pg8::EpiF16<0>{U, LDC_})); SYNC();
                P_(11, diag_scan<MX_HGRN, 1>(C)); SYNC();
                P_(5, diag_cross<MX_HGRN>(C)); SYNC();
                P_(11, diag_scan<MX_HGRN, 2>(C)); SYNC();
                P_(12, hgrn_final(C)); SYNC();
                P_(2, run_gemm(C, HN, (const h16*)(C.ws + W_IN2), LDD_, D, pg8::EpiF16<0>{U, LDD_})); SYNC();
                P_(13, ret_mfma_pass1(C)); SYNC();
                P_(5, ret_mfma_cross(C)); SYNC();
                P_(13, ret_mfma_pass2(C)); SYNC();
                P_(14, ret_final(C)); SYNC();
            }
            P_(15, run_gemm(C, MIX, (const h16*)(C.ws + W_OUT), D, MIXW, pg8::EpiRes{C.hsrc, C.hdst, D})); SYNC();
            P_(1, phase_norm(C, C.hdst, IN(I_LNFFN) + layer * D, HN)); SYNC();
            P_(2, run_gemm(C, HN, (const h16*)(C.ws + W_F1), FF, D, pg8::EpiF16<1>{U, FF})); SYNC();
            P_(15, run_gemm(C, U, (const h16*)(C.ws + W_F2), D, FF, pg8::EpiRes{C.hdst, C.hdst, D})); SYNC();
        }
    }
    P_(1, phase_final_norm(C, args.out, IN(I_LNFINAL)));
}

extern "C" void kernel_launch(void* const* d_in, const int* in_sizes, int n_in, void* d_out, int out_size, void* d_ws, size_t ws_size, hipStream_t stream) {
    static int grid = 0;
    if (grid == 0) {
        if (n_in != 32 || ws_size < WS_END) { fprintf(stderr, "kernel_launch: unexpected n_in %d or ws_size %zu (< %zu)\n", n_in, ws_size, (size_t)WS_END); grid = -1; return; }
        int dev = 0, cus = 0, per_cu = 0;
        hipGetDevice(&dev); hipDeviceGetAttribute(&cus, hipDeviceAttributeMultiprocessorCount, dev);
        if (hipFuncSetAttribute((const void*)mega, hipFuncAttributeMaxDynamicSharedMemorySize, LDS_BYTES) != hipSuccess) { fprintf(stderr, "kernel_launch: hipFuncSetAttribute failed\n"); grid = -1; return; }
        if (hipOccupancyMaxActiveBlocksPerMultiprocessor(&per_cu, (const void*)mega, NTHR, LDS_BYTES) != hipSuccess || per_cu < 1) { fprintf(stderr, "kernel_launch: occupancy query says %d\n", per_cu); per_cu = 1; }
        (void)hipGetLastError();
        grid = cus * per_cu;
    }
    if (grid < 0) return;
    Args a{};
    for (int i = 0; i < 32; ++i) a.in[i] = (const float*)d_in[i];
    a.out = (float*)d_out; a.ws = (unsigned char*)d_ws;
    void* params[] = {&a};
    hipError_t e = hipLaunchCooperativeKernel((const void*)mega, dim3(grid), dim3(NTHR), params, LDS_BYTES, stream);
    if (e != hipSuccess) fprintf(stderr, "kernel_launch: cooperative launch failed: %s (grid %d)\n", hipGetErrorString(e), grid);
}
```

```cpp
#include <hip/hip_runtime.h>
#include <hip/hip_cooperative_groups.h>
#include <cstdio>
#include <cstdint>
namespace cg = cooperative_groups;

#define LAS __attribute__((address_space(3)))
typedef _Float16 h16;
typedef _Float16 h16x8 __attribute__((ext_vector_type(8)));
typedef _Float16 h16x4 __attribute__((ext_vector_type(4)));
typedef float f32x4 __attribute__((ext_vector_type(4)));

constexpr int D = 1024, FF = 4096, MIXW = 1536, MG = 16384;
constexpr int A_IN = 1920, B_IN = 2592, AB_IN = 4512, C_IN = 4096, D_IN = 3072, CD_IN = 7168;
constexpr int LDA_ = 2048, LDB_ = 2816, LDC_ = 4096, LDD_ = 3072;
constexpr int CH_R = 128, CH_M = 256, CH_H = 128, CH_T = 256;
constexpr int SUB = 8;
constexpr int NWAVES = 8, NTHR = 512;
constexpr int LDS_BYTES = 147456;
constexpr size_t MiB = 1u << 20;
constexpr size_t WS_ROT = 0, WS_DEC = 8 * MiB, WS_W = 10 * MiB, WS_HN = 43 * MiB, WS_MIX = 75 * MiB, WS_U = 123 * MiB, WS_ST = 251 * MiB, WS_O = 315 * MiB, WS_BAR = 347 * MiB, WS_END = 348 * MiB;
constexpr size_t W_IN1 = WS_W, W_IN2 = WS_W + 8 * MiB, W_OUT = WS_W + 14 * MiB, W_F1 = WS_W + 17 * MiB, W_F2 = WS_W + 25 * MiB;

struct Args { const float* in[32]; float* out; unsigned char* ws; };
enum { I_XP = 0, I_XS, I_LNMIX, I_LNFFN, I_LNFINAL, I_WOUT, I_W1, I_W2, I_ABW, I_MU, I_W0, I_RW2, I_A0, I_A2, I_G2, I_KK, I_KA, I_RK, I_GNW, I_GNB,
       I_CONVW, I_CONVB, I_DTB, I_ALOG, I_SSMD, I_SSMNW, I_CDW, I_HGLB, I_HGNW, I_RETLD, I_RETGW, I_RETGB };

__device__ __forceinline__ float sigm(float x) { return 1.f / (1.f + __expf(-x)); }
__device__ __forceinline__ float silu(float x) { return x / (1.f + __expf(-x)); }
__device__ __forceinline__ float wave_sum(float v) {
#pragma unroll
    for (int o = 1; o < 64; o <<= 1) v += __shfl_xor(v, o);
    return v;
}
#define WAVE_SYNC() do { asm volatile("s_waitcnt lgkmcnt(0)" ::: "memory"); __builtin_amdgcn_wave_barrier(); } while (0)

namespace pg8 {
constexpr int BM = 256, BK = 64, HALF = 128, HTB = HALF * BK * 2, STAGE_BYTES = 8 * HTB, NXCD = 8, WGM = 8;
__host__ __device__ __forceinline__ int lds_byte(int r, int c) { const int st = (r >> 4) * 2 + (c >> 5), rr = r & 15, cc = c & 31, ob = rr * 64 + cc * 2; return st * 1024 + (ob ^ (((ob >> 9) & 1) << 5)); }
__host__ __device__ __forceinline__ void stage_rc(int b, int& R, int& C) { const int st = b / 1024, sb = b % 1024, swz = sb ^ (((sb >> 9) & 1) << 5); R = (st >> 1) * 16 + swz / 64; C = (st & 1) * 32 + (swz % 64) / 2; }
__host__ __device__ __forceinline__ int perm32(int rho) { const int n = rho >> 4, i = rho & 15; return 8 * (i >> 2) + 4 * n + (i & 3); }
struct Unit { int pm, pn; };
struct Gemm { const h16* A; const h16* Bt; int M, N, K; };
struct StaticOrder {
    int nM, nN, nwg, G, c;
    __device__ void init(int M, int N, int G_, int c_) { nM = M / BM; nN = N / BM; nwg = nM * nN; G = G_; c = c_; }
    __device__ bool next(int i, Unit& u) const {
        const long L = (long)i * G + c; if (L >= nwg) return false;
        int wgid = (int)L; { const int q = nwg / NXCD, r = nwg % NXCD, xcd = wgid % NXCD, off = wgid / NXCD; wgid = (xcd < r ? xcd * (q + 1) : r * (q + 1) + (xcd - r) * q) + off; }
        const int nig = WGM * nN, gid = wgid / nig, fm = gid * WGM, gsz = (nM - fm) < WGM ? (nM - fm) : WGM;
        u.pm = fm + ((wgid % nig) % gsz); u.pn = (wgid % nig) / gsz; return true;
    }
};
template <int ACT> struct EpiF16 {
    h16* O; int ldc;
    __device__ __forceinline__ void operator()(const f32x4 (&acc)[2][2][4][2], const Unit& u, int wr, int wc, int fr, int fq) const {
        const int row0 = u.pm * BM + wr * 64 + fr; const int col0 = u.pn * BM + wc * 32 + 8 * fq;
#pragma unroll
        for (int ai = 0; ai < 2; ++ai)
#pragma unroll
            for (int m = 0; m < 4; ++m) { h16* rowp = O + (size_t)(row0 + ai * HALF + m * 16) * ldc + col0;
#pragma unroll
                for (int bj = 0; bj < 2; ++bj) { f32x4 v0 = acc[ai][bj][m][0], v1 = acc[ai][bj][m][1];
                    if (ACT == 1) {
#pragma unroll
                        for (int e = 0; e < 4; ++e) { float a = fmaxf(v0[e], 0.f), b = fmaxf(v1[e], 0.f); v0[e] = a * a; v1[e] = b * b; } }
                    h16x8 w; w[0] = (h16)v0[0]; w[1] = (h16)v0[1]; w[2] = (h16)v0[2]; w[3] = (h16)v0[3]; w[4] = (h16)v1[0]; w[5] = (h16)v1[1]; w[6] = (h16)v1[2]; w[7] = (h16)v1[3];
                    *(h16x8*)(rowp + bj * HALF) = w; } }
    }
};
struct EpiRes {
    const float* src; float* dst; int ldc;
    __device__ __forceinline__ void operator()(const f32x4 (&acc)[2][2][4][2], const Unit& u, int wr, int wc, int fr, int fq) const {
        const int row0 = u.pm * BM + wr * 64 + fr; const int col0 = u.pn * BM + wc * 32 + 8 * fq;
#pragma unroll
        for (int ai = 0; ai < 2; ++ai)
#pragma unroll
            for (int m = 0; m < 4; ++m) { const size_t off = (size_t)(row0 + ai * HALF + m * 16) * ldc + col0;
#pragma unroll
                for (int bj = 0; bj < 2; ++bj) {
                    const f32x4 s0 = *(const f32x4*)(src + off + bj * HALF), s1 = *(const f32x4*)(src + off + bj * HALF + 4);
                    *(f32x4*)(dst + off + bj * HALF) = s0 + acc[ai][bj][m][0]; *(f32x4*)(dst + off + bj * HALF + 4) = s1 + acc[ai][bj][m][1]; } }
    }
};

template <class Epi, class Sched>
__device__ __forceinline__ void gemm_phase(LAS unsigned char* lds, const Gemm g, const Sched& S, const Epi& E, const int tid) {
    const int wid = __builtin_amdgcn_readfirstlane(tid >> 6), lane = tid & 63, wr = wid >> 2, wc = wid & 3, fr = lane & 15, fq = lane >> 4;
    const int K = g.K, nt = K / BK;
    unsigned voffA[2], voffB[2];
#pragma unroll
    for (int i = 0; i < 2; ++i) { int R, C; stage_rc(tid * 16 + i * 8192, R, C); const int Rb = (R & ~31) + perm32(R & 31);
        voffA[i] = (unsigned)(R * K + C) * 2u; voffB[i] = (unsigned)(Rb * K + C) * 2u; }
    const size_t kstep = (size_t)(BK * 2);
    const size_t hstep = (size_t)HALF * K * 2;
    const size_t tstep = 2 * hstep;
    const unsigned ldsw = (unsigned)wid * 1024u;
    const int aoff = lds_byte(wr * 64 + fr, fq * 8), boff = lds_byte(wc * 32 + fr, fq * 8);
#define PG8_SA(b, h) (((b) * 2 + (h)) * HTB)
#define PG8_SB(b, h) ((4 + (b) * 2 + (h)) * HTB)
#define PG8_STAGE(bufoff, gbase, voff) do { _Pragma("unroll") for (int _i = 0; _i < 2; ++_i) \
        __builtin_amdgcn_global_load_lds((const unsigned*)((const char*)(gbase) + (voff)[_i]), (LAS unsigned*)(lds + (bufoff) + ldsw + _i * 8192), 16, 0, 0); } while (0)
#define PG8_LDA(dst, b, h) do { _Pragma("unroll") for (int m = 0; m < 4; ++m) _Pragma("unroll") for (int k = 0; k < 2; ++k) dst[m][k] = *(const LAS h16x8*)(lds + PG8_SA(b, h) + aoff + m * 2048 + k * 1024); } while (0)
#define PG8_LDB(dst, b, h) do { _Pragma("unroll") for (int n = 0; n < 2; ++n) _Pragma("unroll") for (int k = 0; k < 2; ++k) dst[n][k] = *(const LAS h16x8*)(lds + PG8_SB(b, h) + boff + n * 2048 + k * 1024); } while (0)
#define PG8_MMA(ai, bj, At, Bt) do { __builtin_amdgcn_s_setprio(1); _Pragma("unroll") for (int m = 0; m < 4; ++m) _Pragma("unroll") for (int n = 0; n < 2; ++n) _Pragma("unroll") for (int k = 0; k < 2; ++k) \
        acc[ai][bj][m][n] = __builtin_amdgcn_mfma_f32_16x16x32_f16(Bt[n][k], At[m][k], acc[ai][bj][m][n], 0, 0, 0); __builtin_amdgcn_s_setprio(0); } while (0)
#define PG8_WAIT_V(n) asm volatile("s_waitcnt vmcnt(" #n ")" ::: "memory")
#define PG8_WAIT_L(n) asm volatile("s_waitcnt lgkmcnt(" #n ")" ::: "memory")
#define PG8_BAR __builtin_amdgcn_s_barrier()
#define PG8_SCHED __builtin_amdgcn_sched_barrier(0)
    Unit cur, nxt; int ui = 0;
    if (!S.next(0, cur)) return;
    f32x4 acc[2][2][4][2];
#pragma unroll
    for (int a = 0; a < 2; ++a)
#pragma unroll
        for (int b = 0; b < 2; ++b)
#pragma unroll
            for (int m = 0; m < 4; ++m)
#pragma unroll
                for (int n = 0; n < 2; ++n) acc[a][b][m][n] = (f32x4){0.f, 0.f, 0.f, 0.f};
    h16x8 At[4][2], B0[2][2], B1[2][2];
    const char* cA = (const char*)g.A + (size_t)cur.pm * tstep; const char* cB = (const char*)g.Bt + (size_t)cur.pn * tstep;
    PG8_STAGE(PG8_SB(0, 0), cB, voffB); PG8_STAGE(PG8_SB(0, 1), cB + hstep, voffB); PG8_STAGE(PG8_SA(0, 0), cA, voffA); PG8_STAGE(PG8_SA(0, 1), cA + hstep, voffA);
    if (wr == 1) PG8_BAR;
    PG8_WAIT_V(2); PG8_BAR;
    PG8_STAGE(PG8_SB(1, 0), cB + kstep, voffB); PG8_STAGE(PG8_SA(1, 0), cA + kstep, voffA); PG8_STAGE(PG8_SB(1, 1), cB + hstep + kstep, voffB);
    PG8_WAIT_V(6); PG8_BAR;
    for (;;) {
        const bool has_next = S.next(ui + 1, nxt);
        const char* nA = has_next ? (const char*)g.A + (size_t)nxt.pm * tstep : cA; const char* nB = has_next ? (const char*)g.Bt + (size_t)nxt.pn * tstep : cB;
        for (int t = 0; t < nt; t += 2) {
            const bool last = (t == nt - 2);
            const char* a1 = cA + (size_t)(t + 1) * kstep;
            const char* a2 = last ? nA : cA + (size_t)(t + 2) * kstep; const char* b2 = last ? nB : cB + (size_t)(t + 2) * kstep;
            const char* a3 = a2 + kstep; const char* b3 = b2 + kstep;
            PG8_LDB(B0, 0, 0); PG8_LDB(B1, 0, 1); PG8_SCHED; PG8_LDA(At, 0, 0); PG8_STAGE(PG8_SA(1, 1), a1 + hstep, voffA);
            PG8_WAIT_V(8); PG8_WAIT_L(0); PG8_BAR; PG8_MMA(0, 0, At, B0); PG8_MMA(0, 1, At, B1); PG8_BAR; PG8_SCHED;
            PG8_LDA(At, 0, 1); PG8_STAGE(PG8_SB(0, 0), b2, voffB); PG8_STAGE(PG8_SB(0, 1), b2 + hstep, voffB); PG8_STAGE(PG8_SA(0, 0), a2, voffA);
            PG8_WAIT_V(8); PG8_WAIT_L(0); PG8_BAR; PG8_MMA(1, 0, At, B0); PG8_MMA(1, 1, At, B1); PG8_BAR; PG8_SCHED;
            PG8_LDB(B0, 1, 0); PG8_LDB(B1, 1, 1); PG8_SCHED; PG8_LDA(At, 1, 0); PG8_STAGE(PG8_SA(0, 1), a2 + hstep, voffA);
            PG8_WAIT_V(8); PG8_WAIT_L(0); PG8_BAR; PG8_MMA(0, 0, At, B0); PG8_MMA(0, 1, At, B1); PG8_BAR; PG8_SCHED;
            PG8_LDA(At, 1, 1); PG8_STAGE(PG8_SB(1, 0), b3, voffB); PG8_STAGE(PG8_SB(1, 1), b3 + hstep, voffB); PG8_STAGE(PG8_SA(1, 0), a3, voffA);
            PG8_WAIT_V(8); PG8_WAIT_L(0); PG8_BAR; PG8_MMA(1, 0, At, B0); PG8_MMA(1, 1, At, B1); PG8_BAR; PG8_SCHED;
        }
        if (wr == 0) PG8_BAR;
        E(acc, cur, wr, wc, fr, fq);
        if (!has_next) break;
#pragma unroll
        for (int a = 0; a < 2; ++a)
#pragma unroll
            for (int b = 0; b < 2; ++b)
#pragma unroll
                for (int m = 0; m < 4; ++m)
#pragma unroll
                    for (int n = 0; n < 2; ++n) acc[a][b][m][n] = (f32x4){0.f, 0.f, 0.f, 0.f};
        cur = nxt; cA = nA; cB = nB; ++ui;
        if (wr == 1) PG8_BAR;
    }
    PG8_WAIT_V(0);
    PG8_BAR;
#undef PG8_SA
#undef PG8_SB
#undef PG8_STAGE
#undef PG8_LDA
#undef PG8_LDB
#undef PG8_MMA
#undef PG8_WAIT_V
#undef PG8_WAIT_L
#undef PG8_BAR
#undef PG8_SCHED
}
}


#define XB_TMO      128
#define XB_XCNT(j)  (256  + 64 * (j))
#define XB_XSUB(j)  (1280 + 64 * (j))
#define XB_XGEN(j)  (2304 + 64 * (j))
#define XB_TOP      3328
#define XB_TOPGEN   3392
#define XCD_BAR_WORDS 3456
#define XB_SPIN_CAP (1u << 22)
__device__ __forceinline__ unsigned xb_ld(unsigned* p)              { return __hip_atomic_load(p, __ATOMIC_RELAXED, __HIP_MEMORY_SCOPE_AGENT); }
__device__ __forceinline__ unsigned xb_add(unsigned* p, unsigned v) { return __hip_atomic_fetch_add(p, v, __ATOMIC_RELAXED, __HIP_MEMORY_SCOPE_AGENT); }
__device__ __forceinline__ unsigned xb_xcc_id() { return (unsigned)__builtin_amdgcn_s_getreg((3 << 11) | 20) & 0xFu; }
#define XB_SPIN(cond, bar) do { unsigned _sp = 0; while (cond) { __builtin_amdgcn_s_sleep(1); \
    if ((++_sp & 255u) == 0u) { if (xb_ld(&(bar)[XB_TMO])) break; if (_sp > XB_SPIN_CAP) { atomicAdd(&(bar)[XB_TMO], 1u); break; } } } } while (0)
struct XcdBarrier { unsigned* bar; unsigned x; volatile LAS unsigned* st; };
__device__ __forceinline__ XcdBarrier xcd_barrier_post(unsigned* bar, volatile LAS unsigned* st) {
    XcdBarrier b; b.bar = bar; b.x = xb_xcc_id(); b.st = st;
    if (threadIdx.x == 0) (void)xb_add(&bar[XB_XCNT(b.x)], 1u);
    return b;
}
__device__ __forceinline__ void xcd_barrier_complete(unsigned* bar, unsigned x, unsigned& nloc, unsigned& nx) {
    const unsigned G = gridDim.x * gridDim.y * gridDim.z;
    unsigned sum, cnt, mine, sp = 0u;
    for (;;) {
        sum = 0u; cnt = 0u; mine = 0u;
#pragma unroll
        for (unsigned j = 0; j < 16; ++j) { const unsigned c = xb_ld(&bar[XB_XCNT(j)]); sum += c; cnt += (c > 0u) ? 1u : 0u; mine = (j == x) ? c : mine; }
        if (sum == G) break;
        __builtin_amdgcn_s_sleep(1);
        if ((++sp & 255u) == 0u) { if (xb_ld(&bar[XB_TMO])) break; if (sp > XB_SPIN_CAP) { atomicAdd(&bar[XB_TMO], 1u); break; } }
    }
    nloc = mine > 0u ? mine : 1u; nx = cnt > 0u ? cnt : 1u;
}
__device__ __forceinline__ void xcd_barrier(const XcdBarrier& b) {
    asm volatile("s_waitcnt vmcnt(0)" ::: "memory");
    __syncthreads();
    if (threadIdx.x == 0) {
        unsigned* bar = b.bar;
        __builtin_amdgcn_s_waitcnt(0);
        unsigned nloc = b.st[0], nx = b.st[1];
        if (nloc == 0u) { xcd_barrier_complete(bar, b.x, nloc, nx); b.st[0] = nloc; b.st[1] = nx; }
        const unsigned old = xb_add(&bar[XB_XSUB(b.x)], 1u);
        const unsigned gen = old / nloc;
        if (old + 1u == (gen + 1u) * nloc) {
            __builtin_amdgcn_fence(__ATOMIC_RELEASE, "agent");
            asm volatile("s_waitcnt vmcnt(0)" ::: "memory");
            const unsigned og = xb_add(&bar[XB_TOP], 1u);
            const unsigned tg = og / nx;
            if (og + 1u == (tg + 1u) * nx) xb_add(&bar[XB_TOPGEN], 1u);
            else XB_SPIN(xb_ld(&bar[XB_TOPGEN]) == tg, bar);
            __builtin_amdgcn_fence(__ATOMIC_ACQUIRE, "agent");
            xb_add(&bar[XB_XGEN(b.x)], 1u);
            asm volatile("s_waitcnt vmcnt(0)" ::: "memory");
        } else {
            XB_SPIN(xb_ld(&bar[XB_XGEN(b.x)]) == gen, bar);
            __builtin_amdgcn_fence(__ATOMIC_ACQUIRE, "agent");
            asm volatile("s_waitcnt vmcnt(0)" ::: "memory");
        }
    }
    __syncthreads();
}

struct Ctx {
    const float* in[32]; LAS unsigned char* lds; int tid, lane, wave, gw, ngw, gtid, ngt;
    int layer, j, grp, nseq, T;
    const float* hsrc; float* hdst;
    unsigned char* ws;
};
#define IN(k) (C.in[k])

__device__ __forceinline__ void transpose_item(const float* W, int ldw, int c0, int nvalid, int K, int Npad, h16* WT, LAS float* scr, int item, int lane) {
    const int nblk = Npad / 32, kb = item / nblk, nb = item % nblk, k0 = 64 * kb, n0 = 32 * nb;
    const int n = n0 + (lane & 31);
#pragma unroll 8
    for (int i = 0; i < 32; ++i) { const int kk = 2 * i + (lane >> 5); scr[kk * 33 + (lane & 31)] = (n < nvalid) ? W[(size_t)(k0 + kk) * ldw + c0 + n] : 0.f; }
    WAVE_SYNC();
    const int c = lane & 7;
#pragma unroll
    for (int jj = 0; jj < 4; ++jj) { const int nn = (lane >> 3) + 8 * jj; const LAS float* s = scr + (8 * c) * 33 + nn;
        h16x8 o;
#pragma unroll
        for (int e = 0; e < 8; ++e) o[e] = (h16)s[e * 33];
        *(h16x8*)(WT + (size_t)(n0 + nn) * K + k0 + 8 * c) = o; }
    WAVE_SYNC();
}
__device__ __forceinline__ void phase_weights(Ctx& C) {
    LAS float* scr = (LAS float*)(C.lds + C.wave * 12288);
    const int layer = C.layer, j = C.j;
    const bool ab = (layer & 1) == 0;
    const float* Win = ab ? IN(I_ABW) + (size_t)j * D * AB_IN : IN(I_CDW) + (size_t)j * D * CD_IN;
    const int ldw = ab ? AB_IN : CD_IN;
    const int n1 = ab ? A_IN : C_IN, n1p = ab ? LDA_ : LDC_, n2 = ab ? B_IN : D_IN, n2p = ab ? LDB_ : LDD_;
    const int it1 = (D / 64) * (n1p / 32), it2 = (D / 64) * (n2p / 32), it3 = (MIXW / 64) * (D / 32), it4 = (D / 64) * (FF / 32), it5 = (FF / 64) * (D / 32);
    const int total = it1 + it2 + it3 + it4 + it5;
    for (int it = C.gw; it < total; it += C.ngw) {
        int r = it;
        if (r < it1) { transpose_item(Win, ldw, 0, n1, D, n1p, (h16*)(C.ws + W_IN1), scr, r, C.lane); continue; } r -= it1;
        if (r < it2) { transpose_item(Win, ldw, n1, n2, D, n2p, (h16*)(C.ws + W_IN2), scr, r, C.lane); continue; } r -= it2;
        if (r < it3) { transpose_item(IN(I_WOUT) + (size_t)layer * MIXW * D, D, 0, D, MIXW, D, (h16*)(C.ws + W_OUT), scr, r, C.lane); continue; } r -= it3;
        if (r < it4) { transpose_item(IN(I_W1) + (size_t)layer * D * FF, FF, 0, FF, D, FF, (h16*)(C.ws + W_F1), scr, r, C.lane); continue; } r -= it4;
        transpose_item(IN(I_W2) + (size_t)layer * FF * D, D, 0, D, FF, D, (h16*)(C.ws + W_F2), scr, r, C.lane);
    }
    if (layer == 0) {
        float* rot = (float*)(C.ws + WS_ROT);
        for (int idx = C.gtid; idx < 16384 * 64; idx += C.ngt) { const int t = idx >> 6, i = idx & 63;
            const float invf = exp2f(-(float)i * (13.287712379549449f / 64.f)); const float ang = (float)t * invf;
            rot[t * 128 + i] = cosf(ang); rot[t * 128 + 64 + i] = sinf(ang); }
    }
}
__device__ __forceinline__ void phase_norm(Ctx& C, const float* src, const float* gain, h16* dst) {
    const f32x4 g0 = ((const f32x4*)gain)[C.lane], g1 = ((const f32x4*)gain)[64 + C.lane], g2 = ((const f32x4*)gain)[128 + C.lane], g3 = ((const f32x4*)gain)[192 + C.lane];
    for (int m = C.gw; m < MG; m += C.ngw) {
        const f32x4* xr = (const f32x4*)(src + (size_t)m * D) + C.lane;
        f32x4 v[4]; float s = 0.f;
#pragma unroll
        for (int q = 0; q < 4; ++q) { v[q] = xr[64 * q]; s += (v[q].x * v[q].x + v[q].y * v[q].y) + (v[q].z * v[q].z + v[q].w * v[q].w); }
        const float rstd = rsqrtf(wave_sum(s) * (1.f / D) + 1e-5f);
        v[0] = v[0] * g0 * rstd; v[1] = v[1] * g1 * rstd; v[2] = v[2] * g2 * rstd; v[3] = v[3] * g3 * rstd;
        h16x4* o = (h16x4*)(dst + (size_t)m * D) + C.lane;
#pragma unroll
        for (int q = 0; q < 4; ++q) { h16x4 w; w[0] = (h16)v[q].x; w[1] = (h16)v[q].y; w[2] = (h16)v[q].z; w[3] = (h16)v[q].w; o[64 * q] = w; }
    }
}
__device__ __forceinline__ void phase_final_norm(Ctx& C, float* io, const float* gain) {
    const f32x4 g0 = ((const f32x4*)gain)[C.lane], g1 = ((const f32x4*)gain)[64 + C.lane], g2 = ((const f32x4*)gain)[128 + C.lane], g3 = ((const f32x4*)gain)[192 + C.lane];
    for (int m = C.gw; m < 2 * MG; m += C.ngw) {
        f32x4* xr = (f32x4*)(io + (size_t)m * D) + C.lane;
        f32x4 v[4]; float s = 0.f;
#pragma unroll
        for (int q = 0; q < 4; ++q) { v[q] = xr[64 * q]; s += (v[q].x * v[q].x + v[q].y * v[q].y) + (v[q].z * v[q].z + v[q].w * v[q].w); }
        const float rstd = rsqrtf(wave_sum(s) * (1.f / D) + 1e-5f);
        xr[0] = v[0] * g0 * rstd; xr[64] = v[1] * g1 * rstd; xr[128] = v[2] * g2 * rstd; xr[192] = v[3] * g3 * rstd;
    }
}

template <int KS, int MODE, int NT>
__device__ __forceinline__ void rwkv_lora(Ctx& C, int col0, const float* Wl, const float* bias, h16* outp, int ldo, int noff) {
    const int lane = C.lane, fr = lane & 15, fq = lane >> 4, w = C.wave, T = C.T;
    const h16* U = (const h16*)(C.ws + WS_U);
    const float* mu0p = IN(I_MU) + (size_t)C.j * 2 * A_IN, *mu1p = mu0p + A_IN;
    h16x8 bf[NT][KS];
#pragma unroll
    for (int nt = 0; nt < NT; ++nt)
#pragma unroll
        for (int ks = 0; ks < KS; ++ks)
#pragma unroll
            for (int e = 0; e < 8; ++e) bf[nt][ks][e] = (h16)Wl[(size_t)(ks * 32 + fq * 8 + e) * 512 + w * 64 + noff + nt * 16 + fr];
    float bv[NT];
#pragma unroll
    for (int nt = 0; nt < NT; ++nt) bv[nt] = bias ? bias[w * 64 + noff + nt * 16 + fr] : 0.f;
    for (int tile = blockIdx.x; tile < MG / 16; tile += gridDim.x) {
        f32x4 acc[NT];
#pragma unroll
        for (int nt = 0; nt < NT; ++nt) acc[nt] = (f32x4){0.f, 0.f, 0.f, 0.f};
        const int tok = tile * 16 + fr, t = tok % T;
#pragma unroll
        for (int ks = 0; ks < KS; ++ks) {
            const int c = col0 + ks * 32 + fq * 8;
            const h16* up = U + (size_t)tok * LDA_ + c;
            const h16x8 cur = *(const h16x8*)up;
            h16x8 prv, nxt;
#pragma unroll
            for (int e = 0; e < 8; ++e) { prv[e] = (h16)0.f; nxt[e] = (h16)0.f; }
            if (t > 0) prv = *(const h16x8*)(up - LDA_);
            if (t < T - 1) nxt = *(const h16x8*)(up + LDA_);
            h16x8 af;
#pragma unroll
            for (int e = 0; e < 8; ++e) { const float x = (float)cur[e]; float y = x + mu0p[c + e] * ((float)prv[e] - x) + mu1p[c + e] * ((float)nxt[e] - x);
                if (MODE == 0) y = tanhf(y); else if (MODE == 2) y = sigm(y);
                af[e] = (h16)y; }
#pragma unroll
            for (int nt = 0; nt < NT; ++nt) acc[nt] = __builtin_amdgcn_mfma_f32_16x16x32_f16(af, bf[nt][ks], acc[nt], 0, 0, 0);
        }
#pragma unroll
        for (int nt = 0; nt < NT; ++nt)
#pragma unroll
            for (int e = 0; e < 4; ++e) { const int otok = tile * 16 + fq * 4 + e, n = w * 64 + noff + nt * 16 + fr; float y = acc[nt][e] + bv[nt];
                if (MODE == 0) y = sigm(y) * 0.6065306597126334f; else if (MODE == 1) y = sigm(y);
                outp[(size_t)otok * ldo + n] = (h16)y; }
    }
}
__device__ __forceinline__ void rwkv_pre(Ctx& C) {
    h16* U2 = (h16*)(C.ws + WS_U + 64 * MiB); h16* G = (h16*)(C.ws + WS_MIX) + 512;
    const int j = C.j;
    for (int d = 0; d < 2; ++d) {
        rwkv_lora<2, 0, 4>(C, 1536 + 64 * d, IN(I_RW2) + (size_t)(j * 2 + d) * 64 * 512, IN(I_W0) + (size_t)(j * 2 + d) * 512, U2 + d * 1024, 2048, 0);
        rwkv_lora<2, 1, 4>(C, 1664 + 64 * d, IN(I_A2) + (size_t)(j * 2 + d) * 64 * 512, IN(I_A0) + (size_t)(j * 2 + d) * 512, U2 + d * 1024 + 512, 2048, 0);
    }
    for (int hf = 0; hf < 2; ++hf) rwkv_lora<4, 2, 2>(C, 1792, IN(I_G2) + (size_t)j * 128 * 512, nullptr, G, MIXW, hf * 32);
}
template <int PASS>
__device__ __forceinline__ void rwkv_scan(Ctx& C) {
    const int lane = C.lane, T = C.T, NC = T / CH_R, j = C.j;
    const int nunits = C.nseq * 2 * NC * 8;
    const h16* U = (const h16*)(C.ws + WS_U); const h16* U2 = (const h16*)(C.ws + WS_U + 64 * MiB);
    LAS float* wl = (LAS float*)(C.lds + C.wave * 12288);
    const float* mu0p = IN(I_MU) + (size_t)j * 2 * A_IN, *mu1p = mu0p + A_IN;
    for (int unit = C.gw; unit < nunits; unit += C.ngw) {
        const int hd = unit & 7; int r = unit >> 3; const int c = r % NC; r /= NC; const int dir = r & 1, b = r >> 1;
        const int col = hd * 64 + lane;
        const float m0r = mu0p[col], m1r = mu1p[col], m0k = mu0p[512 + col], m1k = mu1p[512 + col], m0v = mu0p[1024 + col], m1v = mu1p[1024 + col];
        const float kkw = IN(I_KK)[j * 512 + col], kaw = IN(I_KA)[j * 512 + col];
        float* slot = (float*)(C.ws + WS_ST) + (size_t)((((b * 2 + dir) * NC + c) * 8) + hd) * 8192;
        float S[64], P[64];
        if (PASS == 1) {
            int ln = lane; asm volatile("" : "+v"(ln));
#pragma unroll
            for (int q = 0; q < 64; ++q) { S[q] = 0.f; P[q] = (q == ln) ? 1.f : 0.f; }
        } else {
#pragma unroll
            for (int q = 0; q < 16; ++q) { const f32x4 v = *(const f32x4*)(slot + lane * 64 + q * 4); S[4 * q] = v.x; S[4 * q + 1] = v.y; S[4 * q + 2] = v.z; S[4 * q + 3] = v.w; }
        }
        h16* outp = (dir == 0) ? (h16*)(C.ws + WS_MIX) : (h16*)(C.ws + WS_O);
        const int ldo = (dir == 0) ? MIXW : 512;
#pragma unroll 1
        for (int sub = 0; sub < CH_R / SUB; ++sub) {
#pragma unroll 1
            for (int s = 0; s < SUB; ++s) {
                const int p = c * CH_R + sub * SUB + s, t = dir ? T - 1 - p : p; const size_t tok = (size_t)b * T + t;
                const h16* ur = U + tok * LDA_ + col;
                const float rc = (float)ur[0], kc = (float)ur[512], vc = (float)ur[1024];
                float rp = 0.f, kp = 0.f, vp = 0.f, rn = 0.f, kn = 0.f, vn = 0.f;
                if (t > 0) { rp = (float)ur[-LDA_]; kp = (float)ur[512 - LDA_]; vp = (float)ur[1024 - LDA_]; }
                if (t < T - 1) { rn = (float)ur[LDA_]; kn = (float)ur[512 + LDA_]; vn = (float)ur[1024 + LDA_]; }
                const float rr = rc + m0r * (rp - rc) + m1r * (rn - rc), kk_ = kc + m0k * (kp - kc) + m1k * (kn - kc), vv = vc + m0v * (vp - vc) + m1v * (vn - vc);
                const float e = (float)U2[tok * 2048 + dir * 1024 + col], av = (float)U2[tok * 2048 + dir * 1024 + 512 + col];
                const float wdec = __expf(-e);
                const float kx = kk_ * kkw; const float n2 = wave_sum(kx * kx); const float kkn = kx / fmaxf(sqrtf(n2), 1e-12f);
                LAS float* q = wl + s * 384;
                q[lane] = wdec; q[64 + lane] = kkn; q[128 + lane] = kkn * av; q[192 + lane] = kk_ * (1.f + (av - 1.f) * kaw); q[256 + lane] = rr; q[320 + lane] = vv;
            }
            WAVE_SYNC();
#pragma unroll 1
            for (int s = 0; s < SUB; ++s) {
                const LAS f32x4* q = (const LAS f32x4*)(wl + s * 384);
                const float vv = wl[s * 384 + 320 + lane];
                float sa0 = 0.f, sa1 = 0.f, sp0 = 0.f, sp1 = 0.f;
#pragma unroll
                for (int k4 = 0; k4 < 16; ++k4) { const f32x4 kk4 = q[16 + k4];
                    sa0 += S[4 * k4] * kk4.x + S[4 * k4 + 2] * kk4.z; sa1 += S[4 * k4 + 1] * kk4.y + S[4 * k4 + 3] * kk4.w;
                    if (PASS == 1) { sp0 += P[4 * k4] * kk4.x + P[4 * k4 + 2] * kk4.z; sp1 += P[4 * k4 + 1] * kk4.y + P[4 * k4 + 3] * kk4.w; }
                    if ((k4 & 3) == 3) __builtin_amdgcn_sched_barrier(0); }
                const float sa = -(sa0 + sa1), sp = -(sp0 + sp1);
                float o0 = 0.f, o1 = 0.f;
#pragma unroll
                for (int k4 = 0; k4 < 16; ++k4) { const f32x4 w4 = q[k4], b4 = q[32 + k4], d4 = q[48 + k4];
                    S[4 * k4] = S[4 * k4] * w4.x + sa * b4.x + vv * d4.x; S[4 * k4 + 1] = S[4 * k4 + 1] * w4.y + sa * b4.y + vv * d4.y;
                    S[4 * k4 + 2] = S[4 * k4 + 2] * w4.z + sa * b4.z + vv * d4.z; S[4 * k4 + 3] = S[4 * k4 + 3] * w4.w + sa * b4.w + vv * d4.w;
                    if (PASS == 1) { P[4 * k4] = P[4 * k4] * w4.x + sp * b4.x; P[4 * k4 + 1] = P[4 * k4 + 1] * w4.y + sp * b4.y; P[4 * k4 + 2] = P[4 * k4 + 2] * w4.z + sp * b4.z; P[4 * k4 + 3] = P[4 * k4 + 3] * w4.w + sp * b4.w; }
                    else { const f32x4 r4 = q[64 + k4]; o0 += S[4 * k4] * r4.x + S[4 * k4 + 2] * r4.z; o1 += S[4 * k4 + 1] * r4.y + S[4 * k4 + 3] * r4.w; }
                    if ((k4 & 1) == 1) __builtin_amdgcn_sched_barrier(0); }
                if (PASS == 2) { const int p = c * CH_R + sub * SUB + s, t = dir ? T - 1 - p : p; outp[((size_t)b * T + t) * ldo + col] = (h16)(o0 + o1); }
            }
            WAVE_SYNC();
        }
        if (PASS == 1) {
#pragma unroll
            for (int q = 0; q < 16; ++q) { *(f32x4*)(slot + lane * 64 + q * 4) = (f32x4){S[4 * q], S[4 * q + 1], S[4 * q + 2], S[4 * q + 3]};
                *(f32x4*)(slot + 4096 + lane * 64 + q * 4) = (f32x4){P[4 * q], P[4 * q + 1], P[4 * q + 2], P[4 * q + 3]}; }
        }
    }
}
__device__ __forceinline__ void rwkv_cross(Ctx& C) {
    const int T = C.T, NC = T / CH_R, nchains = C.nseq * 16, tid = C.tid;
    LAS float* Cs = (LAS float*)C.lds; LAS float* Ps = Cs + 64 * 65;
    const int i = tid >> 3, jg = tid & 7;
    for (int chain = blockIdx.x; chain < nchains; chain += gridDim.x) {
        const int hd = chain & 7, dir = (chain >> 3) & 1, b = chain >> 4;
        float cr[8];
#pragma unroll
        for (int k = 0; k < 8; ++k) cr[k] = 0.f;
        for (int c = 0; c < NC; ++c) {
            float* base = (float*)(C.ws + WS_ST) + (size_t)((((b * 2 + dir) * NC + c) * 8) + hd) * 8192;
            const f32x4 s0 = *(const f32x4*)(base + i * 64 + jg * 8), s1 = *(const f32x4*)(base + i * 64 + jg * 8 + 4);
            const f32x4 p0 = *(const f32x4*)(base + 4096 + tid * 8), p1 = *(const f32x4*)(base + 4096 + tid * 8 + 4);
            *(LAS f32x4*)(Ps + tid * 8) = p0; *(LAS f32x4*)(Ps + tid * 8 + 4) = p1;
#pragma unroll
            for (int k = 0; k < 8; ++k) Cs[i * 65 + jg * 8 + k] = cr[k];
            *(f32x4*)(base + i * 64 + jg * 8) = (f32x4){cr[0], cr[1], cr[2], cr[3]}; *(f32x4*)(base + i * 64 + jg * 8 + 4) = (f32x4){cr[4], cr[5], cr[6], cr[7]};
            __syncthreads();
            float nr[8] = {s0.x, s0.y, s0.z, s0.w, s1.x, s1.y, s1.z, s1.w};
#pragma unroll 8
            for (int m = 0; m < 64; ++m) { const float cm = Cs[i * 65 + m]; const f32x4 a0 = *(const LAS f32x4*)(Ps + m * 64 + jg * 8), a1 = *(const LAS f32x4*)(Ps + m * 64 + jg * 8 + 4);
                nr[0] += cm * a0.x; nr[1] += cm * a0.y; nr[2] += cm * a0.z; nr[3] += cm * a0.w; nr[4] += cm * a1.x; nr[5] += cm * a1.y; nr[6] += cm * a1.z; nr[7] += cm * a1.w; }
            __syncthreads();
#pragma unroll
            for (int k = 0; k < 8; ++k) cr[k] = nr[k];
        }
    }
}
__device__ __forceinline__ void rwkv_final(Ctx& C) {
    const int lane = C.lane, T = C.T, j = C.j, c0 = lane * 8;
    const h16* U = (const h16*)(C.ws + WS_U); h16* MIX = (h16*)(C.ws + WS_MIX); const h16* O = (const h16*)(C.ws + WS_O);
    const float* mu0p = IN(I_MU) + (size_t)j * 2 * A_IN, *mu1p = mu0p + A_IN;
    for (int tok = C.gw; tok < MG; tok += C.ngw) {
        const int t = tok % T;
        const h16x8 of = *(const h16x8*)(MIX + (size_t)tok * MIXW + c0), ob = *(const h16x8*)(O + (size_t)tok * 512 + c0), gg = *(const h16x8*)(MIX + (size_t)tok * MIXW + 512 + c0);
        float o[8], s = 0.f;
#pragma unroll
        for (int e = 0; e < 8; ++e) { o[e] = (float)of[e] + (float)ob[e]; s += o[e]; }
        s += __shfl_xor(s, 1); s += __shfl_xor(s, 2); s += __shfl_xor(s, 4);
        const float mean = s * (1.f / 64.f); float v2 = 0.f;
#pragma unroll
        for (int e = 0; e < 8; ++e) { o[e] -= mean; v2 += o[e] * o[e]; }
        v2 += __shfl_xor(v2, 1); v2 += __shfl_xor(v2, 2); v2 += __shfl_xor(v2, 4);
        const float rstd = rsqrtf(v2 * (1.f / 64.f) + 64e-5f);
        float rv[3][8];
#pragma unroll
        for (int part = 0; part < 3; ++part) {
            const h16* up = U + (size_t)tok * LDA_ + part * 512 + c0;
            const h16x8 cur = *(const h16x8*)up; h16x8 prv, nxt;
#pragma unroll
            for (int e = 0; e < 8; ++e) { prv[e] = (h16)0.f; nxt[e] = (h16)0.f; }
            if (t > 0) prv = *(const h16x8*)(up - LDA_);
            if (t < T - 1) nxt = *(const h16x8*)(up + LDA_);
#pragma unroll
            for (int e = 0; e < 8; ++e) { const float x = (float)cur[e]; rv[part][e] = x + mu0p[part * 512 + c0 + e] * ((float)prv[e] - x) + mu1p[part * 512 + c0 + e] * ((float)nxt[e] - x); }
        }
        float rk = 0.f;
#pragma unroll
        for (int e = 0; e < 8; ++e) rk += rv[0][e] * rv[1][e] * IN(I_RK)[j * 512 + c0 + e];
        rk += __shfl_xor(rk, 1); rk += __shfl_xor(rk, 2); rk += __shfl_xor(rk, 4);
        h16x8 w;
#pragma unroll
        for (int e = 0; e < 8; ++e) { const float y = o[e] * rstd * IN(I_GNW)[j * 512 + c0 + e] + IN(I_GNB)[j * 512 + c0 + e]; w[e] = (h16)((y + rk * rv[2][e]) * (float)gg[e]); }
        *(h16x8*)(MIX + (size_t)tok * MIXW + c0) = w;
    }
}

enum { MX_MAMBA = 0, MX_HGRN = 1, MX_RET = 2 };
template <int MX> struct MXC;
template <> struct MXC<MX_MAMBA> { static constexpr int CH = CH_M, NH = 16, LDU = LDB_; };
template <> struct MXC<MX_HGRN>  { static constexpr int CH = CH_H, NH = 8,  LDU = LDC_; };
template <> struct MXC<MX_RET>   { static constexpr int CH = CH_T, NH = 16, LDU = LDD_; };

__device__ __forceinline__ float ret_gamma(Ctx& C, int dir, int head) { return __expf(-__expf(IN(I_RETLD)[(C.j * 2 + dir) * 4 + head])); }

__device__ __forceinline__ void mamba_pre(Ctx& C) {
    const int T = C.T, j = C.j;
    const h16* U = (const h16*)(C.ws + WS_U); h16* BC = (h16*)(C.ws + WS_U + 88 * MiB); float* DT = (float*)(C.ws + WS_U + 104 * MiB); h16* XS = (h16*)(C.ws + WS_ST + 32 * MiB);
    const float* cw = IN(I_CONVW) + (size_t)j * 4 * 1536; const float* cb = IN(I_CONVB) + (size_t)j * 1536;
    for (int idx = C.gtid; idx < MG * 192; idx += C.ngt) {
        const int tok = idx / 192, q = idx - tok * 192, t = tok % T, c = q * 8;
        float acc[8];
#pragma unroll
        for (int e = 0; e < 8; ++e) acc[e] = cb[c + e];
#pragma unroll
        for (int jj = 0; jj < 4; ++jj) { const int tt = t + jj - 2;
            if (tt >= 0 && tt < T) { const h16x8 x = *(const h16x8*)(U + (size_t)(tok + jj - 2) * LDB_ + 1024 + c);
#pragma unroll
                for (int e = 0; e < 8; ++e) acc[e] += cw[jj * 1536 + c + e] * (float)x[e]; } }
        h16x8 w;
#pragma unroll
        for (int e = 0; e < 8; ++e) w[e] = (h16)silu(acc[e]);
        if (c < 1024) *(h16x8*)(XS + (size_t)tok * 1024 + c) = w; else *(h16x8*)(BC + (size_t)tok * 512 + (c - 1024)) = w;
    }
    for (int idx = C.gtid; idx < MG * 32; idx += C.ngt) { const int tok = idx >> 5, q = idx & 31;
        const float x = (float)U[(size_t)tok * LDB_ + 2560 + q] + IN(I_DTB)[j * 32 + q];
        const float dt = (x > 20.f) ? x : log1pf(expf(x)); const float da = -dt * expf(IN(I_ALOG)[j * 32 + q]);
        DT[(size_t)tok * 64 + q] = dt; DT[(size_t)tok * 64 + 32 + q] = da; }
}

constexpr int MC_OFF = 0, MB_OFF = 17408, MX_OFF = 36864, MG_OFF = 110592, MA_OFF = 119808;
__device__ __forceinline__ void mamba_stage_bc(Ctx& C, LAS h16* dst, bool transposed, int colbase, int b, int dir, int p0) {
    const int T = C.T, m = C.tid >> 3, i0 = (C.tid & 7) * 16;
    const int p = p0 + m, t = dir ? T - 1 - p : p; const size_t tok = (size_t)b * T + t;
    const h16* BC = (const h16*)(C.ws + WS_U + 88 * MiB);
    const h16x8 x1 = *(const h16x8*)(BC + tok * 512 + colbase + i0), x2 = *(const h16x8*)(BC + tok * 512 + colbase + i0 + 8);
    if (!transposed) { *(LAS h16x8*)(dst + m * 136 + i0) = x1; *(LAS h16x8*)(dst + m * 136 + i0 + 8) = x2; }
    else {
#pragma unroll
        for (int e = 0; e < 8; ++e) { dst[(i0 + e) * 72 + m] = x1[e]; dst[(i0 + 8 + e) * 72 + m] = x2[e]; } }
}
template <bool WEIGHTED>
__device__ __forceinline__ void mamba_stage_xt(Ctx& C, LAS h16* Xt, const LAS float* As, int g, int b, int dir, int p0, int lbase) {
    const int T = C.T; const h16* XS = (const h16*)(C.ws + WS_ST + 32 * MiB); const float* DT = (const float*)(C.ws + WS_U + 104 * MiB);
#pragma unroll 2
    for (int q = 0; q < 8; ++q) { const int it = C.tid + 512 * q, m = it >> 6, cb = it & 63, hl = cb >> 3;
        const int p = p0 + m, t = dir ? T - 1 - p : p; const size_t tok = (size_t)b * T + t;
        const h16x8 x = *(const h16x8*)(XS + tok * 1024 + g * 512 + cb * 8);
        float sc = DT[tok * 64 + dir * 16 + g * 8 + hl];
        if (WEIGHTED) sc *= __expf(As[hl * 256 + 255] - As[hl * 256 + lbase + m]);
#pragma unroll
        for (int e = 0; e < 8; ++e) Xt[(cb * 8 + e) * 72 + m] = (h16)((float)x[e] * sc); }
}
__device__ __forceinline__ void mamba_cum_decay(Ctx& C, LAS float* As, int g, int b, int dir, int c) {
    const int T = C.T, lane = C.lane, w = C.wave; const float* DT = (const float*)(C.ws + WS_U + 104 * MiB);
    float d[4]; float s = 0.f;
#pragma unroll
    for (int i = 0; i < 4; ++i) { const int p = c * 256 + 4 * lane + i, t = dir ? T - 1 - p : p; d[i] = DT[((size_t)b * T + t) * 64 + 32 + dir * 16 + g * 8 + w]; s += d[i]; d[i] = s; }
    float inc = s;
#pragma unroll
    for (int off = 1; off < 64; off <<= 1) { const float tv = __shfl_up(inc, off); if (lane >= off) inc += tv; }
    const float ex = inc - s;
#pragma unroll
    for (int i = 0; i < 4; ++i) As[w * 256 + 4 * lane + i] = ex + d[i];
}
__device__ __forceinline__ void mamba_mfma_pass1(Ctx& C) {
    const int T = C.T, NCH = T / 256, nunits = C.nseq * 2 * NCH * 2, lane = C.lane, w = C.wave, fr = lane & 15, fq = lane >> 4;
    LAS h16* Bt = (LAS h16*)(C.lds + MB_OFF); LAS h16* Xt = (LAS h16*)(C.lds + MX_OFF); LAS float* As = (LAS float*)(C.lds + MA_OFF);
    for (int unit = blockIdx.x; unit < nunits; unit += gridDim.x) {
        const int g = unit & 1; int r = unit >> 1; const int c = r % NCH; r /= NCH; const int dir = r & 1, b = r >> 1;
        __syncthreads();
        mamba_cum_decay(C, As, g, b, dir, c);
        f32x4 acc[8][4];
#pragma unroll
        for (int mt = 0; mt < 8; ++mt)
#pragma unroll
            for (int nt = 0; nt < 4; ++nt) acc[mt][nt] = (f32x4){0.f, 0.f, 0.f, 0.f};
#pragma unroll 1
        for (int jb = 0; jb < 4; ++jb) {
            __syncthreads();
            mamba_stage_bc(C, Bt, true, g * 128, b, dir, c * 256 + 64 * jb);
            mamba_stage_xt<true>(C, Xt, As, g, b, dir, c * 256 + 64 * jb, 64 * jb);
            __syncthreads();
#pragma unroll
            for (int ks = 0; ks < 2; ++ks) {
                h16x8 bx[4];
#pragma unroll
                for (int nt = 0; nt < 4; ++nt) bx[nt] = *(const LAS h16x8*)(Xt + (64 * w + 16 * nt + fr) * 72 + ks * 32 + fq * 8);
#pragma unroll
                for (int mt = 0; mt < 8; ++mt) { const h16x8 a = *(const LAS h16x8*)(Bt + (16 * mt + fr) * 72 + ks * 32 + fq * 8);
#pragma unroll
                    for (int nt = 0; nt < 4; ++nt) acc[mt][nt] = __builtin_amdgcn_mfma_f32_16x16x32_f16(a, bx[nt], acc[mt][nt], 0, 0, 0); }
            }
        }
        const int slot = (((b * 2 + dir) * NCH + c) * 16) + g * 8 + w;
        h16* Hg = (h16*)(C.ws + WS_ST) + (size_t)slot * 8192;
#pragma unroll
        for (int mt = 0; mt < 8; ++mt)
#pragma unroll
            for (int nt = 0; nt < 4; ++nt) { h16x4 v; v[0] = (h16)acc[mt][nt][0]; v[1] = (h16)acc[mt][nt][1]; v[2] = (h16)acc[mt][nt][2]; v[3] = (h16)acc[mt][nt][3];
                *(h16x4*)(Hg + (size_t)(16 * nt + fr) * 128 + 16 * mt + fq * 4) = v; }
        if (lane == 0) ((float*)(C.ws + WS_DEC))[slot] = __expf(As[w * 256 + 255]);
    }
}
__device__ __forceinline__ void mamba_mfma_cross(Ctx& C) {
    const int T = C.T, NCH = T / 256, nchains = C.nseq * 2 * 16;
    const float* DEC = (const float*)(C.ws + WS_DEC);
    for (int idx = C.gtid; idx < nchains * 1024; idx += C.ngt) {
        const int chain = idx >> 10, e8 = (idx & 1023) * 8, hd = chain & 15, dir = (chain >> 4) & 1, b = chain >> 5;
        float carry[8];
#pragma unroll
        for (int e = 0; e < 8; ++e) carry[e] = 0.f;
#pragma unroll 2
        for (int c = 0; c < NCH; ++c) { const int slot = (((b * 2 + dir) * NCH + c) * 16) + hd; h16* p = (h16*)(C.ws + WS_ST) + (size_t)slot * 8192 + e8;
            const h16x8 sl = *(const h16x8*)p; const float d = DEC[slot]; h16x8 o;
#pragma unroll
            for (int e = 0; e < 8; ++e) { o[e] = (h16)carry[e]; carry[e] = d * carry[e] + (float)sl[e]; }
            *(h16x8*)p = o; }
    }
}
__device__ __forceinline__ void mamba_mfma_pass2(Ctx& C) {
    const int T = C.T, NCH = T / 256, nunits = C.nseq * 2 * NCH * 2, lane = C.lane, w = C.wave, fr = lane & 15, fq = lane >> 4;
    LAS h16* Cs = (LAS h16*)(C.lds + MC_OFF); LAS h16* Bs = (LAS h16*)(C.lds + MB_OFF); LAS h16* Xt = (LAS h16*)(C.lds + MX_OFF); LAS h16* Gs = (LAS h16*)(C.lds + MG_OFF); LAS float* As = (LAS float*)(C.lds + MA_OFF);
    for (int unit = blockIdx.x; unit < nunits; unit += gridDim.x) {
        const int g = unit & 1; int r = unit >> 1; const int c = r % NCH; r /= NCH; const int dir = r & 1, b = r >> 1;
        const int hd = g * 8 + w;
        __syncthreads();
        mamba_cum_decay(C, As, g, b, dir, c);
        const int slot = (((b * 2 + dir) * NCH + c) * 16) + hd;
        const h16* Hg = (const h16*)(C.ws + WS_ST) + (size_t)slot * 8192;
        h16* outp; int ldo; if (dir == 0) { outp = (h16*)(C.ws + WS_MIX) + 512; ldo = MIXW; } else { outp = (h16*)(C.ws + WS_O); ldo = 1024; }
#pragma unroll 1
        for (int ib = 0; ib < 4; ++ib) {
            f32x4 acc[4][4];
#pragma unroll
            for (int mt = 0; mt < 4; ++mt)
#pragma unroll
                for (int nt = 0; nt < 4; ++nt) acc[mt][nt] = (f32x4){0.f, 0.f, 0.f, 0.f};
#pragma unroll 1
            for (int jb = 0; jb <= ib; ++jb) {
                __syncthreads();
                if (jb == 0) mamba_stage_bc(C, Cs, false, 256 + g * 128, b, dir, c * 256 + 64 * ib);
                mamba_stage_bc(C, Bs, false, g * 128, b, dir, c * 256 + 64 * jb);
                mamba_stage_xt<false>(C, Xt, As, g, b, dir, c * 256 + 64 * jb, 0);
                __syncthreads();
                if (jb == 0) {
#pragma unroll
                    for (int ks = 0; ks < 4; ++ks) { h16x8 hf[4];
#pragma unroll
                        for (int nt = 0; nt < 4; ++nt) hf[nt] = *(const h16x8*)(Hg + (size_t)(16 * nt + fr) * 128 + ks * 32 + fq * 8);
#pragma unroll
                        for (int mt = 0; mt < 4; ++mt) { const h16x8 a = *(const LAS h16x8*)(Cs + (16 * mt + fr) * 136 + ks * 32 + fq * 8);
#pragma unroll
                            for (int nt = 0; nt < 4; ++nt) acc[mt][nt] = __builtin_amdgcn_mfma_f32_16x16x32_f16(a, hf[nt], acc[mt][nt], 0, 0, 0); } }
#pragma unroll
                    for (int mt = 0; mt < 4; ++mt)
#pragma unroll
                        for (int jj = 0; jj < 4; ++jj) { const float rs = __expf(As[w * 256 + 64 * ib + 16 * mt + fq * 4 + jj]);
#pragma unroll
                            for (int nt = 0; nt < 4; ++nt) acc[mt][nt][jj] *= rs; }
                }
                {
                    const int gm = w >> 1, gn = w & 1;
                    f32x4 g0 = (f32x4){0.f, 0.f, 0.f, 0.f}, g1 = (f32x4){0.f, 0.f, 0.f, 0.f};
#pragma unroll
                    for (int ks = 0; ks < 4; ++ks) { const h16x8 a = *(const LAS h16x8*)(Cs + (16 * gm + fr) * 136 + ks * 32 + fq * 8);
                        const h16x8 k0 = *(const LAS h16x8*)(Bs + (32 * gn + fr) * 136 + ks * 32 + fq * 8), k1 = *(const LAS h16x8*)(Bs + (32 * gn + 16 + fr) * 136 + ks * 32 + fq * 8);
                        g0 = __builtin_amdgcn_mfma_f32_16x16x32_f16(a, k0, g0, 0, 0, 0); g1 = __builtin_amdgcn_mfma_f32_16x16x32_f16(a, k1, g1, 0, 0, 0); }
#pragma unroll
                    for (int jj = 0; jj < 4; ++jj) { const int l = 16 * gm + fq * 4 + jj; Gs[l * 72 + 32 * gn + fr] = (h16)g0[jj]; Gs[l * 72 + 32 * gn + 16 + fr] = (h16)g1[jj]; }
                }
                __syncthreads();
#pragma unroll
                for (int ks = 0; ks < 2; ++ks) {
                    h16x8 bx[4];
#pragma unroll
                    for (int nt = 0; nt < 4; ++nt) bx[nt] = *(const LAS h16x8*)(Xt + (64 * w + 16 * nt + fr) * 72 + ks * 32 + fq * 8);
                    const LAS float* Am = As + w * 256 + 64 * jb + ks * 32 + fq * 8;
                    const f32x4 am0 = *(const LAS f32x4*)Am, am1 = *(const LAS f32x4*)(Am + 4);
                    const float am[8] = {am0.x, am0.y, am0.z, am0.w, am1.x, am1.y, am1.z, am1.w};
                    const int Mb = 64 * jb + ks * 32 + fq * 8;
#pragma unroll
                    for (int mt = 0; mt < 4; ++mt) { const int l = 16 * mt + fr, Lg = 64 * ib + l; const float Al = As[w * 256 + Lg];
                        const h16x8 gr = *(const LAS h16x8*)(Gs + l * 72 + ks * 32 + fq * 8); h16x8 a;
#pragma unroll
                        for (int e = 0; e < 8; ++e) a[e] = (h16)((Mb + e <= Lg) ? (float)gr[e] * __expf(Al - am[e]) : 0.f);
#pragma unroll
                        for (int nt = 0; nt < 4; ++nt) acc[mt][nt] = __builtin_amdgcn_mfma_f32_16x16x32_f16(a, bx[nt], acc[mt][nt], 0, 0, 0); }
                }
            }
#pragma unroll
            for (int mt = 0; mt < 4; ++mt)
#pragma unroll
                for (int jj = 0; jj < 4; ++jj) { const int Lg = 64 * ib + 16 * mt + fq * 4 + jj; const int p = c * 256 + Lg, t = dir ? T - 1 - p : p; h16* op = outp + ((size_t)b * T + t) * ldo + hd * 64 + fr;
#pragma unroll
                    for (int nt = 0; nt < 4; ++nt) op[16 * nt] = (h16)acc[mt][nt][jj]; }
        }
    }
}

template <int MX, int PASS>
__device__ __forceinline__ void diag_scan(Ctx& C) {
    constexpr int CH = MXC<MX>::CH, NH = MXC<MX>::NH, LDU = MXC<MX>::LDU;
    const int lane = C.lane, T = C.T, NC = T / CH, j = C.j;
    const int nunits = C.nseq * 2 * NC * NH;
    const h16* U = (const h16*)(C.ws + WS_U);
    const h16* BC = (const h16*)(C.ws + WS_U + 88 * MiB); const float* DT = (const float*)(C.ws + WS_U + 104 * MiB);
    const float* ROT = (const float*)(C.ws + WS_ROT);
    float* DEC = (float*)(C.ws + WS_DEC);
    LAS float* wl = (LAS float*)(C.lds + C.wave * 12288);
    for (int unit = C.gw; unit < nunits; unit += C.ngw) {
        const int hd = unit % NH; int r = unit / NH; const int c = r % NC; r /= NC; const int dir = r & 1, b = r >> 1;
        const int slotid = ((b * 2 + dir) * NC + c) * NH + hd;
        float* slot = (float*)(C.ws + WS_ST) + (size_t)slotid * 8192;
        float S[128];
        if (PASS == 1) {
#pragma unroll
            for (int q = 0; q < 128; ++q) S[q] = 0.f;
        } else {
#pragma unroll
            for (int q = 0; q < 128; ++q) S[q] = slot[q * 64 + lane];
        }
        float k0 = 0.f, k1 = 0.f, k2 = 0.f, k3 = 0.f, k4c = 0.f, gam = 1.f, dprod = 1.f, D0 = 1.f, D1 = 1.f;
        h16* outp; int ldo, ocol;
        if (MX == MX_MAMBA) { const int cc = hd * 64 + lane; const float* cw = IN(I_CONVW) + (size_t)j * 4 * 1536; k0 = cw[cc]; k1 = cw[1536 + cc]; k2 = cw[2 * 1536 + cc]; k3 = cw[3 * 1536 + cc]; k4c = IN(I_CONVB)[j * 1536 + cc];
            ocol = hd * 64 + lane; if (dir == 0) { outp = (h16*)(C.ws + WS_MIX) + 512; ldo = MIXW; } else { outp = (h16*)(C.ws + WS_O); ldo = 1024; } }
        else if (MX == MX_HGRN) {
            if (j == 1) { const float* lb = IN(I_HGLB); const int f0 = hd * 128 + lane;
                k0 = sigm(lb[(dir * 2 + 1) * 1024 + f0] - lb[(dir * 2 + 0) * 1024 + f0]); k1 = sigm(lb[(dir * 2 + 1) * 1024 + f0 + 64] - lb[(dir * 2 + 0) * 1024 + f0 + 64]); }
            ocol = hd * 64 + lane; if (dir == 0) { outp = (h16*)(C.ws + WS_MIX); ldo = MIXW; } else { outp = (h16*)(C.ws + WS_O); ldo = 512; } }
        else { gam = ret_gamma(C, dir, hd >> 2);
            ocol = hd * 64 + lane; if (dir == 0) { outp = (h16*)(C.ws + WS_MIX) + 512; ldo = MIXW; } else { outp = (h16*)(C.ws + WS_O); ldo = 1024; } }
#pragma unroll 1
        for (int sub = 0; sub < CH / SUB; ++sub) {
#pragma unroll
            for (int s = 0; s < SUB; ++s) {
                const int p = c * CH + sub * SUB + s, t = dir ? T - 1 - p : p; const size_t tok = (size_t)b * T + t;
                const h16* ur = U + tok * LDU;
                LAS float* q = wl + s * 384;
                if (MX == MX_MAMBA) {
                    const int g = hd >> 3; const h16* bc = BC + tok * 512 + g * 128 + lane;
                    q[lane] = (float)bc[0]; q[64 + lane] = (float)bc[64];
                    if (PASS == 2) { q[128 + lane] = (float)bc[256]; q[192 + lane] = (float)bc[320]; }
                    const h16* xp = ur + 1024 + hd * 64 + lane;
                    float acc = k4c + k2 * (float)xp[0];
                    if (t >= 2) acc += k0 * (float)xp[-2 * LDU];
                    if (t >= 1) acc += k1 * (float)xp[-LDU];
                    if (t < T - 1) acc += k3 * (float)xp[LDU];
                    const float dt = DT[tok * 64 + dir * 16 + hd], dA = DT[tok * 64 + 32 + dir * 16 + hd];
                    q[256 + lane] = silu(acc) * dt; q[320] = dA; dprod *= dA;
                } else if (MX == MX_HGRN) {
                    const h16* fp = ur + 1024 + dir * 1024 + hd * 128 + lane;
                    const float f0 = k0 + (1.f - k0) * sigm((float)fp[0]), f1 = k1 + (1.f - k1) * sigm((float)fp[64]);
                    q[lane] = f0; q[64 + lane] = f1; D0 *= f0; D1 *= f1;
                    if (PASS == 2) { q[128 + lane] = (float)ur[hd * 128 + lane]; q[192 + lane] = (float)ur[hd * 128 + 64 + lane]; }
                    q[256 + lane] = (float)ur[3072 + hd * 64 + lane];
                } else {
                    const int h = hd >> 2; const float cs = ROT[t * 128 + lane], sn = ROT[t * 128 + 64 + lane];
                    const float x1 = (float)ur[512 + h * 128 + lane], x2 = (float)ur[512 + h * 128 + 64 + lane];
                    q[lane] = (x1 * cs - x2 * sn) * 0.08838834764831845f; q[64 + lane] = (x2 * cs + x1 * sn) * 0.08838834764831845f;
                    if (PASS == 2) { const float y1 = (float)ur[h * 128 + lane], y2 = (float)ur[h * 128 + 64 + lane]; q[128 + lane] = y1 * cs - y2 * sn; q[192 + lane] = y2 * cs + y1 * sn; }
                    q[256 + lane] = (float)ur[1024 + hd * 64 + lane];
                }
            }
            WAVE_SYNC();
#pragma unroll 1
            for (int s = 0; s < SUB; ++s) {
                const LAS f32x4* q = (const LAS f32x4*)(wl + s * 384);
                const float vv = wl[s * 384 + 256 + lane];
                const float dec = (MX == MX_MAMBA) ? wl[s * 384 + 320] : gam;
                float o0 = 0.f, o1 = 0.f, o2 = 0.f, o3 = 0.f;
#pragma unroll
                for (int k4 = 0; k4 < 32; ++k4) { const f32x4 a4 = q[k4];
                    if (MX == MX_HGRN) { S[4 * k4] = a4.x * (S[4 * k4] - vv) + vv; S[4 * k4 + 1] = a4.y * (S[4 * k4 + 1] - vv) + vv; S[4 * k4 + 2] = a4.z * (S[4 * k4 + 2] - vv) + vv; S[4 * k4 + 3] = a4.w * (S[4 * k4 + 3] - vv) + vv; }
                    else { S[4 * k4] = S[4 * k4] * dec + a4.x * vv; S[4 * k4 + 1] = S[4 * k4 + 1] * dec + a4.y * vv; S[4 * k4 + 2] = S[4 * k4 + 2] * dec + a4.z * vv; S[4 * k4 + 3] = S[4 * k4 + 3] * dec + a4.w * vv; }
                    if (PASS == 2) { const f32x4 q4 = q[32 + k4]; o0 += S[4 * k4] * q4.x; o1 += S[4 * k4 + 1] * q4.y; o2 += S[4 * k4 + 2] * q4.z; o3 += S[4 * k4 + 3] * q4.w; } }
                if (PASS == 2) { const int p = c * CH + sub * SUB + s, t = dir ? T - 1 - p : p; outp[((size_t)b * T + t) * ldo + ocol] = (h16)((o0 + o1) + (o2 + o3)); }
            }
            WAVE_SYNC();
        }
        if (PASS == 1) {
#pragma unroll
            for (int q = 0; q < 128; ++q) slot[q * 64 + lane] = S[q];
            if (MX == MX_MAMBA) { if (lane == 0) DEC[slotid] = dprod; }
            if (MX == MX_HGRN) { DEC[(size_t)slotid * 128 + lane] = D0; DEC[(size_t)slotid * 128 + 64 + lane] = D1; }
        }
    }
}
template <int MX>
__device__ __forceinline__ void diag_cross(Ctx& C) {
    constexpr int CH = MXC<MX>::CH, NH = MXC<MX>::NH;
    const int T = C.T, NC = T / CH, nchains = C.nseq * 2 * NH;
    const float* DEC = (const float*)(C.ws + WS_DEC);
    for (int idx = C.gtid; idx < nchains * 8192; idx += C.ngt) {
        const int chain = idx >> 13, e = idx & 8191, hd = chain % NH; int r = chain / NH; const int dir = r & 1, b = r >> 1;
        float gch = 1.f;
        if (MX == MX_RET) { const float lg = -__expf(IN(I_RETLD)[(C.j * 2 + dir) * 4 + (hd >> 2)]); gch = __expf(lg * (float)CH); }
        float carry = 0.f;
#pragma unroll 4
        for (int c = 0; c < NC; ++c) {
            const int slotid = ((b * 2 + dir) * NC + c) * NH + hd;
            float* p = (float*)(C.ws + WS_ST) + (size_t)slotid * 8192 + e;
            const float sl = *p; *p = carry;
            const float d = (MX == MX_HGRN) ? DEC[(size_t)slotid * 128 + (e >> 6)] : (MX == MX_MAMBA) ? DEC[slotid] : gch;
            carry = d * carry + sl;
        }
    }
}

constexpr int RQ_OFF = 0, RK_OFF = 17408, RV_OFF = 36864, RM_OFF = 73728;
__device__ __forceinline__ void ret_stage_qk(Ctx& C, LAS h16* dst, bool transposed, int colbase, float scale, float lg2, int wbase, int b, int dir, int p0) {
    const int T = C.T, m = C.tid >> 3, i0 = (C.tid & 7) * 8;
    const int p = p0 + m, t = dir ? T - 1 - p : p; const size_t tok = (size_t)b * T + t;
    const h16* U = (const h16*)(C.ws + WS_U); const float* ROT = (const float*)(C.ws + WS_ROT);
    const h16x8 x1 = *(const h16x8*)(U + tok * LDD_ + colbase + i0), x2 = *(const h16x8*)(U + tok * LDD_ + colbase + 64 + i0);
    const f32x4 c0 = *(const f32x4*)(ROT + t * 128 + i0), c1 = *(const f32x4*)(ROT + t * 128 + i0 + 4), s0 = *(const f32x4*)(ROT + t * 128 + 64 + i0), s1 = *(const f32x4*)(ROT + t * 128 + 64 + i0 + 4);
    const float cs[8] = {c0.x, c0.y, c0.z, c0.w, c1.x, c1.y, c1.z, c1.w}, sn[8] = {s0.x, s0.y, s0.z, s0.w, s1.x, s1.y, s1.z, s1.w};
    const float sc = transposed ? scale * exp2f((float)(wbase - m) * lg2) : scale;
    h16x8 y1, y2;
#pragma unroll
    for (int e = 0; e < 8; ++e) { const float a = (float)x1[e], bb = (float)x2[e]; y1[e] = (h16)((a * cs[e] - bb * sn[e]) * sc); y2[e] = (h16)((bb * cs[e] + a * sn[e]) * sc); }
    if (!transposed) { *(LAS h16x8*)(dst + m * 136 + i0) = y1; *(LAS h16x8*)(dst + m * 136 + 64 + i0) = y2; }
    else {
#pragma unroll
        for (int e = 0; e < 8; ++e) { dst[(i0 + e) * 72 + m] = y1[e]; dst[(64 + i0 + e) * 72 + m] = y2[e]; } }
}
__device__ __forceinline__ void ret_stage_vt(Ctx& C, LAS h16* Vt, int h, int b, int dir, int p0) {
    const int T = C.T; const h16* U = (const h16*)(C.ws + WS_U);
#pragma unroll
    for (int q = 0; q < 4; ++q) { const int it = C.tid + 512 * q, m = it >> 5, cb = it & 31;
        const int p = p0 + m, t = dir ? T - 1 - p : p; const size_t tok = (size_t)b * T + t;
        const h16x8 x = *(const h16x8*)(U + tok * LDD_ + 1024 + h * 256 + cb * 8);
#pragma unroll
        for (int e = 0; e < 8; ++e) Vt[(cb * 8 + e) * 72 + m] = x[e]; }
}
__device__ __forceinline__ void ret_mfma_pass1(Ctx& C) {
    const int T = C.T, NCH = T / 256, nunits = C.nseq * 2 * NCH * 4, lane = C.lane, w = C.wave, fr = lane & 15, fq = lane >> 4;
    LAS h16* Kt = (LAS h16*)(C.lds + RK_OFF); LAS h16* Vt = (LAS h16*)(C.lds + RV_OFF);
    for (int unit = blockIdx.x; unit < nunits; unit += gridDim.x) {
        const int h = unit & 3; int r = unit >> 2; const int c = r % NCH; r /= NCH; const int dir = r & 1, b = r >> 1;
        const float lg2 = -__expf(IN(I_RETLD)[(C.j * 2 + dir) * 4 + h]) * 1.4426950408889634f;
        f32x4 acc[8][2];
#pragma unroll
        for (int mt = 0; mt < 8; ++mt) { acc[mt][0] = (f32x4){0.f, 0.f, 0.f, 0.f}; acc[mt][1] = (f32x4){0.f, 0.f, 0.f, 0.f}; }
#pragma unroll 1
        for (int jb = 0; jb < 4; ++jb) {
            __syncthreads();
            ret_stage_qk(C, Kt, true, 512 + h * 128, 0.08838834764831845f, lg2, 255 - 64 * jb, b, dir, c * 256 + 64 * jb);
            ret_stage_vt(C, Vt, h, b, dir, c * 256 + 64 * jb);
            __syncthreads();
#pragma unroll
            for (int ks = 0; ks < 2; ++ks) {
                const h16x8 b0 = *(const LAS h16x8*)(Vt + (32 * w + fr) * 72 + ks * 32 + fq * 8), b1 = *(const LAS h16x8*)(Vt + (32 * w + 16 + fr) * 72 + ks * 32 + fq * 8);
#pragma unroll
                for (int mt = 0; mt < 8; ++mt) { const h16x8 a = *(const LAS h16x8*)(Kt + (16 * mt + fr) * 72 + ks * 32 + fq * 8);
                    acc[mt][0] = __builtin_amdgcn_mfma_f32_16x16x32_f16(a, b0, acc[mt][0], 0, 0, 0); acc[mt][1] = __builtin_amdgcn_mfma_f32_16x16x32_f16(a, b1, acc[mt][1], 0, 0, 0); }
            }
        }
        float* Sg = (float*)(C.ws + WS_ST) + (size_t)unit * 32768;
#pragma unroll
        for (int mt = 0; mt < 8; ++mt)
#pragma unroll
            for (int nt = 0; nt < 2; ++nt) *(f32x4*)(Sg + (size_t)(32 * w + 16 * nt + fr) * 128 + 16 * mt + fq * 4) = acc[mt][nt];
    }
}
__device__ __forceinline__ void ret_mfma_cross(Ctx& C) {
    const int T = C.T, NCH = T / 256, nchains = C.nseq * 2 * 4;
    for (int idx = C.gtid; idx < nchains * 32768; idx += C.ngt) {
        const int chain = idx >> 15, e = idx & 32767, h = chain & 3, dir = (chain >> 2) & 1, b = chain >> 3;
        const float gch = __expf(-__expf(IN(I_RETLD)[(C.j * 2 + dir) * 4 + h]) * 256.f);
        float carry = 0.f;
#pragma unroll 4
        for (int c = 0; c < NCH; ++c) { float* p = (float*)(C.ws + WS_ST) + (size_t)((((b * 2 + dir) * NCH + c) * 4) + h) * 32768 + e; const float sl = *p; *p = carry; carry = gch * carry + sl; }
    }
}
__device__ __forceinline__ void ret_mfma_pass2(Ctx& C) {
    const int T = C.T, NCH = T / 256, nunits = C.nseq * 2 * NCH * 4, lane = C.lane, w = C.wave, fr = lane & 15, fq = lane >> 4;
    LAS h16* Qs = (LAS h16*)(C.lds + RQ_OFF); LAS h16* Ks = (LAS h16*)(C.lds + RK_OFF); LAS h16* Vt = (LAS h16*)(C.lds + RV_OFF); LAS h16* Ms = (LAS h16*)(C.lds + RM_OFF);
    for (int unit = blockIdx.x; unit < nunits; unit += gridDim.x) {
        const int h = unit & 3; int r = unit >> 2; const int c = r % NCH; r /= NCH; const int dir = r & 1, b = r >> 1;
        const float lg2 = -__expf(IN(I_RETLD)[(C.j * 2 + dir) * 4 + h]) * 1.4426950408889634f;
        const float* Sg = (const float*)(C.ws + WS_ST) + (size_t)unit * 32768;
        h16x8 sf[2][4];
#pragma unroll
        for (int nt = 0; nt < 2; ++nt)
#pragma unroll
            for (int ks = 0; ks < 4; ++ks) { const float* p = Sg + (size_t)(32 * w + 16 * nt + fr) * 128 + ks * 32 + fq * 8; const f32x4 a = *(const f32x4*)p, bb = *(const f32x4*)(p + 4);
                sf[nt][ks][0] = (h16)a.x; sf[nt][ks][1] = (h16)a.y; sf[nt][ks][2] = (h16)a.z; sf[nt][ks][3] = (h16)a.w; sf[nt][ks][4] = (h16)bb.x; sf[nt][ks][5] = (h16)bb.y; sf[nt][ks][6] = (h16)bb.z; sf[nt][ks][7] = (h16)bb.w; }
        h16* outp; int ldo; if (dir == 0) { outp = (h16*)(C.ws + WS_MIX) + 512; ldo = MIXW; } else { outp = (h16*)(C.ws + WS_O); ldo = 1024; }
#pragma unroll 1
        for (int ib = 0; ib < 4; ++ib) {
            f32x4 acc[4][2];
#pragma unroll
            for (int mt = 0; mt < 4; ++mt) { acc[mt][0] = (f32x4){0.f, 0.f, 0.f, 0.f}; acc[mt][1] = (f32x4){0.f, 0.f, 0.f, 0.f}; }
#pragma unroll 1
            for (int jb = 0; jb <= ib; ++jb) {
                __syncthreads();
                if (jb == 0) ret_stage_qk(C, Qs, false, h * 128, 1.f, lg2, 0, b, dir, c * 256 + 64 * ib);
                ret_stage_qk(C, Ks, false, 512 + h * 128, 0.08838834764831845f, lg2, 0, b, dir, c * 256 + 64 * jb);
                ret_stage_vt(C, Vt, h, b, dir, c * 256 + 64 * jb);
                __syncthreads();
                {
                    const int gm = w >> 1, gn = w & 1;
                    f32x4 g0 = (f32x4){0.f, 0.f, 0.f, 0.f}, g1 = (f32x4){0.f, 0.f, 0.f, 0.f};
#pragma unroll
                    for (int ks = 0; ks < 4; ++ks) { const h16x8 a = *(const LAS h16x8*)(Qs + (16 * gm + fr) * 136 + ks * 32 + fq * 8);
                        const h16x8 k0 = *(const LAS h16x8*)(Ks + (32 * gn + fr) * 136 + ks * 32 + fq * 8), k1 = *(const LAS h16x8*)(Ks + (32 * gn + 16 + fr) * 136 + ks * 32 + fq * 8);
                        g0 = __builtin_amdgcn_mfma_f32_16x16x32_f16(a, k0, g0, 0, 0, 0); g1 = __builtin_amdgcn_mfma_f32_16x16x32_f16(a, k1, g1, 0, 0, 0); }
#pragma unroll
                    for (int jj = 0; jj < 4; ++jj) { const int l = 16 * gm + fq * 4 + jj, Lg = 64 * ib + l;
                        const int m0 = 32 * gn + fr, M0 = 64 * jb + m0, M1 = M0 + 16;
                        Ms[l * 72 + m0] = (h16)((M0 <= Lg) ? g0[jj] * exp2f((float)(Lg - M0) * lg2) : 0.f);
                        Ms[l * 72 + m0 + 16] = (h16)((M1 <= Lg) ? g1[jj] * exp2f((float)(Lg - M1) * lg2) : 0.f); }
                }
                __syncthreads();
#pragma unroll
                for (int ks = 0; ks < 2; ++ks) {
                    const h16x8 b0 = *(const LAS h16x8*)(Vt + (32 * w + fr) * 72 + ks * 32 + fq * 8), b1 = *(const LAS h16x8*)(Vt + (32 * w + 16 + fr) * 72 + ks * 32 + fq * 8);
#pragma unroll
                    for (int mt = 0; mt < 4; ++mt) { const h16x8 a = *(const LAS h16x8*)(Ms + (16 * mt + fr) * 72 + ks * 32 + fq * 8);
                        acc[mt][0] = __builtin_amdgcn_mfma_f32_16x16x32_f16(a, b0, acc[mt][0], 0, 0, 0); acc[mt][1] = __builtin_amdgcn_mfma_f32_16x16x32_f16(a, b1, acc[mt][1], 0, 0, 0); }
                }
            }
            f32x4 ac2[4][2];
#pragma unroll
            for (int mt = 0; mt < 4; ++mt) { ac2[mt][0] = (f32x4){0.f, 0.f, 0.f, 0.f}; ac2[mt][1] = (f32x4){0.f, 0.f, 0.f, 0.f}; }
#pragma unroll
            for (int ks = 0; ks < 4; ++ks)
#pragma unroll
                for (int mt = 0; mt < 4; ++mt) { const h16x8 a = *(const LAS h16x8*)(Qs + (16 * mt + fr) * 136 + ks * 32 + fq * 8);
                    ac2[mt][0] = __builtin_amdgcn_mfma_f32_16x16x32_f16(a, sf[0][ks], ac2[mt][0], 0, 0, 0); ac2[mt][1] = __builtin_amdgcn_mfma_f32_16x16x32_f16(a, sf[1][ks], ac2[mt][1], 0, 0, 0); }
#pragma unroll
            for (int mt = 0; mt < 4; ++mt)
#pragma unroll
                for (int jj = 0; jj < 4; ++jj) { const int Lg = 64 * ib + 16 * mt + fq * 4 + jj; const float rs = exp2f((float)(Lg + 1) * lg2);
                    const int p = c * 256 + Lg, t = dir ? T - 1 - p : p; h16* op = outp + ((size_t)b * T + t) * ldo + h * 256 + 32 * w + fr;
                    op[0] = (h16)(acc[mt][0][jj] + ac2[mt][0][jj] * rs); op[16] = (h16)(acc[mt][1][jj] + ac2[mt][1][jj] * rs); }
        }
    }
}
__device__ __forceinline__ void mamba_final(Ctx& C) {
    const int lane = C.lane, j = C.j, c0 = lane * 16;
    const h16* U = (const h16*)(C.ws + WS_U); h16* MIX = (h16*)(C.ws + WS_MIX); const h16* O = (const h16*)(C.ws + WS_O); const h16* XS = (const h16*)(C.ws + WS_ST + 32 * MiB);
    const float dsk = IN(I_SSMD)[j * 16 + (lane >> 2)];
    for (int tok = C.gw; tok < MG; tok += C.ngw) {
        float y[16]; float ss = 0.f;
#pragma unroll
        for (int hf = 0; hf < 2; ++hf) {
            const int c = c0 + hf * 8;
            const h16x8 xs = *(const h16x8*)(XS + (size_t)tok * 1024 + c), yf = *(const h16x8*)(MIX + (size_t)tok * MIXW + 512 + c), yb = *(const h16x8*)(O + (size_t)tok * 1024 + c), z = *(const h16x8*)(U + (size_t)tok * LDB_ + c);
#pragma unroll
            for (int e = 0; e < 8; ++e) { const float v = ((float)yf[e] + (float)yb[e] + (float)xs[e] * dsk) * silu((float)z[e]); y[hf * 8 + e] = v; ss += v * v; }
        }
#pragma unroll
        for (int o = 1; o < 32; o <<= 1) ss += __shfl_xor(ss, o);
        const float rstd = rsqrtf(ss * (1.f / 512.f) + 1e-5f);
#pragma unroll
        for (int hf = 0; hf < 2; ++hf) { h16x8 w;
#pragma unroll
            for (int e = 0; e < 8; ++e) w[e] = (h16)(y[hf * 8 + e] * rstd * IN(I_SSMNW)[j * 1024 + c0 + hf * 8 + e]);
            *(h16x8*)(MIX + (size_t)tok * MIXW + 512 + c0 + hf * 8) = w; }
    }
}
__device__ __forceinline__ void hgrn_final(Ctx& C) {
    const int lane = C.lane, j = C.j, c0 = lane * 8;
    const h16* U = (const h16*)(C.ws + WS_U); h16* MIX = (h16*)(C.ws + WS_MIX); const h16* O = (const h16*)(C.ws + WS_O);
    for (int tok = C.gw; tok < MG; tok += C.ngw) {
        const h16x8 of = *(const h16x8*)(MIX + (size_t)tok * MIXW + c0), ob = *(const h16x8*)(O + (size_t)tok * 512 + c0), gg = *(const h16x8*)(U + (size_t)tok * LDC_ + 3584 + c0);
        float o[8], ss = 0.f;
#pragma unroll
        for (int e = 0; e < 8; ++e) { o[e] = (float)of[e] + (float)ob[e]; ss += o[e] * o[e]; }
        ss += __shfl_xor(ss, 1); ss += __shfl_xor(ss, 2); ss += __shfl_xor(ss, 4);
        const float rstd = rsqrtf(ss * (1.f / 64.f) + 1e-5f);
        h16x8 w;
#pragma unroll
        for (int e = 0; e < 8; ++e) w[e] = (h16)(o[e] * rstd * IN(I_HGNW)[j * 512 + c0 + e] * sigm((float)gg[e]));
        *(h16x8*)(MIX + (size_t)tok * MIXW + c0) = w;
    }
}
__device__ __forceinline__ void ret_final(Ctx& C) {
    const int lane = C.lane, j = C.j, c0 = lane * 16;
    const h16* U = (const h16*)(C.ws + WS_U); h16* MIX = (h16*)(C.ws + WS_MIX); const h16* O = (const h16*)(C.ws + WS_O);
    for (int tok = C.gw; tok < MG; tok += C.ngw) {
        float o[16], s = 0.f;
#pragma unroll
        for (int hf = 0; hf < 2; ++hf) { const h16x8 of = *(const h16x8*)(MIX + (size_t)tok * MIXW + 512 + c0 + hf * 8), ob = *(const h16x8*)(O + (size_t)tok * 1024 + c0 + hf * 8);
#pragma unroll
            for (int e = 0; e < 8; ++e) { o[hf * 8 + e] = (float)of[e] + (float)ob[e]; s += o[hf * 8 + e]; } }
#pragma unroll
        for (int q = 1; q < 16; q <<= 1) s += __shfl_xor(s, q);
        const float mean = s * (1.f / 256.f); float v2 = 0.f;
#pragma unroll
        for (int e = 0; e < 16; ++e) { o[e] -= mean; v2 += o[e] * o[e]; }
#pragma unroll
        for (int q = 1; q < 16; q <<= 1) v2 += __shfl_xor(v2, q);
        const float rstd = rsqrtf(v2 * (1.f / 256.f) + 1e-5f);
#pragma unroll
        for (int hf = 0; hf < 2; ++hf) { const h16x8 gg = *(const h16x8*)(U + (size_t)tok * LDD_ + 2048 + c0 + hf * 8); h16x8 w;
#pragma unroll
            for (int e = 0; e < 8; ++e) { const int cc = c0 + hf * 8 + e; w[e] = (h16)((o[hf * 8 + e] * rstd * IN(I_RETGW)[j * 1024 + cc] + IN(I_RETGB)[j * 1024 + cc]) * silu((float)gg[e])); }
            *(h16x8*)(MIX + (size_t)tok * MIXW + 512 + c0 + hf * 8) = w; }
    }
}

template <class Epi> __device__ __forceinline__ void run_gemm(Ctx& C, const h16* A, const h16* Bt, int N, int K, const Epi& E) {
    pg8::Gemm g{A, Bt, MG, N, K}; pg8::StaticOrder S; S.init(MG, N, (int)gridDim.x, (int)blockIdx.x);
    pg8::gemm_phase<Epi, pg8::StaticOrder>(C.lds, g, S, E, C.tid);
}

__global__ void __launch_bounds__(NTHR, 2) mega(Args args) {
    extern __shared__ __attribute__((aligned(16))) unsigned char lds_raw[];
    cg::grid_group grid = cg::this_grid();
    Ctx C;
#pragma unroll
    for (int i = 0; i < 32; ++i) C.in[i] = args.in[i];
    C.lds = (LAS unsigned char*)lds_raw; C.tid = threadIdx.x; C.lane = C.tid & 63; C.wave = __builtin_amdgcn_readfirstlane(C.tid >> 6);
    C.gw = blockIdx.x * NWAVES + C.wave; C.ngw = gridDim.x * NWAVES; C.gtid = blockIdx.x * NTHR + C.tid; C.ngt = gridDim.x * NTHR; C.ws = args.ws;
    h16* HN = (h16*)(C.ws + WS_HN); h16* MIX = (h16*)(C.ws + WS_MIX); h16* U = (h16*)(C.ws + WS_U);
    volatile LAS unsigned* bst = (volatile LAS unsigned*)(C.lds + LDS_BYTES - 16);
    if (threadIdx.x < 4) bst[threadIdx.x] = 0u;
    __syncthreads();
    const XcdBarrier xbar = xcd_barrier_post((unsigned*)(C.ws + WS_BAR), bst);
#define SYNC() xcd_barrier(xbar)
#ifndef PH
#define PH 0xFFFF
#endif
#ifndef DUP
#define DUP 0
#endif
#define P_(b, ...) do { for (int rep_ = 0; rep_ < 1 + ((DUP >> (b)) & 1); ++rep_) if (PH & (1 << (b))) { int t_ = threadIdx.x; asm volatile("" : "+v"(t_)); C.tid = t_; C.lane = t_ & 63; C.wave = __builtin_amdgcn_readfirstlane(t_ >> 6); C.gw = blockIdx.x * NWAVES + C.wave; C.gtid = blockIdx.x * NTHR + t_; __VA_ARGS__; } } while (0)
#pragma unroll 1
    for (int layer = 0; layer < 4; ++layer) {
        C.layer = layer; C.j = layer >> 1;
        P_(0, phase_weights(C)); if (layer == 0) grid.sync(); else SYNC();
#pragma unroll 1
        for (int grp = 0; grp < 2; ++grp) {
            C.grp = grp; C.nseq = grp == 0 ? 2 : 1; C.T = grp == 0 ? 8192 : 16384;
            C.hdst = args.out + (size_t)grp * MG * D; C.hsrc = (layer == 0) ? args.in[grp == 0 ? I_XP : I_XS] : C.hdst;
            P_(1, phase_norm(C, C.hsrc, IN(I_LNMIX) + layer * D, HN)); SYNC();
            if ((layer & 1) == 0) {
                P_(2, run_gemm(C, HN, (const h16*)(C.ws + W_IN1), LDA_, D, pg8::EpiF16<0>{U, LDA_})); SYNC();
                P_(3, rwkv_pre(C)); SYNC();
                P_(4, rwkv_scan<1>(C)); SYNC();
                P_(5, rwkv_cross(C)); SYNC();
                P_(6, rwkv_scan<2>(C)); SYNC();
                P_(7, rwkv_final(C)); SYNC();
                P_(2, run_gemm(C, HN, (const h16*)(C.ws + W_IN2), LDB_, D, pg8::EpiF16<0>{U, LDB_})); SYNC();
                P_(8, mamba_pre(C)); SYNC();
                P_(9, mamba_mfma_pass1(C)); SYNC();
                P_(5, mamba_mfma_cross(C)); SYNC();
                P_(9, mamba_mfma_pass2(C)); SYNC();
                P_(10, mamba_final(C)); SYNC();
            } else {
                P_(2, run_gemm(C, HN, (const h16*)(C.ws + W_IN1), LDC_, D, pg8::EpiF16<0>{U, LDC_})); SYNC();
                P_(11, diag_scan<MX_HGRN, 1>(C)); SYNC();
                P_(5, diag_cross<MX_HGRN>(C)); SYNC();
                P_(11, diag_scan<MX_HGRN, 2>(C)); SYNC();
                P_(12, hgrn_final(C)); SYNC();
                P_(2, run_gemm(C, HN, (const h16*)(C.ws + W_IN2), LDD_, D, pg8::EpiF16<0>{U, LDD_})); SYNC();
                P_(13, ret_mfma_pass1(C)); SYNC();
                P_(5, ret_mfma_cross(C)); SYNC();
                P_(13, ret_mfma_pass2(C)); SYNC();
                P_(14, ret_final(C)); SYNC();
            }
            P_(15, run_gemm(C, MIX, (const h16*)(C.ws + W_OUT), D, MIXW, pg8::EpiRes{C.hsrc, C.hdst, D})); SYNC();
            P_(1, phase_norm(C, C.hdst, IN(I_LNFFN) + layer * D, HN)); SYNC();
            P_(2, run_gemm(C, HN, (const h16*)(C.ws + W_F1), FF, D, pg8::EpiF16<1>{U, FF})); SYNC();
            P_(15, run_gemm(C, U, (const h16*)(C.ws + W_F2), D, FF, pg8::EpiRes{C.hdst, C.hdst, D})); SYNC();
        }
    }
    P_(1, phase_final_norm(C, args.out, IN(I_LNFINAL)));
}

extern "C" void kernel_launch(void* const* d_in, const int* in_sizes, int n_in, void* d_out, int out_size, void* d_ws, size_t ws_size, hipStream_t stream) {
    static int grid = 0;
    if (grid == 0) {
        if (n_in != 32 || ws_size < WS_END) { fprintf(stderr, "kernel_launch: unexpected n_in %d or ws_size %zu (< %zu)\n", n_in, ws_size, (size_t)WS_END); grid = -1; return; }
        int dev = 0, cus = 0, per_cu = 0;
        hipGetDevice(&dev); hipDeviceGetAttribute(&cus, hipDeviceAttributeMultiprocessorCount, dev);
        if (hipFuncSetAttribute((const void*)mega, hipFuncAttributeMaxDynamicSharedMemorySize, LDS_BYTES) != hipSuccess) { fprintf(stderr, "kernel_launch: hipFuncSetAttribute failed\n"); grid = -1; return; }
        if (hipOccupancyMaxActiveBlocksPerMultiprocessor(&per_cu, (const void*)mega, NTHR, LDS_BYTES) != hipSuccess || per_cu < 1) { fprintf(stderr, "kernel_launch: occupancy query says %d\n", per_cu); per_cu = 1; }
        (void)hipGetLastError();
        grid = cus * per_cu;
    }
    if (grid < 0) return;
    if (hipMemsetAsync((char*)d_ws + WS_BAR, 0, XCD_BAR_WORDS * 4, stream) != hipSuccess) { fprintf(stderr, "kernel_launch: memset failed\n"); return; }
    Args a{};
    for (int i = 0; i < 32; ++i) a.in[i] = (const float*)d_in[i];
    a.out = (float*)d_out; a.ws = (unsigned char*)d_ws;
    void* params[] = {&a};
    hipError_t e = hipLaunchCooperativeKernel((const void*)mega, dim3(grid), dim3(NTHR), params, LDS_BYTES, stream);
    if (e != hipSuccess) fprintf(stderr, "kernel_launch: cooperative launch failed: %s (grid %d)\n", hipGetErrorString(e), grid);
}
```

```cpp
#include <hip/hip_runtime.h>
#include <hip/hip_cooperative_groups.h>
#include <cstdio>
#include <cstdint>
namespace cg = cooperative_groups;

#define LAS __attribute__((address_space(3)))
typedef _Float16 h16;
typedef _Float16 h16x8 __attribute__((ext_vector_type(8)));
typedef _Float16 h16x4 __attribute__((ext_vector_type(4)));
typedef float f32x4 __attribute__((ext_vector_type(4)));

constexpr int D = 1024, FF = 4096, MIXW = 1536, MG = 16384;
constexpr int A_IN = 1920, B_IN = 2592, AB_IN = 4512, C_IN = 4096, D_IN = 3072, CD_IN = 7168;
constexpr int LDA_ = 2048, LDB_ = 2816, LDC_ = 4096, LDD_ = 3072;
constexpr int CH_R = 128, CH_M = 256, CH_H = 128, CH_T = 256;
constexpr int SUB = 8;
constexpr int NWAVES = 8, NTHR = 512;
constexpr int LDS_BYTES = 147456;
constexpr size_t MiB = 1u << 20;
constexpr size_t WS_ROT = 0, WS_DEC = 8 * MiB, WS_W = 10 * MiB, WS_HN = 43 * MiB, WS_MIX = 75 * MiB, WS_U = 123 * MiB, WS_ST = 251 * MiB, WS_O = 315 * MiB, WS_BAR = 347 * MiB, WS_END = 348 * MiB;
constexpr size_t W_IN1 = WS_W, W_IN2 = WS_W + 8 * MiB, W_OUT = WS_W + 14 * MiB, W_F1 = WS_W + 17 * MiB, W_F2 = WS_W + 25 * MiB;

struct Args { const float* in[32]; float* out; unsigned char* ws; };
enum { I_XP = 0, I_XS, I_LNMIX, I_LNFFN, I_LNFINAL, I_WOUT, I_W1, I_W2, I_ABW, I_MU, I_W0, I_RW2, I_A0, I_A2, I_G2, I_KK, I_KA, I_RK, I_GNW, I_GNB,
       I_CONVW, I_CONVB, I_DTB, I_ALOG, I_SSMD, I_SSMNW, I_CDW, I_HGLB, I_HGNW, I_RETLD, I_RETGW, I_RETGB };

__device__ __forceinline__ float sigm(float x) { return 1.f / (1.f + __expf(-x)); }
__device__ __forceinline__ float silu(float x) { return x / (1.f + __expf(-x)); }
__device__ __forceinline__ float wave_sum(float v) {
#pragma unroll
    for (int o = 1; o < 64; o <<= 1) v += __shfl_xor(v, o);
    return v;
}
#define WAVE_SYNC() do { asm volatile("s_waitcnt lgkmcnt(0)" ::: "memory"); __builtin_amdgcn_wave_barrier(); } while (0)

namespace pg8 {
constexpr int BM = 256, BK = 64, HALF = 128, HTB = HALF * BK * 2, STAGE_BYTES = 8 * HTB, NXCD = 8, WGM = 8;
__host__ __device__ __forceinline__ int lds_byte(int r, int c) { const int st = (r >> 4) * 2 + (c >> 5), rr = r & 15, cc = c & 31, ob = rr * 64 + cc * 2; return st * 1024 + (ob ^ (((ob >> 9) & 1) << 5)); }
__host__ __device__ __forceinline__ void stage_rc(int b, int& R, int& C) { const int st = b / 1024, sb = b % 1024, swz = sb ^ (((sb >> 9) & 1) << 5); R = (st >> 1) * 16 + swz / 64; C = (st & 1) * 32 + (swz % 64) / 2; }
__host__ __device__ __forceinline__ int perm32(int rho) { const int n = rho >> 4, i = rho & 15; return 8 * (i >> 2) + 4 * n + (i & 3); }
struct Unit { int pm, pn; };
struct Gemm { const h16* A; const h16* Bt; int M, N, K; };
struct StaticOrder {
    int nM, nN, nwg, G, c;
    __device__ void init(int M, int N, int G_, int c_) { nM = M / BM; nN = N / BM; nwg = nM * nN; G = G_; c = c_; }
    __device__ bool next(int i, Unit& u) const {
        const long L = (long)i * G + c; if (L >= nwg) return false;
        int wgid = (int)L; { const int q = nwg / NXCD, r = nwg % NXCD, xcd = wgid % NXCD, off = wgid / NXCD; wgid = (xcd < r ? xcd * (q + 1) : r * (q + 1) + (xcd - r) * q) + off; }
        const int nig = WGM * nN, gid = wgid / nig, fm = gid * WGM, gsz = (nM - fm) < WGM ? (nM - fm) : WGM;
        u.pm = fm + ((wgid % nig) % gsz); u.pn = (wgid % nig) / gsz; return true;
    }
};
template <int ACT> struct EpiF16 {
    h16* O; int ldc;
    __device__ __forceinline__ void operator()(const f32x4 (&acc)[2][2][4][2], const Unit& u, int wr, int wc, int fr, int fq) const {
        const int row0 = u.pm * BM + wr * 64 + fr; const int col0 = u.pn * BM + wc * 32 + 8 * fq;
#pragma unroll
        for (int ai = 0; ai < 2; ++ai)
#pragma unroll
            for (int m = 0; m < 4; ++m) { h16* rowp = O + (size_t)(row0 + ai * HALF + m * 16) * ldc + col0;
#pragma unroll
                for (int bj = 0; bj < 2; ++bj) { f32x4 v0 = acc[ai][bj][m][0], v1 = acc[ai][bj][m][1];
                    if (ACT == 1) {
#pragma unroll
                        for (int e = 0; e < 4; ++e) { float a = fmaxf(v0[e], 0.f), b = fmaxf(v1[e], 0.f); v0[e] = a * a; v1[e] = b * b; } }
                    h16x8 w; w[0] = (h16)v0[0]; w[1] = (h16)v0[1]; w[2] = (h16)v0[2]; w[3] = (h16)v0[3]; w[4] = (h16)v1[0]; w[5] = (h16)v1[1]; w[6] = (h16)v1[2]; w[7] = (h16)v1[3];
                    *(h16x8*)(rowp + bj * HALF) = w; } }
    }
};
struct EpiRes {
    const float* src; float* dst; int ldc;
    __device__ __forceinline__ void operator()(const f32x4 (&acc)[2][2][4][2], const Unit& u, int wr, int wc, int fr, int fq) const {
        const int row0 = u.pm * BM + wr * 64 + fr; const int col0 = u.pn * BM + wc * 32 + 8 * fq;
#pragma unroll
        for (int ai = 0; ai < 2; ++ai)
#pragma unroll
            for (int m = 0; m < 4; ++m) { const size_t off = (size_t)(row0 + ai * HALF + m * 16) * ldc + col0;
#pragma unroll
                for (int bj = 0; bj < 2; ++bj) {
                    const f32x4 s0 = *(const f32x4*)(src + off + bj * HALF), s1 = *(const f32x4*)(src + off + bj * HALF + 4);
                    *(f32x4*)(dst + off + bj * HALF) = s0 + acc[ai][bj][m][0]; *(f32x4*)(dst + off + bj * HALF + 4) = s1 + acc[ai][bj][m][1]; } }
    }
};

template <class Epi, class Sched>
__device__ __forceinline__ void gemm_phase(LAS unsigned char* lds, const Gemm g, const Sched& S, const Epi& E, const int tid) {
    const int wid = __builtin_amdgcn_readfirstlane(tid >> 6), lane = tid & 63, wr = wid >> 2, wc = wid & 3, fr = lane & 15, fq = lane >> 4;
    const int K = g.K, nt = K / BK;
    unsigned voffA[2], voffB[2];
#pragma unroll
    for (int i = 0; i < 2; ++i) { int R, C; stage_rc(tid * 16 + i * 8192, R, C); const int Rb = (R & ~31) + perm32(R & 31);
        voffA[i] = (unsigned)(R * K + C) * 2u; voffB[i] = (unsigned)(Rb * K + C) * 2u; }
    const size_t kstep = (size_t)(BK * 2);
    const size_t hstep = (size_t)HALF * K * 2;
    const size_t tstep = 2 * hstep;
    const unsigned ldsw = (unsigned)wid * 1024u;
    const int aoff = lds_byte(wr * 64 + fr, fq * 8), boff = lds_byte(wc * 32 + fr, fq * 8);
#define PG8_SA(b, h) (((b) * 2 + (h)) * HTB)
#define PG8_SB(b, h) ((4 + (b) * 2 + (h)) * HTB)
#define PG8_STAGE(bufoff, gbase, voff) do { _Pragma("unroll") for (int _i = 0; _i < 2; ++_i) \
        __builtin_amdgcn_global_load_lds((const unsigned*)((const char*)(gbase) + (voff)[_i]), (LAS unsigned*)(lds + (bufoff) + ldsw + _i * 8192), 16, 0, 0); } while (0)
#define PG8_LDA(dst, b, h) do { _Pragma("unroll") for (int m = 0; m < 4; ++m) _Pragma("unroll") for (int k = 0; k < 2; ++k) dst[m][k] = *(const LAS h16x8*)(lds + PG8_SA(b, h) + aoff + m * 2048 + k * 1024); } while (0)
#define PG8_LDB(dst, b, h) do { _Pragma("unroll") for (int n = 0; n < 2; ++n) _Pragma("unroll") for (int k = 0; k < 2; ++k) dst[n][k] = *(const LAS h16x8*)(lds + PG8_SB(b, h) + boff + n * 2048 + k * 1024); } while (0)
#define PG8_MMA(ai, bj, At, Bt) do { __builtin_amdgcn_s_setprio(1); _Pragma("unroll") for (int m = 0; m < 4; ++m) _Pragma("unroll") for (int n = 0; n < 2; ++n) _Pragma("unroll") for (int k = 0; k < 2; ++k) \
        acc[ai][bj][m][n] = __builtin_amdgcn_mfma_f32_16x16x32_f16(Bt[n][k], At[m][k], acc[ai][bj][m][n], 0, 0, 0); __builtin_amdgcn_s_setprio(0); } while (0)
#define PG8_WAIT_V(n) asm volatile("s_waitcnt vmcnt(" #n ")" ::: "memory")
#define PG8_WAIT_L(n) asm volatile("s_waitcnt lgkmcnt(" #n ")" ::: "memory")
#define PG8_BAR __builtin_amdgcn_s_barrier()
#define PG8_SCHED __builtin_amdgcn_sched_barrier(0)
    Unit cur, nxt; int ui = 0;
    if (!S.next(0, cur)) return;
    f32x4 acc[2][2][4][2];
#pragma unroll
    for (int a = 0; a < 2; ++a)
#pragma unroll
        for (int b = 0; b < 2; ++b)
#pragma unroll
            for (int m = 0; m < 4; ++m)
#pragma unroll
                for (int n = 0; n < 2; ++n) acc[a][b][m][n] = (f32x4){0.f, 0.f, 0.f, 0.f};
    h16x8 At[4][2], B0[2][2], B1[2][2];
    const char* cA = (const char*)g.A + (size_t)cur.pm * tstep; const char* cB = (const char*)g.Bt + (size_t)cur.pn * tstep;
    PG8_STAGE(PG8_SB(0, 0), cB, voffB); PG8_STAGE(PG8_SB(0, 1), cB + hstep, voffB); PG8_STAGE(PG8_SA(0, 0), cA, voffA); PG8_STAGE(PG8_SA(0, 1), cA + hstep, voffA);
    if (wr == 1) PG8_BAR;
    PG8_WAIT_V(2); PG8_BAR;
    PG8_STAGE(PG8_SB(1, 0), cB + kstep, voffB); PG8_STAGE(PG8_SA(1, 0), cA + kstep, voffA); PG8_STAGE(PG8_SB(1, 1), cB + hstep + kstep, voffB);
    PG8_WAIT_V(6); PG8_BAR;
    for (;;) {
        const bool has_next = S.next(ui + 1, nxt);
        const char* nA = has_next ? (const char*)g.A + (size_t)nxt.pm * tstep : cA; const char* nB = has_next ? (const char*)g.Bt + (size_t)nxt.pn * tstep : cB;
        for (int t = 0; t < nt; t += 2) {
            const bool last = (t == nt - 2);
            const char* a1 = cA + (size_t)(t + 1) * kstep;
            const char* a2 = last ? nA : cA + (size_t)(t + 2) * kstep; const char* b2 = last ? nB : cB + (size_t)(t + 2) * kstep;
            const char* a3 = a2 + kstep; const char* b3 = b2 + kstep;
            PG8_LDB(B0, 0, 0); PG8_LDB(B1, 0, 1); PG8_SCHED; PG8_LDA(At, 0, 0); PG8_STAGE(PG8_SA(1, 1), a1 + hstep, voffA);
            PG8_WAIT_V(8); PG8_WAIT_L(0); PG8_BAR; PG8_MMA(0, 0, At, B0); PG8_MMA(0, 1, At, B1); PG8_BAR; PG8_SCHED;
            PG8_LDA(At, 0, 1); PG8_STAGE(PG8_SB(0, 0), b2, voffB); PG8_STAGE(PG8_SB(0, 1), b2 + hstep, voffB); PG8_STAGE(PG8_SA(0, 0), a2, voffA);
            PG8_WAIT_V(8); PG8_WAIT_L(0); PG8_BAR; PG8_MMA(1, 0, At, B0); PG8_MMA(1, 1, At, B1); PG8_BAR; PG8_SCHED;
            PG8_LDB(B0, 1, 0); PG8_LDB(B1, 1, 1); PG8_SCHED; PG8_LDA(At, 1, 0); PG8_STAGE(PG8_SA(0, 1), a2 + hstep, voffA);
            PG8_WAIT_V(8); PG8_WAIT_L(0); PG8_BAR; PG8_MMA(0, 0, At, B0); PG8_MMA(0, 1, At, B1); PG8_BAR; PG8_SCHED;
            PG8_LDA(At, 1, 1); PG8_STAGE(PG8_SB(1, 0), b3, voffB); PG8_STAGE(PG8_SB(1, 1), b3 + hstep, voffB); PG8_STAGE(PG8_SA(1, 0), a3, voffA);
            PG8_WAIT_V(8); PG8_WAIT_L(0); PG8_BAR; PG8_MMA(1, 0, At, B0); PG8_MMA(1, 1, At, B1); PG8_BAR; PG8_SCHED;
        }
        if (wr == 0) PG8_BAR;
        E(acc, cur, wr, wc, fr, fq);
        if (!has_next) break;
#pragma unroll
        for (int a = 0; a < 2; ++a)
#pragma unroll
            for (int b = 0; b < 2; ++b)
#pragma unroll
                for (int m = 0; m < 4; ++m)
#pragma unroll
                    for (int n = 0; n < 2; ++n) acc[a][b][m][n] = (f32x4){0.f, 0.f, 0.f, 0.f};
        cur = nxt; cA = nA; cB = nB; ++ui;
        if (wr == 1) PG8_BAR;
    }
    PG8_WAIT_V(0);
    PG8_BAR;
#undef PG8_SA
#undef PG8_SB
#undef PG8_STAGE
#undef PG8_LDA
#undef PG8_LDB
#undef PG8_MMA
#undef PG8_WAIT_V
#undef PG8_WAIT_L
#undef PG8_BAR
#undef PG8_SCHED
}
}


#define XB_TMO      128
#define XB_XCNT(j)  (256  + 64 * (j))
#define XB_XSUB(j)  (1280 + 64 * (j))
#define XB_XGEN(j)  (2304 + 64 * (j))
#define XB_TOP      3328
#define XB_TOPGEN   3392
#define XCD_BAR_WORDS 3456
#define XB_SPIN_CAP (1u << 22)
__device__ __forceinline__ unsigned xb_ld(unsigned* p)              { return __hip_atomic_load(p, __ATOMIC_RELAXED, __HIP_MEMORY_SCOPE_AGENT); }
__device__ __forceinline__ unsigned xb_add(unsigned* p, unsigned v) { return __hip_atomic_fetch_add(p, v, __ATOMIC_RELAXED, __HIP_MEMORY_SCOPE_AGENT); }
__device__ __forceinline__ unsigned xb_xcc_id() { return (unsigned)__builtin_amdgcn_s_getreg((3 << 11) | 20) & 0xFu; }
#define XB_SPIN(cond, bar) do { unsigned _sp = 0; while (cond) { __builtin_amdgcn_s_sleep(1); \
    if ((++_sp & 255u) == 0u) { if (xb_ld(&(bar)[XB_TMO])) break; if (_sp > XB_SPIN_CAP) { atomicAdd(&(bar)[XB_TMO], 1u); break; } } } } while (0)
struct XcdBarrier { unsigned* bar; unsigned x; volatile LAS unsigned* st; };
__device__ __forceinline__ XcdBarrier xcd_barrier_post(unsigned* bar, volatile LAS unsigned* st) {
    XcdBarrier b; b.bar = bar; b.x = xb_xcc_id(); b.st = st;
    if (threadIdx.x == 0) (void)xb_add(&bar[XB_XCNT(b.x)], 1u);
    return b;
}
__device__ __forceinline__ void xcd_barrier_complete(unsigned* bar, unsigned x, unsigned& nloc, unsigned& nx) {
    const unsigned G = gridDim.x * gridDim.y * gridDim.z;
    unsigned sum, cnt, mine, sp = 0u;
    for (;;) {
        sum = 0u; cnt = 0u; mine = 0u;
#pragma unroll
        for (unsigned j = 0; j < 16; ++j) { const unsigned c = xb_ld(&bar[XB_XCNT(j)]); sum += c; cnt += (c > 0u) ? 1u : 0u; mine = (j == x) ? c : mine; }
        if (sum == G) break;
        __builtin_amdgcn_s_sleep(1);
        if ((++sp & 255u) == 0u) { if (xb_ld(&bar[XB_TMO])) break; if (sp > XB_SPIN_CAP) { atomicAdd(&bar[XB_TMO], 1u); break; } }
    }
    nloc = mine > 0u ? mine : 1u; nx = cnt > 0u ? cnt : 1u;
}
__device__ __forceinline__ void xcd_barrier(const XcdBarrier& b) {
    asm volatile("s_waitcnt vmcnt(0)" ::: "memory");
    __syncthreads();
    if (threadIdx.x == 0) {
        unsigned* bar = b.bar;
        __builtin_amdgcn_s_waitcnt(0);
        unsigned nloc = b.st[0], nx = b.st[1];
        if (nloc == 0u) { xcd_barrier_complete(bar, b.x, nloc, nx); b.st[0] = nloc; b.st[1] = nx; }
        const unsigned old = xb_add(&bar[XB_XSUB(b.x)], 1u);
        const unsigned gen = old / nloc;
        if (old + 1u == (gen + 1u) * nloc) {
            __builtin_amdgcn_fence(__ATOMIC_RELEASE, "agent");
            asm volatile("s_waitcnt vmcnt(0)" ::: "memory");
            const unsigned og = xb_add(&bar[XB_TOP], 1u);
            const unsigned tg = og / nx;
            if (og + 1u == (tg + 1u) * nx) xb_add(&bar[XB_TOPGEN], 1u);
            else XB_SPIN(xb_ld(&bar[XB_TOPGEN]) == tg, bar);
            __builtin_amdgcn_fence(__ATOMIC_ACQUIRE, "agent");
            xb_add(&bar[XB_XGEN(b.x)], 1u);
            asm volatile("s_waitcnt vmcnt(0)" ::: "memory");
        } else {
            XB_SPIN(xb_ld(&bar[XB_XGEN(b.x)]) == gen, bar);
            __builtin_amdgcn_fence(__ATOMIC_ACQUIRE, "agent");
            asm volatile("s_waitcnt vmcnt(0)" ::: "memory");
        }
    }
    __syncthreads();
}

struct Ctx {
    const float* in[32]; LAS unsigned char* lds; int tid, lane, wave, gw, ngw, gtid, ngt;
    int layer, j, grp, nseq, T;
    const float* hsrc; float* hdst;
    unsigned char* ws;
};
#define IN(k) (C.in[k])

__device__ __forceinline__ void transpose_item(const float* W, int ldw, int c0, int nvalid, int K, int Npad, h16* WT, LAS float* scr, int item, int lane) {
    const int nblk = Npad / 32, kb = item / nblk, nb = item % nblk, k0 = 64 * kb, n0 = 32 * nb;
    const int n = n0 + (lane & 31);
#pragma unroll 8
    for (int i = 0; i < 32; ++i) { const int kk = 2 * i + (lane >> 5); scr[kk * 33 + (lane & 31)] = (n < nvalid) ? W[(size_t)(k0 + kk) * ldw + c0 + n] : 0.f; }
    WAVE_SYNC();
    const int c = lane & 7;
#pragma unroll
    for (int jj = 0; jj < 4; ++jj) { const int nn = (lane >> 3) + 8 * jj; const LAS float* s = scr + (8 * c) * 33 + nn;
        h16x8 o;
#pragma unroll
        for (int e = 0; e < 8; ++e) o[e] = (h16)s[e * 33];
        *(h16x8*)(WT + (size_t)(n0 + nn) * K + k0 + 8 * c) = o; }
    WAVE_SYNC();
}
__device__ __forceinline__ void phase_weights(Ctx& C) {
    LAS float* scr = (LAS float*)(C.lds + C.wave * 12288);
    const int layer = C.layer, j = C.j;
    const bool ab = (layer & 1) == 0;
    const float* Win = ab ? IN(I_ABW) + (size_t)j * D * AB_IN : IN(I_CDW) + (size_t)j * D * CD_IN;
    const int ldw = ab ? AB_IN : CD_IN;
    const int n1 = ab ? A_IN : C_IN, n1p = ab ? LDA_ : LDC_, n2 = ab ? B_IN : D_IN, n2p = ab ? LDB_ : LDD_;
    const int it1 = (D / 64) * (n1p / 32), it2 = (D / 64) * (n2p / 32), it3 = (MIXW / 64) * (D / 32), it4 = (D / 64) * (FF / 32), it5 = (FF / 64) * (D / 32);
    const int total = it1 + it2 + it3 + it4 + it5;
    for (int it = C.gw; it < total; it += C.ngw) {
        int r = it;
        if (r < it1) { transpose_item(Win, ldw, 0, n1, D, n1p, (h16*)(C.ws + W_IN1), scr, r, C.lane); continue; } r -= it1;
        if (r < it2) { transpose_item(Win, ldw, n1, n2, D, n2p, (h16*)(C.ws + W_IN2), scr, r, C.lane); continue; } r -= it2;
        if (r < it3) { transpose_item(IN(I_WOUT) + (size_t)layer * MIXW * D, D, 0, D, MIXW, D, (h16*)(C.ws + W_OUT), scr, r, C.lane); continue; } r -= it3;
        if (r < it4) { transpose_item(IN(I_W1) + (size_t)layer * D * FF, FF, 0, FF, D, FF, (h16*)(C.ws + W_F1), scr, r, C.lane); continue; } r -= it4;
        transpose_item(IN(I_W2) + (size_t)layer * FF * D, D, 0, D, FF, D, (h16*)(C.ws + W_F2), scr, r, C.lane);
    }
    if (layer == 0) {
        float* rot = (float*)(C.ws + WS_ROT);
        for (int idx = C.gtid; idx < 16384 * 64; idx += C.ngt) { const int t = idx >> 6, i = idx & 63;
            const float invf = exp2f(-(float)i * (13.287712379549449f / 64.f)); const float ang = (float)t * invf;
            rot[t * 128 + i] = cosf(ang); rot[t * 128 + 64 + i] = sinf(ang); }
    }
}
__device__ __forceinline__ void phase_norm(Ctx& C, const float* src, const float* gain, h16* dst) {
    const f32x4 g0 = ((const f32x4*)gain)[C.lane], g1 = ((const f32x4*)gain)[64 + C.lane], g2 = ((const f32x4*)gain)[128 + C.lane], g3 = ((const f32x4*)gain)[192 + C.lane];
    for (int m = C.gw; m < MG; m += C.ngw) {
        const f32x4* xr = (const f32x4*)(src + (size_t)m * D) + C.lane;
        f32x4 v[4]; float s = 0.f;
#pragma unroll
        for (int q = 0; q < 4; ++q) { v[q] = xr[64 * q]; s += (v[q].x * v[q].x + v[q].y * v[q].y) + (v[q].z * v[q].z + v[q].w * v[q].w); }
        const float rstd = rsqrtf(wave_sum(s) * (1.f / D) + 1e-5f);
        v[0] = v[0] * g0 * rstd; v[1] = v[1] * g1 * rstd; v[2] = v[2] * g2 * rstd; v[3] = v[3] * g3 * rstd;
        h16x4* o = (h16x4*)(dst + (size_t)m * D) + C.lane;
#pragma unroll
        for (int q = 0; q < 4; ++q) { h16x4 w; w[0] = (h16)v[q].x; w[1] = (h16)v[q].y; w[2] = (h16)v[q].z; w[3] = (h16)v[q].w; o[64 * q] = w; }
    }
}
__device__ __forceinline__ void phase_final_norm(Ctx& C, float* io, const float* gain) {
    const f32x4 g0 = ((const f32x4*)gain)[C.lane], g1 = ((const f32x4*)gain)[64 + C.lane], g2 = ((const f32x4*)gain)[128 + C.lane], g3 = ((const f32x4*)gain)[192 + C.lane];
    for (int m = C.gw; m < 2 * MG; m += C.ngw) {
        f32x4* xr = (f32x4*)(io + (size_t)m * D) + C.lane;
        f32x4 v[4]; float s = 0.f;
#pragma unroll
        for (int q = 0; q < 4; ++q) { v[q] = xr[64 * q]; s += (v[q].x * v[q].x + v[q].y * v[q].y) + (v[q].z * v[q].z + v[q].w * v[q].w); }
        const float rstd = rsqrtf(wave_sum(s) * (1.f / D) + 1e-5f);
        xr[0] = v[0] * g0 * rstd; xr[64] = v[1] * g1 * rstd; xr[128] = v[2] * g2 * rstd; xr[192] = v[3] * g3 * rstd;
    }
}

template <int KS, int MODE, int NT>
__device__ __forceinline__ void rwkv_lora(Ctx& C, int col0, const float* Wl, const float* bias, h16* outp, int ldo, int noff) {
    const int lane = C.lane, fr = lane & 15, fq = lane >> 4, w = C.wave, T = C.T;
    const h16* U = (const h16*)(C.ws + WS_U);
    const float* mu0p = IN(I_MU) + (size_t)C.j * 2 * A_IN, *mu1p = mu0p + A_IN;
    h16x8 bf[NT][KS];
#pragma unroll
    for (int nt = 0; nt < NT; ++nt)
#pragma unroll
        for (int ks = 0; ks < KS; ++ks)
#pragma unroll
            for (int e = 0; e < 8; ++e) bf[nt][ks][e] = (h16)Wl[(size_t)(ks * 32 + fq * 8 + e) * 512 + w * 64 + noff + nt * 16 + fr];
    float bv[NT];
#pragma unroll
    for (int nt = 0; nt < NT; ++nt) bv[nt] = bias ? bias[w * 64 + noff + nt * 16 + fr] : 0.f;
    for (int tile = blockIdx.x; tile < MG / 16; tile += gridDim.x) {
        f32x4 acc[NT];
#pragma unroll
        for (int nt = 0; nt < NT; ++nt) acc[nt] = (f32x4){0.f, 0.f, 0.f, 0.f};
        const int tok = tile * 16 + fr, t = tok % T;
#pragma unroll
        for (int ks = 0; ks < KS; ++ks) {
            const int c = col0 + ks * 32 + fq * 8;
            const h16* up = U + (size_t)tok * LDA_ + c;
            const h16x8 cur = *(const h16x8*)up;
            h16x8 prv, nxt;
#pragma unroll
            for (int e = 0; e < 8; ++e) { prv[e] = (h16)0.f; nxt[e] = (h16)0.f; }
            if (t > 0) prv = *(const h16x8*)(up - LDA_);
            if (t < T - 1) nxt = *(const h16x8*)(up + LDA_);
            h16x8 af;
#pragma unroll
            for (int e = 0; e < 8; ++e) { const float x = (float)cur[e]; float y = x + mu0p[c + e] * ((float)prv[e] - x) + mu1p[c + e] * ((float)nxt[e] - x);
                if (MODE == 0) y = tanhf(y); else if (MODE == 2) y = sigm(y);
                af[e] = (h16)y; }
#pragma unroll
            for (int nt = 0; nt < NT; ++nt) acc[nt] = __builtin_amdgcn_mfma_f32_16x16x32_f16(af, bf[nt][ks], acc[nt], 0, 0, 0);
        }
#pragma unroll
        for (int nt = 0; nt < NT; ++nt)
#pragma unroll
            for (int e = 0; e < 4; ++e) { const int otok = tile * 16 + fq * 4 + e, n = w * 64 + noff + nt * 16 + fr; float y = acc[nt][e] + bv[nt];
                if (MODE == 0) y = sigm(y) * 0.6065306597126334f; else if (MODE == 1) y = sigm(y);
                outp[(size_t)otok * ldo + n] = (h16)y; }
    }
}
__device__ __forceinline__ void rwkv_pre(Ctx& C) {
    h16* U2 = (h16*)(C.ws + WS_U + 64 * MiB); h16* G = (h16*)(C.ws + WS_MIX) + 512;
    const int j = C.j;
    for (int d = 0; d < 2; ++d) {
        rwkv_lora<2, 0, 4>(C, 1536 + 64 * d, IN(I_RW2) + (size_t)(j * 2 + d) * 64 * 512, IN(I_W0) + (size_t)(j * 2 + d) * 512, U2 + d * 1024, 2048, 0);
        rwkv_lora<2, 1, 4>(C, 1664 + 64 * d, IN(I_A2) + (size_t)(j * 2 + d) * 64 * 512, IN(I_A0) + (size_t)(j * 2 + d) * 512, U2 + d * 1024 + 512, 2048, 0);
    }
    for (int hf = 0; hf < 2; ++hf) rwkv_lora<4, 2, 2>(C, 1792, IN(I_G2) + (size_t)j * 128 * 512, nullptr, G, MIXW, hf * 32);
}
template <int PASS>
__device__ __forceinline__ void rwkv_scan(Ctx& C) {
    const int lane = C.lane, T = C.T, NC = T / CH_R, j = C.j;
    const int nunits = C.nseq * 2 * NC * 8;
    const h16* U = (const h16*)(C.ws + WS_U); const h16* U2 = (const h16*)(C.ws + WS_U + 64 * MiB);
    LAS float* wl = (LAS float*)(C.lds + C.wave * 12288);
    const float* mu0p = IN(I_MU) + (size_t)j * 2 * A_IN, *mu1p = mu0p + A_IN;
    for (int unit = C.gw; unit < nunits; unit += C.ngw) {
        const int hd = unit & 7; int r = unit >> 3; const int c = r % NC; r /= NC; const int dir = r & 1, b = r >> 1;
        const int col = hd * 64 + lane;
        const float m0r = mu0p[col], m1r = mu1p[col], m0k = mu0p[512 + col], m1k = mu1p[512 + col], m0v = mu0p[1024 + col], m1v = mu1p[1024 + col];
        const float kkw = IN(I_KK)[j * 512 + col], kaw = IN(I_KA)[j * 512 + col];
        float* slot = (float*)(C.ws + WS_ST) + (size_t)((((b * 2 + dir) * NC + c) * 8) + hd) * 8192;
        float S[64], P[64];
        if (PASS == 1) {
            int ln = lane; asm volatile("" : "+v"(ln));
#pragma unroll
            for (int q = 0; q < 64; ++q) { S[q] = 0.f; P[q] = (q == ln) ? 1.f : 0.f; }
        } else {
#pragma unroll
            for (int q = 0; q < 16; ++q) { const f32x4 v = *(const f32x4*)(slot + lane * 64 + q * 4); S[4 * q] = v.x; S[4 * q + 1] = v.y; S[4 * q + 2] = v.z; S[4 * q + 3] = v.w; }
        }
        h16* outp = (dir == 0) ? (h16*)(C.ws + WS_MIX) : (h16*)(C.ws + WS_O);
        const int ldo = (dir == 0) ? MIXW : 512;
#pragma unroll 1
        for (int sub = 0; sub < CH_R / SUB; ++sub) {
#pragma unroll 1
            for (int s = 0; s < SUB; ++s) {
                const int p = c * CH_R + sub * SUB + s, t = dir ? T - 1 - p : p; const size_t tok = (size_t)b * T + t;
                const h16* ur = U + tok * LDA_ + col;
                const float rc = (float)ur[0], kc = (float)ur[512], vc = (float)ur[1024];
                float rp = 0.f, kp = 0.f, vp = 0.f, rn = 0.f, kn = 0.f, vn = 0.f;
                if (t > 0) { rp = (float)ur[-LDA_]; kp = (float)ur[512 - LDA_]; vp = (float)ur[1024 - LDA_]; }
                if (t < T - 1) { rn = (float)ur[LDA_]; kn = (float)ur[512 + LDA_]; vn = (float)ur[1024 + LDA_]; }
                const float rr = rc + m0r * (rp - rc) + m1r * (rn - rc), kk_ = kc + m0k * (kp - kc) + m1k * (kn - kc), vv = vc + m0v * (vp - vc) + m1v * (vn - vc);
                const float e = (float)U2[tok * 2048 + dir * 1024 + col], av = (float)U2[tok * 2048 + dir * 1024 + 512 + col];
                const float wdec = __expf(-e);
                const float kx = kk_ * kkw; const float n2 = wave_sum(kx * kx); const float kkn = kx / fmaxf(sqrtf(n2), 1e-12f);
                LAS float* q = wl + s * 384;
                q[lane] = wdec; q[64 + lane] = kkn; q[128 + lane] = kkn * av; q[192 + lane] = kk_ * (1.f + (av - 1.f) * kaw); q[256 + lane] = rr; q[320 + lane] = vv;
            }
            WAVE_SYNC();
#pragma unroll 1
            for (int s = 0; s < SUB; ++s) {
                const LAS f32x4* q = (const LAS f32x4*)(wl + s * 384);
                const float vv = wl[s * 384 + 320 + lane];
                float sa0 = 0.f, sa1 = 0.f, sp0 = 0.f, sp1 = 0.f;
#pragma unroll
                for (int k4 = 0; k4 < 16; ++k4) { const f32x4 kk4 = q[16 + k4];
                    sa0 += S[4 * k4] * kk4.x + S[4 * k4 + 2] * kk4.z; sa1 += S[4 * k4 + 1] * kk4.y + S[4 * k4 + 3] * kk4.w;
                    if (PASS == 1) { sp0 += P[4 * k4] * kk4.x + P[4 * k4 + 2] * kk4.z; sp1 += P[4 * k4 + 1] * kk4.y + P[4 * k4 + 3] * kk4.w; }
                    if ((k4 & 3) == 3) __builtin_amdgcn_sched_barrier(0); }
                const float sa = -(sa0 + sa1), sp = -(sp0 + sp1);
                float o0 = 0.f, o1 = 0.f;
#pragma unroll
                for (int k4 = 0; k4 < 16; ++k4) { const f32x4 w4 = q[k4], b4 = q[32 + k4], d4 = q[48 + k4];
                    S[4 * k4] = S[4 * k4] * w4.x + sa * b4.x + vv * d4.x; S[4 * k4 + 1] = S[4 * k4 + 1] * w4.y + sa * b4.y + vv * d4.y;
                    S[4 * k4 + 2] = S[4 * k4 + 2] * w4.z + sa * b4.z + vv * d4.z; S[4 * k4 + 3] = S[4 * k4 + 3] * w4.w + sa * b4.w + vv * d4.w;
                    if (PASS == 1) { P[4 * k4] = P[4 * k4] * w4.x + sp * b4.x; P[4 * k4 + 1] = P[4 * k4 + 1] * w4.y + sp * b4.y; P[4 * k4 + 2] = P[4 * k4 + 2] * w4.z + sp * b4.z; P[4 * k4 + 3] = P[4 * k4 + 3] * w4.w + sp * b4.w; }
                    else { const f32x4 r4 = q[64 + k4]; o0 += S[4 * k4] * r4.x + S[4 * k4 + 2] * r4.z; o1 += S[4 * k4 + 1] * r4.y + S[4 * k4 + 3] * r4.w; }
                    if ((k4 & 1) == 1) __builtin_amdgcn_sched_barrier(0); }
                if (PASS == 2) { const int p = c * CH_R + sub * SUB + s, t = dir ? T - 1 - p : p; outp[((size_t)b * T + t) * ldo + col] = (h16)(o0 + o1); }
            }
            WAVE_SYNC();
        }
        if (PASS == 1) {
#pragma unroll
            for (int q = 0; q < 16; ++q) { *(f32x4*)(slot + lane * 64 + q * 4) = (f32x4){S[4 * q], S[4 * q + 1], S[4 * q + 2], S[4 * q + 3]};
                *(f32x4*)(slot + 4096 + lane * 64 + q * 4) = (f32x4){P[4 * q], P[4 * q + 1], P[4 * q + 2], P[4 * q + 3]}; }
        }
    }
}
__device__ __forceinline__ void rwkv_cross(Ctx& C) {
    const int T = C.T, NC = T / CH_R, nunits = C.nseq * 16 * 8, tid = C.tid;
    LAS float* Cs = (LAS float*)C.lds; LAS float* Ps = Cs + 512;
    const int il = tid >> 6, jc = tid & 63;
    for (int unit = blockIdx.x; unit < nunits; unit += gridDim.x) {
        const int chain = unit >> 3, rg = unit & 7, hd = chain & 7, dir = (chain >> 3) & 1, b = chain >> 4;
        const int i = rg * 8 + il;
        float* base = (float*)(C.ws + WS_ST) + (size_t)((((b * 2 + dir) * NC) * 8) + hd) * 8192;
        float cr = 0.f;
        f32x4 p0 = *(const f32x4*)(base + 4096 + tid * 8), p1 = *(const f32x4*)(base + 4096 + tid * 8 + 4); float sl = base[i * 64 + jc];
        __syncthreads();
        for (int c = 0; c < NC; ++c) {
            float* cb = base + (size_t)c * 8 * 8192;
            *(LAS f32x4*)(Ps + tid * 8) = p0; *(LAS f32x4*)(Ps + tid * 8 + 4) = p1; Cs[il * 64 + jc] = cr;
            cb[i * 64 + jc] = cr;
            __syncthreads();
            float nr = sl;
            if (c + 1 < NC) { const float* nb = cb + 8 * 8192; p0 = *(const f32x4*)(nb + 4096 + tid * 8); p1 = *(const f32x4*)(nb + 4096 + tid * 8 + 4); sl = nb[i * 64 + jc]; }
#pragma unroll
            for (int m4 = 0; m4 < 16; ++m4) { const f32x4 cm = *(const LAS f32x4*)(Cs + il * 64 + m4 * 4);
                nr += cm.x * Ps[(m4 * 4) * 64 + jc]; nr += cm.y * Ps[(m4 * 4 + 1) * 64 + jc]; nr += cm.z * Ps[(m4 * 4 + 2) * 64 + jc]; nr += cm.w * Ps[(m4 * 4 + 3) * 64 + jc]; }
            __syncthreads();
            cr = nr;
        }
    }
}
__device__ __forceinline__ void rwkv_final(Ctx& C) {
    const int lane = C.lane, T = C.T, j = C.j, c0 = lane * 8;
    const h16* U = (const h16*)(C.ws + WS_U); h16* MIX = (h16*)(C.ws + WS_MIX); const h16* O = (const h16*)(C.ws + WS_O);
    const float* mu0p = IN(I_MU) + (size_t)j * 2 * A_IN, *mu1p = mu0p + A_IN;
    for (int tok = C.gw; tok < MG; tok += C.ngw) {
        const int t = tok % T;
        const h16x8 of = *(const h16x8*)(MIX + (size_t)tok * MIXW + c0), ob = *(const h16x8*)(O + (size_t)tok * 512 + c0), gg = *(const h16x8*)(MIX + (size_t)tok * MIXW + 512 + c0);
        float o[8], s = 0.f;
#pragma unroll
        for (int e = 0; e < 8; ++e) { o[e] = (float)of[e] + (float)ob[e]; s += o[e]; }
        s += __shfl_xor(s, 1); s += __shfl_xor(s, 2); s += __shfl_xor(s, 4);
        const float mean = s * (1.f / 64.f); float v2 = 0.f;
#pragma unroll
        for (int e = 0; e < 8; ++e) { o[e] -= mean; v2 += o[e] * o[e]; }
        v2 += __shfl_xor(v2, 1); v2 += __shfl_xor(v2, 2); v2 += __shfl_xor(v2, 4);
        const float rstd = rsqrtf(v2 * (1.f / 64.f) + 64e-5f);
        float rv[3][8];
#pragma unroll
        for (int part = 0; part < 3; ++part) {
            const h16* up = U + (size_t)tok * LDA_ + part * 512 + c0;
            const h16x8 cur = *(const h16x8*)up; h16x8 prv, nxt;
#pragma unroll
            for (int e = 0; e < 8; ++e) { prv[e] = (h16)0.f; nxt[e] = (h16)0.f; }
            if (t > 0) prv = *(const h16x8*)(up - LDA_);
            if (t < T - 1) nxt = *(const h16x8*)(up + LDA_);
#pragma unroll
            for (int e = 0; e < 8; ++e) { const float x = (float)cur[e]; rv[part][e] = x + mu0p[part * 512 + c0 + e] * ((float)prv[e] - x) + mu1p[part * 512 + c0 + e] * ((float)nxt[e] - x); }
        }
        float rk = 0.f;
#pragma unroll
        for (int e = 0; e < 8; ++e) rk += rv[0][e] * rv[1][e] * IN(I_RK)[j * 512 + c0 + e];
        rk += __shfl_xor(rk, 1); rk += __shfl_xor(rk, 2); rk += __shfl_xor(rk, 4);
        h16x8 w;
#pragma unroll
        for (int e = 0; e < 8; ++e) { const float y = o[e] * rstd * IN(I_GNW)[j * 512 + c0 + e] + IN(I_GNB)[j * 512 + c0 + e]; w[e] = (h16)((y + rk * rv[2][e]) * (float)gg[e]); }
        *(h16x8*)(MIX + (size_t)tok * MIXW + c0) = w;
    }
}

enum { MX_MAMBA = 0, MX_HGRN = 1, MX_RET = 2 };
template <int MX> struct MXC;
template <> struct MXC<MX_MAMBA> { static constexpr int CH = CH_M, NH = 16, LDU = LDB_; };
template <> struct MXC<MX_HGRN>  { static constexpr int CH = CH_H, NH = 8,  LDU = LDC_; };
template <> struct MXC<MX_RET>   { static constexpr int CH = CH_T, NH = 16, LDU = LDD_; };

__device__ __forceinline__ float ret_gamma(Ctx& C, int dir, int head) { return __expf(-__expf(IN(I_RETLD)[(C.j * 2 + dir) * 4 + head])); }

__device__ __forceinline__ void mamba_pre(Ctx& C) {
    const int T = C.T, j = C.j;
    const h16* U = (const h16*)(C.ws + WS_U); h16* BC = (h16*)(C.ws + WS_U + 88 * MiB); float* DT = (float*)(C.ws + WS_U + 104 * MiB); h16* XS = (h16*)(C.ws + WS_ST + 32 * MiB);
    const float* cw = IN(I_CONVW) + (size_t)j * 4 * 1536; const float* cb = IN(I_CONVB) + (size_t)j * 1536;
    for (int idx = C.gtid; idx < MG * 192; idx += C.ngt) {
        const int tok = idx / 192, q = idx - tok * 192, t = tok % T, c = q * 8;
        float acc[8];
#pragma unroll
        for (int e = 0; e < 8; ++e) acc[e] = cb[c + e];
#pragma unroll
        for (int jj = 0; jj < 4; ++jj) { const int tt = t + jj - 2;
            if (tt >= 0 && tt < T) { const h16x8 x = *(const h16x8*)(U + (size_t)(tok + jj - 2) * LDB_ + 1024 + c);
#pragma unroll
                for (int e = 0; e < 8; ++e) acc[e] += cw[jj * 1536 + c + e] * (float)x[e]; } }
        h16x8 w;
#pragma unroll
        for (int e = 0; e < 8; ++e) w[e] = (h16)silu(acc[e]);
        if (c < 1024) *(h16x8*)(XS + (size_t)tok * 1024 + c) = w; else *(h16x8*)(BC + (size_t)tok * 512 + (c - 1024)) = w;
    }
    for (int idx = C.gtid; idx < MG * 32; idx += C.ngt) { const int tok = idx >> 5, q = idx & 31;
        const float x = (float)U[(size_t)tok * LDB_ + 2560 + q] + IN(I_DTB)[j * 32 + q];
        const float dt = (x > 20.f) ? x : log1pf(expf(x)); const float da = -dt * expf(IN(I_ALOG)[j * 32 + q]);
        DT[(size_t)tok * 64 + q] = dt; DT[(size_t)tok * 64 + 32 + q] = da; }
}

constexpr int MC_OFF = 0, MB_OFF = 17408, MX_OFF = 36864, MG_OFF = 110592, MA_OFF = 119808;
__device__ __forceinline__ void mamba_stage_bc(Ctx& C, LAS h16* dst, bool transposed, int colbase, int b, int dir, int p0) {
    const int T = C.T, m = C.tid >> 3, i0 = (C.tid & 7) * 16;
    const int p = p0 + m, t = dir ? T - 1 - p : p; const size_t tok = (size_t)b * T + t;
    const h16* BC = (const h16*)(C.ws + WS_U + 88 * MiB);
    const h16x8 x1 = *(const h16x8*)(BC + tok * 512 + colbase + i0), x2 = *(const h16x8*)(BC + tok * 512 + colbase + i0 + 8);
    if (!transposed) { *(LAS h16x8*)(dst + m * 136 + i0) = x1; *(LAS h16x8*)(dst + m * 136 + i0 + 8) = x2; }
    else {
#pragma unroll
        for (int e = 0; e < 8; ++e) { dst[(i0 + e) * 72 + m] = x1[e]; dst[(i0 + 8 + e) * 72 + m] = x2[e]; } }
}
template <bool WEIGHTED>
__device__ __forceinline__ void mamba_stage_xt(Ctx& C, LAS h16* Xt, const LAS float* As, int g, int b, int dir, int p0, int lbase) {
    const int T = C.T; const h16* XS = (const h16*)(C.ws + WS_ST + 32 * MiB); const float* DT = (const float*)(C.ws + WS_U + 104 * MiB);
#pragma unroll 2
    for (int q = 0; q < 8; ++q) { const int it = C.tid + 512 * q, m = it >> 6, cb = it & 63, hl = cb >> 3;
        const int p = p0 + m, t = dir ? T - 1 - p : p; const size_t tok = (size_t)b * T + t;
        const h16x8 x = *(const h16x8*)(XS + tok * 1024 + g * 512 + cb * 8);
        float sc = DT[tok * 64 + dir * 16 + g * 8 + hl];
        if (WEIGHTED) sc *= __expf(As[hl * 256 + 255] - As[hl * 256 + lbase + m]);
#pragma unroll
        for (int e = 0; e < 8; ++e) Xt[(cb * 8 + e) * 72 + m] = (h16)((float)x[e] * sc); }
}
__device__ __forceinline__ void mamba_cum_decay(Ctx& C, LAS float* As, int g, int b, int dir, int c) {
    const int T = C.T, lane = C.lane, w = C.wave; const float* DT = (const float*)(C.ws + WS_U + 104 * MiB);
    float d[4]; float s = 0.f;
#pragma unroll
    for (int i = 0; i < 4; ++i) { const int p = c * 256 + 4 * lane + i, t = dir ? T - 1 - p : p; d[i] = DT[((size_t)b * T + t) * 64 + 32 + dir * 16 + g * 8 + w]; s += d[i]; d[i] = s; }
    float inc = s;
#pragma unroll
    for (int off = 1; off < 64; off <<= 1) { const float tv = __shfl_up(inc, off); if (lane >= off) inc += tv; }
    const float ex = inc - s;
#pragma unroll
    for (int i = 0; i < 4; ++i) As[w * 256 + 4 * lane + i] = ex + d[i];
}
__device__ __forceinline__ void mamba_mfma_pass1(Ctx& C) {
    const int T = C.T, NCH = T / 256, nunits = C.nseq * 2 * NCH * 2, lane = C.lane, w = C.wave, fr = lane & 15, fq = lane >> 4;
    LAS h16* Bt = (LAS h16*)(C.lds + MB_OFF); LAS h16* Xt = (LAS h16*)(C.lds + MX_OFF); LAS float* As = (LAS float*)(C.lds + MA_OFF);
    for (int unit = blockIdx.x; unit < nunits; unit += gridDim.x) {
        const int g = unit & 1; int r = unit >> 1; const int c = r % NCH; r /= NCH; const int dir = r & 1, b = r >> 1;
        __syncthreads();
        mamba_cum_decay(C, As, g, b, dir, c);
        f32x4 acc[8][4];
#pragma unroll
        for (int mt = 0; mt < 8; ++mt)
#pragma unroll
            for (int nt = 0; nt < 4; ++nt) acc[mt][nt] = (f32x4){0.f, 0.f, 0.f, 0.f};
#pragma unroll 1
        for (int jb = 0; jb < 4; ++jb) {
            __syncthreads();
            mamba_stage_bc(C, Bt, true, g * 128, b, dir, c * 256 + 64 * jb);
            mamba_stage_xt<true>(C, Xt, As, g, b, dir, c * 256 + 64 * jb, 64 * jb);
            __syncthreads();
#pragma unroll
            for (int ks = 0; ks < 2; ++ks) {
                h16x8 bx[4];
#pragma unroll
                for (int nt = 0; nt < 4; ++nt) bx[nt] = *(const LAS h16x8*)(Xt + (64 * w + 16 * nt + fr) * 72 + ks * 32 + fq * 8);
#pragma unroll
                for (int mt = 0; mt < 8; ++mt) { const h16x8 a = *(const LAS h16x8*)(Bt + (16 * mt + fr) * 72 + ks * 32 + fq * 8);
#pragma unroll
                    for (int nt = 0; nt < 4; ++nt) acc[mt][nt] = __builtin_amdgcn_mfma_f32_16x16x32_f16(a, bx[nt], acc[mt][nt], 0, 0, 0); }
            }
        }
        const int slot = (((b * 2 + dir) * NCH + c) * 16) + g * 8 + w;
        h16* Hg = (h16*)(C.ws + WS_ST) + (size_t)slot * 8192;
#pragma unroll
        for (int mt = 0; mt < 8; ++mt)
#pragma unroll
            for (int nt = 0; nt < 4; ++nt) { h16x4 v; v[0] = (h16)acc[mt][nt][0]; v[1] = (h16)acc[mt][nt][1]; v[2] = (h16)acc[mt][nt][2]; v[3] = (h16)acc[mt][nt][3];
                *(h16x4*)(Hg + (size_t)(16 * nt + fr) * 128 + 16 * mt + fq * 4) = v; }
        if (lane == 0) ((float*)(C.ws + WS_DEC))[slot] = __expf(As[w * 256 + 255]);
    }
}
__device__ __forceinline__ void mamba_mfma_cross(Ctx& C) {
    const int T = C.T, NCH = T / 256, nchains = C.nseq * 2 * 16;
    const float* DEC = (const float*)(C.ws + WS_DEC);
    for (int idx = C.gtid; idx < nchains * 1024; idx += C.ngt) {
        const int chain = idx >> 10, e8 = (idx & 1023) * 8, hd = chain & 15, dir = (chain >> 4) & 1, b = chain >> 5;
        float carry[8];
#pragma unroll
        for (int e = 0; e < 8; ++e) carry[e] = 0.f;
#pragma unroll 2
        for (int c = 0; c < NCH; ++c) { const int slot = (((b * 2 + dir) * NCH + c) * 16) + hd; h16* p = (h16*)(C.ws + WS_ST) + (size_t)slot * 8192 + e8;
            const h16x8 sl = *(const h16x8*)p; const float d = DEC[slot]; h16x8 o;
#pragma unroll
            for (int e = 0; e < 8; ++e) { o[e] = (h16)carry[e]; carry[e] = d * carry[e] + (float)sl[e]; }
            *(h16x8*)p = o; }
    }
}
__device__ __forceinline__ void mamba_mfma_pass2(Ctx& C) {
    const int T = C.T, NCH = T / 256, nunits = C.nseq * 2 * NCH * 2, lane = C.lane, w = C.wave, fr = lane & 15, fq = lane >> 4;
    LAS h16* Cs = (LAS h16*)(C.lds + MC_OFF); LAS h16* Bs = (LAS h16*)(C.lds + MB_OFF); LAS h16* Xt = (LAS h16*)(C.lds + MX_OFF); LAS h16* Gs = (LAS h16*)(C.lds + MG_OFF); LAS float* As = (LAS float*)(C.lds + MA_OFF);
    for (int unit = blockIdx.x; unit < nunits; unit += gridDim.x) {
        const int g = unit & 1; int r = unit >> 1; const int c = r % NCH; r /= NCH; const int dir = r & 1, b = r >> 1;
        const int hd = g * 8 + w;
        __syncthreads();
        mamba_cum_decay(C, As, g, b, dir, c);
        const int slot = (((b * 2 + dir) * NCH + c) * 16) + hd;
        const h16* Hg = (const h16*)(C.ws + WS_ST) + (size_t)slot * 8192;
        h16* outp; int ldo; if (dir == 0) { outp = (h16*)(C.ws + WS_MIX) + 512; ldo = MIXW; } else { outp = (h16*)(C.ws + WS_O); ldo = 1024; }
#pragma unroll 1
        for (int ib = 0; ib < 4; ++ib) {
            f32x4 acc[4][4];
#pragma unroll
            for (int mt = 0; mt < 4; ++mt)
#pragma unroll
                for (int nt = 0; nt < 4; ++nt) acc[mt][nt] = (f32x4){0.f, 0.f, 0.f, 0.f};
#pragma unroll 1
            for (int jb = 0; jb <= ib; ++jb) {
                __syncthreads();
                if (jb == 0) mamba_stage_bc(C, Cs, false, 256 + g * 128, b, dir, c * 256 + 64 * ib);
                mamba_stage_bc(C, Bs, false, g * 128, b, dir, c * 256 + 64 * jb);
                mamba_stage_xt<false>(C, Xt, As, g, b, dir, c * 256 + 64 * jb, 0);
                __syncthreads();
                if (jb == 0) {
#pragma unroll
                    for (int ks = 0; ks < 4; ++ks) { h16x8 hf[4];
#pragma unroll
                        for (int nt = 0; nt < 4; ++nt) hf[nt] = *(const h16x8*)(Hg + (size_t)(16 * nt + fr) * 128 + ks * 32 + fq * 8);
#pragma unroll
                        for (int mt = 0; mt < 4; ++mt) { const h16x8 a = *(const LAS h16x8*)(Cs + (16 * mt + fr) * 136 + ks * 32 + fq * 8);
#pragma unroll
                            for (int nt = 0; nt < 4; ++nt) acc[mt][nt] = __builtin_amdgcn_mfma_f32_16x16x32_f16(a, hf[nt], acc[mt][nt], 0, 0, 0); } }
#pragma unroll
                    for (int mt = 0; mt < 4; ++mt)
#pragma unroll
                        for (int jj = 0; jj < 4; ++jj) { const float rs = __expf(As[w * 256 + 64 * ib + 16 * mt + fq * 4 + jj]);
#pragma unroll
                            for (int nt = 0; nt < 4; ++nt) acc[mt][nt][jj] *= rs; }
                }
                {
                    const int gm = w >> 1, gn = w & 1;
                    f32x4 g0 = (f32x4){0.f, 0.f, 0.f, 0.f}, g1 = (f32x4){0.f, 0.f, 0.f, 0.f};
#pragma unroll
                    for (int ks = 0; ks < 4; ++ks) { const h16x8 a = *(const LAS h16x8*)(Cs + (16 * gm + fr) * 136 + ks * 32 + fq * 8);
                        const h16x8 k0 = *(const LAS h16x8*)(Bs + (32 * gn + fr) * 136 + ks * 32 + fq * 8), k1 = *(const LAS h16x8*)(Bs + (32 * gn + 16 + fr) * 136 + ks * 32 + fq * 8);
                        g0 = __builtin_amdgcn_mfma_f32_16x16x32_f16(a, k0, g0, 0, 0, 0); g1 = __builtin_amdgcn_mfma_f32_16x16x32_f16(a, k1, g1, 0, 0, 0); }
#pragma unroll
                    for (int jj = 0; jj < 4; ++jj) { const int l = 16 * gm + fq * 4 + jj; Gs[l * 72 + 32 * gn + fr] = (h16)g0[jj]; Gs[l * 72 + 32 * gn + 16 + fr] = (h16)g1[jj]; }
                }
                __syncthreads();
#pragma unroll
                for (int ks = 0; ks < 2; ++ks) {
                    h16x8 bx[4];
#pragma unroll
                    for (int nt = 0; nt < 4; ++nt) bx[nt] = *(const LAS h16x8*)(Xt + (64 * w + 16 * nt + fr) * 72 + ks * 32 + fq * 8);
                    const LAS float* Am = As + w * 256 + 64 * jb + ks * 32 + fq * 8;
                    const f32x4 am0 = *(const LAS f32x4*)Am, am1 = *(const LAS f32x4*)(Am + 4);
                    const float am[8] = {am0.x, am0.y, am0.z, am0.w, am1.x, am1.y, am1.z, am1.w};
                    const int Mb = 64 * jb + ks * 32 + fq * 8;
#pragma unroll
                    for (int mt = 0; mt < 4; ++mt) { const int l = 16 * mt + fr, Lg = 64 * ib + l; const float Al = As[w * 256 + Lg];
                        const h16x8 gr = *(const LAS h16x8*)(Gs + l * 72 + ks * 32 + fq * 8); h16x8 a;
#pragma unroll
                        for (int e = 0; e < 8; ++e) a[e] = (h16)((Mb + e <= Lg) ? (float)gr[e] * __expf(Al - am[e]) : 0.f);
#pragma unroll
                        for (int nt = 0; nt < 4; ++nt) acc[mt][nt] = __builtin_amdgcn_mfma_f32_16x16x32_f16(a, bx[nt], acc[mt][nt], 0, 0, 0); }
                }
            }
#pragma unroll
            for (int mt = 0; mt < 4; ++mt)
#pragma unroll
                for (int jj = 0; jj < 4; ++jj) { const int Lg = 64 * ib + 16 * mt + fq * 4 + jj; const int p = c * 256 + Lg, t = dir ? T - 1 - p : p; h16* op = outp + ((size_t)b * T + t) * ldo + hd * 64 + fr;
#pragma unroll
                    for (int nt = 0; nt < 4; ++nt) op[16 * nt] = (h16)acc[mt][nt][jj]; }
        }
    }
}

template <int MX, int PASS>
__device__ __forceinline__ void diag_scan(Ctx& C) {
    constexpr int CH = MXC<MX>::CH, NH = MXC<MX>::NH, LDU = MXC<MX>::LDU;
    const int lane = C.lane, T = C.T, NC = T / CH, j = C.j;
    const int nunits = C.nseq * 2 * NC * NH;
    const h16* U = (const h16*)(C.ws + WS_U);
    const h16* BC = (const h16*)(C.ws + WS_U + 88 * MiB); const float* DT = (const float*)(C.ws + WS_U + 104 * MiB);
    const float* ROT = (const float*)(C.ws + WS_ROT);
    float* DEC = (float*)(C.ws + WS_DEC);
    LAS float* wl = (LAS float*)(C.lds + C.wave * 12288);
    for (int unit = C.gw; unit < nunits; unit += C.ngw) {
        const int hd = unit % NH; int r = unit / NH; const int c = r % NC; r /= NC; const int dir = r & 1, b = r >> 1;
        const int slotid = ((b * 2 + dir) * NC + c) * NH + hd;
        float* slot = (float*)(C.ws + WS_ST) + (size_t)slotid * 8192;
        float S[128];
        if (PASS == 1) {
#pragma unroll
            for (int q = 0; q < 128; ++q) S[q] = 0.f;
        } else {
#pragma unroll
            for (int q = 0; q < 128; ++q) S[q] = slot[q * 64 + lane];
        }
        float k0 = 0.f, k1 = 0.f, k2 = 0.f, k3 = 0.f, k4c = 0.f, gam = 1.f, dprod = 1.f, D0 = 1.f, D1 = 1.f;
        h16* outp; int ldo, ocol;
        if (MX == MX_MAMBA) { const int cc = hd * 64 + lane; const float* cw = IN(I_CONVW) + (size_t)j * 4 * 1536; k0 = cw[cc]; k1 = cw[1536 + cc]; k2 = cw[2 * 1536 + cc]; k3 = cw[3 * 1536 + cc]; k4c = IN(I_CONVB)[j * 1536 + cc];
            ocol = hd * 64 + lane; if (dir == 0) { outp = (h16*)(C.ws + WS_MIX) + 512; ldo = MIXW; } else { outp = (h16*)(C.ws + WS_O); ldo = 1024; } }
        else if (MX == MX_HGRN) {
            if (j == 1) { const float* lb = IN(I_HGLB); const int f0 = hd * 128 + lane;
                k0 = sigm(lb[(dir * 2 + 1) * 1024 + f0] - lb[(dir * 2 + 0) * 1024 + f0]); k1 = sigm(lb[(dir * 2 + 1) * 1024 + f0 + 64] - lb[(dir * 2 + 0) * 1024 + f0 + 64]); }
            ocol = hd * 64 + lane; if (dir == 0) { outp = (h16*)(C.ws + WS_MIX); ldo = MIXW; } else { outp = (h16*)(C.ws + WS_O); ldo = 512; } }
        else { gam = ret_gamma(C, dir, hd >> 2);
            ocol = hd * 64 + lane; if (dir == 0) { outp = (h16*)(C.ws + WS_MIX) + 512; ldo = MIXW; } else { outp = (h16*)(C.ws + WS_O); ldo = 1024; } }
#pragma unroll 1
        for (int sub = 0; sub < CH / SUB; ++sub) {
#pragma unroll
            for (int s = 0; s < SUB; ++s) {
                const int p = c * CH + sub * SUB + s, t = dir ? T - 1 - p : p; const size_t tok = (size_t)b * T + t;
                const h16* ur = U + tok * LDU;
                LAS float* q = wl + s * 384;
                if (MX == MX_MAMBA) {
                    const int g = hd >> 3; const h16* bc = BC + tok * 512 + g * 128 + lane;
                    q[lane] = (float)bc[0]; q[64 + lane] = (float)bc[64];
                    if (PASS == 2) { q[128 + lane] = (float)bc[256]; q[192 + lane] = (float)bc[320]; }
                    const h16* xp = ur + 1024 + hd * 64 + lane;
                    float acc = k4c + k2 * (float)xp[0];
                    if (t >= 2) acc += k0 * (float)xp[-2 * LDU];
                    if (t >= 1) acc += k1 * (float)xp[-LDU];
                    if (t < T - 1) acc += k3 * (float)xp[LDU];
                    const float dt = DT[tok * 64 + dir * 16 + hd], dA = DT[tok * 64 + 32 + dir * 16 + hd];
                    q[256 + lane] = silu(acc) * dt; q[320] = dA; dprod *= dA;
                } else if (MX == MX_HGRN) {
                    const h16* fp = ur + 1024 + dir * 1024 + hd * 128 + lane;
                    const float f0 = k0 + (1.f - k0) * sigm((float)fp[0]), f1 = k1 + (1.f - k1) * sigm((float)fp[64]);
                    q[lane] = f0; q[64 + lane] = f1; D0 *= f0; D1 *= f1;
                    if (PASS == 2) { q[128 + lane] = (float)ur[hd * 128 + lane]; q[192 + lane] = (float)ur[hd * 128 + 64 + lane]; }
                    q[256 + lane] = (float)ur[3072 + hd * 64 + lane];
                } else {
                    const int h = hd >> 2; const float cs = ROT[t * 128 + lane], sn = ROT[t * 128 + 64 + lane];
                    const float x1 = (float)ur[512 + h * 128 + lane], x2 = (float)ur[512 + h * 128 + 64 + lane];
                    q[lane] = (x1 * cs - x2 * sn) * 0.08838834764831845f; q[64 + lane] = (x2 * cs + x1 * sn) * 0.08838834764831845f;
                    if (PASS == 2) { const float y1 = (float)ur[h * 128 + lane], y2 = (float)ur[h * 128 + 64 + lane]; q[128 + lane] = y1 * cs - y2 * sn; q[192 + lane] = y2 * cs + y1 * sn; }
                    q[256 + lane] = (float)ur[1024 + hd * 64 + lane];
                }
            }
            WAVE_SYNC();
#pragma unroll 1
            for (int s = 0; s < SUB; ++s) {
                const LAS f32x4* q = (const LAS f32x4*)(wl + s * 384);
                const float vv = wl[s * 384 + 256 + lane];
                const float dec = (MX == MX_MAMBA) ? wl[s * 384 + 320] : gam;
                float o0 = 0.f, o1 = 0.f, o2 = 0.f, o3 = 0.f;
#pragma unroll
                for (int k4 = 0; k4 < 32; ++k4) { const f32x4 a4 = q[k4];
                    if (MX == MX_HGRN) { S[4 * k4] = a4.x * (S[4 * k4] - vv) + vv; S[4 * k4 + 1] = a4.y * (S[4 * k4 + 1] - vv) + vv; S[4 * k4 + 2] = a4.z * (S[4 * k4 + 2] - vv) + vv; S[4 * k4 + 3] = a4.w * (S[4 * k4 + 3] - vv) + vv; }
                    else { S[4 * k4] = S[4 * k4] * dec + a4.x * vv; S[4 * k4 + 1] = S[4 * k4 + 1] * dec + a4.y * vv; S[4 * k4 + 2] = S[4 * k4 + 2] * dec + a4.z * vv; S[4 * k4 + 3] = S[4 * k4 + 3] * dec + a4.w * vv; }
                    if (PASS == 2) { const f32x4 q4 = q[32 + k4]; o0 += S[4 * k4] * q4.x; o1 += S[4 * k4 + 1] * q4.y; o2 += S[4 * k4 + 2] * q4.z; o3 += S[4 * k4 + 3] * q4.w; } }
                if (PASS == 2) { const int p = c * CH + sub * SUB + s, t = dir ? T - 1 - p : p; outp[((size_t)b * T + t) * ldo + ocol] = (h16)((o0 + o1) + (o2 + o3)); }
            }
            WAVE_SYNC();
        }
        if (PASS == 1) {
#pragma unroll
            for (int q = 0; q < 128; ++q) slot[q * 64 + lane] = S[q];
            if (MX == MX_MAMBA) { if (lane == 0) DEC[slotid] = dprod; }
            if (MX == MX_HGRN) { DEC[(size_t)slotid * 128 + lane] = D0; DEC[(size_t)slotid * 128 + 64 + lane] = D1; }
        }
    }
}
template <int MX>
__device__ __forceinline__ void diag_cross(Ctx& C) {
    constexpr int CH = MXC<MX>::CH, NH = MXC<MX>::NH;
    const int T = C.T, NC = T / CH, nchains = C.nseq * 2 * NH;
    const float* DEC = (const float*)(C.ws + WS_DEC);
    for (int idx = C.gtid; idx < nchains * 8192; idx += C.ngt) {
        const int chain = idx >> 13, e = idx & 8191, hd = chain % NH; int r = chain / NH; const int dir = r & 1, b = r >> 1;
        float gch = 1.f;
        if (MX == MX_RET) { const float lg = -__expf(IN(I_RETLD)[(C.j * 2 + dir) * 4 + (hd >> 2)]); gch = __expf(lg * (float)CH); }
        float carry = 0.f;
#pragma unroll 4
        for (int c = 0; c < NC; ++c) {
            const int slotid = ((b * 2 + dir) * NC + c) * NH + hd;
            float* p = (float*)(C.ws + WS_ST) + (size_t)slotid * 8192 + e;
            const float sl = *p; *p = carry;
            const float d = (MX == MX_HGRN) ? DEC[(size_t)slotid * 128 + (e >> 6)] : (MX == MX_MAMBA) ? DEC[slotid] : gch;
            carry = d * carry + sl;
        }
    }
}

constexpr int RQ_OFF = 0, RK_OFF = 17408, RV_OFF = 36864, RM_OFF = 73728;
__device__ __forceinline__ void ret_stage_qk(Ctx& C, LAS h16* dst, bool transposed, int colbase, float scale, float lg2, int wbase, int b, int dir, int p0) {
    const int T = C.T, m = C.tid >> 3, i0 = (C.tid & 7) * 8;
    const int p = p0 + m, t = dir ? T - 1 - p : p; const size_t tok = (size_t)b * T + t;
    const h16* U = (const h16*)(C.ws + WS_U); const float* ROT = (const float*)(C.ws + WS_ROT);
    const h16x8 x1 = *(const h16x8*)(U + tok * LDD_ + colbase + i0), x2 = *(const h16x8*)(U + tok * LDD_ + colbase + 64 + i0);
    const f32x4 c0 = *(const f32x4*)(ROT + t * 128 + i0), c1 = *(const f32x4*)(ROT + t * 128 + i0 + 4), s0 = *(const f32x4*)(ROT + t * 128 + 64 + i0), s1 = *(const f32x4*)(ROT + t * 128 + 64 + i0 + 4);
    const float cs[8] = {c0.x, c0.y, c0.z, c0.w, c1.x, c1.y, c1.z, c1.w}, sn[8] = {s0.x, s0.y, s0.z, s0.w, s1.x, s1.y, s1.z, s1.w};
    const float sc = transposed ? scale * exp2f((float)(wbase - m) * lg2) : scale;
    h16x8 y1, y2;
#pragma unroll
    for (int e = 0; e < 8; ++e) { const float a = (float)x1[e], bb = (float)x2[e]; y1[e] = (h16)((a * cs[e] - bb * sn[e]) * sc); y2[e] = (h16)((bb * cs[e] + a * sn[e]) * sc); }
    if (!transposed) { *(LAS h16x8*)(dst + m * 136 + i0) = y1; *(LAS h16x8*)(dst + m * 136 + 64 + i0) = y2; }
    else {
#pragma unroll
        for (int e = 0; e < 8; ++e) { dst[(i0 + e) * 72 + m] = y1[e]; dst[(64 + i0 + e) * 72 + m] = y2[e]; } }
}
__device__ __forceinline__ void ret_stage_vt(Ctx& C, LAS h16* Vt, int h, int b, int dir, int p0) {
    const int T = C.T; const h16* U = (const h16*)(C.ws + WS_U);
#pragma unroll
    for (int q = 0; q < 4; ++q) { const int it = C.tid + 512 * q, m = it >> 5, cb = it & 31;
        const int p = p0 + m, t = dir ? T - 1 - p : p; const size_t tok = (size_t)b * T + t;
        const h16x8 x = *(const h16x8*)(U + tok * LDD_ + 1024 + h * 256 + cb * 8);
#pragma unroll
        for (int e = 0; e < 8; ++e) Vt[(cb * 8 + e) * 72 + m] = x[e]; }
}
__device__ __forceinline__ void ret_mfma_pass1(Ctx& C) {
    const int T = C.T, NCH = T / 256, nunits = C.nseq * 2 * NCH * 4, lane = C.lane, w = C.wave, fr = lane & 15, fq = lane >> 4;
    LAS h16* Kt = (LAS h16*)(C.lds + RK_OFF); LAS h16* Vt = (LAS h16*)(C.lds + RV_OFF);
    for (int unit = blockIdx.x; unit < nunits; unit += gridDim.x) {
        const int h = unit & 3; int r = unit >> 2; const int c = r % NCH; r /= NCH; const int dir = r & 1, b = r >> 1;
        const float lg2 = -__expf(IN(I_RETLD)[(C.j * 2 + dir) * 4 + h]) * 1.4426950408889634f;
        f32x4 acc[8][2];
#pragma unroll
        for (int mt = 0; mt < 8; ++mt) { acc[mt][0] = (f32x4){0.f, 0.f, 0.f, 0.f}; acc[mt][1] = (f32x4){0.f, 0.f, 0.f, 0.f}; }
#pragma unroll 1
        for (int jb = 0; jb < 4; ++jb) {
            __syncthreads();
            ret_stage_qk(C, Kt, true, 512 + h * 128, 0.08838834764831845f, lg2, 255 - 64 * jb, b, dir, c * 256 + 64 * jb);
            ret_stage_vt(C, Vt, h, b, dir, c * 256 + 64 * jb);
            __syncthreads();
#pragma unroll
            for (int ks = 0; ks < 2; ++ks) {
                const h16x8 b0 = *(const LAS h16x8*)(Vt + (32 * w + fr) * 72 + ks * 32 + fq * 8), b1 = *(const LAS h16x8*)(Vt + (32 * w + 16 + fr) * 72 + ks * 32 + fq * 8);
#pragma unroll
                for (int mt = 0; mt < 8; ++mt) { const h16x8 a = *(const LAS h16x8*)(Kt + (16 * mt + fr) * 72 + ks * 32 + fq * 8);
                    acc[mt][0] = __builtin_amdgcn_mfma_f32_16x16x32_f16(a, b0, acc[mt][0], 0, 0, 0); acc[mt][1] = __builtin_amdgcn_mfma_f32_16x16x32_f16(a, b1, acc[mt][1], 0, 0, 0); }
            }
        }
        float* Sg = (float*)(C.ws + WS_ST) + (size_t)unit * 32768;
#pragma unroll
        for (int mt = 0; mt < 8; ++mt)
#pragma unroll
            for (int nt = 0; nt < 2; ++nt) *(f32x4*)(Sg + (size_t)(32 * w + 16 * nt + fr) * 128 + 16 * mt + fq * 4) = acc[mt][nt];
    }
}
__device__ __forceinline__ void ret_mfma_cross(Ctx& C) {
    const int T = C.T, NCH = T / 256, nchains = C.nseq * 2 * 4;
    for (int idx = C.gtid; idx < nchains * 32768; idx += C.ngt) {
        const int chain = idx >> 15, e = idx & 32767, h = chain & 3, dir = (chain >> 2) & 1, b = chain >> 3;
        const float gch = __expf(-__expf(IN(I_RETLD)[(C.j * 2 + dir) * 4 + h]) * 256.f);
        float carry = 0.f;
#pragma unroll 4
        for (int c = 0; c < NCH; ++c) { float* p = (float*)(C.ws + WS_ST) + (size_t)((((b * 2 + dir) * NCH + c) * 4) + h) * 32768 + e; const float sl = *p; *p = carry; carry = gch * carry + sl; }
    }
}
__device__ __forceinline__ void ret_mfma_pass2(Ctx& C) {
    const int T = C.T, NCH = T / 256, nunits = C.nseq * 2 * NCH * 4, lane = C.lane, w = C.wave, fr = lane & 15, fq = lane >> 4;
    LAS h16* Qs = (LAS h16*)(C.lds + RQ_OFF); LAS h16* Ks = (LAS h16*)(C.lds + RK_OFF); LAS h16* Vt = (LAS h16*)(C.lds + RV_OFF); LAS h16* Ms = (LAS h16*)(C.lds + RM_OFF);
    for (int unit = blockIdx.x; unit < nunits; unit += gridDim.x) {
        const int h = unit & 3; int r = unit >> 2; const int c = r % NCH; r /= NCH; const int dir = r & 1, b = r >> 1;
        const float lg2 = -__expf(IN(I_RETLD)[(C.j * 2 + dir) * 4 + h]) * 1.4426950408889634f;
        const float* Sg = (const float*)(C.ws + WS_ST) + (size_t)unit * 32768;
        h16x8 sf[2][4];
#pragma unroll
        for (int nt = 0; nt < 2; ++nt)
#pragma unroll
            for (int ks = 0; ks < 4; ++ks) { const float* p = Sg + (size_t)(32 * w + 16 * nt + fr) * 128 + ks * 32 + fq * 8; const f32x4 a = *(const f32x4*)p, bb = *(const f32x4*)(p + 4);
                sf[nt][ks][0] = (h16)a.x; sf[nt][ks][1] = (h16)a.y; sf[nt][ks][2] = (h16)a.z; sf[nt][ks][3] = (h16)a.w; sf[nt][ks][4] = (h16)bb.x; sf[nt][ks][5] = (h16)bb.y; sf[nt][ks][6] = (h16)bb.z; sf[nt][ks][7] = (h16)bb.w; }
        h16* outp; int ldo; if (dir == 0) { outp = (h16*)(C.ws + WS_MIX) + 512; ldo = MIXW; } else { outp = (h16*)(C.ws + WS_O); ldo = 1024; }
#pragma unroll 1
        for (int ib = 0; ib < 4; ++ib) {
            f32x4 acc[4][2];
#pragma unroll
            for (int mt = 0; mt < 4; ++mt) { acc[mt][0] = (f32x4){0.f, 0.f, 0.f, 0.f}; acc[mt][1] = (f32x4){0.f, 0.f, 0.f, 0.f}; }
#pragma unroll 1
            for (int jb = 0; jb <= ib; ++jb) {
                __syncthreads();
                if (jb == 0) ret_stage_qk(C, Qs, false, h * 128, 1.f, lg2, 0, b, dir, c * 256 + 64 * ib);
                ret_stage_qk(C, Ks, false, 512 + h * 128, 0.08838834764831845f, lg2, 0, b, dir, c * 256 + 64 * jb);
                ret_stage_vt(C, Vt, h, b, dir, c * 256 + 64 * jb);
                __syncthreads();
                {
                    const int gm = w >> 1, gn = w & 1;
                    f32x4 g0 = (f32x4){0.f, 0.f, 0.f, 0.f}, g1 = (f32x4){0.f, 0.f, 0.f, 0.f};
#pragma unroll
                    for (int ks = 0; ks < 4; ++ks) { const h16x8 a = *(const LAS h16x8*)(Qs + (16 * gm + fr) * 136 + ks * 32 + fq * 8);
                        const h16x8 k0 = *(const LAS h16x8*)(Ks + (32 * gn + fr) * 136 + ks * 32 + fq * 8), k1 = *(const LAS h16x8*)(Ks + (32 * gn + 16 + fr) * 136 + ks * 32 + fq * 8);
                        g0 = __builtin_amdgcn_mfma_f32_16x16x32_f16(a, k0, g0, 0, 0, 0); g1 = __builtin_amdgcn_mfma_f32_16x16x32_f16(a, k1, g1, 0, 0, 0); }
#pragma unroll
                    for (int jj = 0; jj < 4; ++jj) { const int l = 16 * gm + fq * 4 + jj, Lg = 64 * ib + l;
                        const int m0 = 32 * gn + fr, M0 = 64 * jb + m0, M1 = M0 + 16;
                        Ms[l * 72 + m0] = (h16)((M0 <= Lg) ? g0[jj] * exp2f((float)(Lg - M0) * lg2) : 0.f);
                        Ms[l * 72 + m0 + 16] = (h16)((M1 <= Lg) ? g1[jj] * exp2f((float)(Lg - M1) * lg2) : 0.f); }
                }
                __syncthreads();
#pragma unroll
                for (int ks = 0; ks < 2; ++ks) {
                    const h16x8 b0 = *(const LAS h16x8*)(Vt + (32 * w + fr) * 72 + ks * 32 + fq * 8), b1 = *(const LAS h16x8*)(Vt + (32 * w + 16 + fr) * 72 + ks * 32 + fq * 8);
#pragma unroll
                    for (int mt = 0; mt < 4; ++mt) { const h16x8 a = *(const LAS h16x8*)(Ms + (16 * mt + fr) * 72 + ks * 32 + fq * 8);
                        acc[mt][0] = __builtin_amdgcn_mfma_f32_16x16x32_f16(a, b0, acc[mt][0], 0, 0, 0); acc[mt][1] = __builtin_amdgcn_mfma_f32_16x16x32_f16(a, b1, acc[mt][1], 0, 0, 0); }
                }
            }
            f32x4 ac2[4][2];
#pragma unroll
            for (int mt = 0; mt < 4; ++mt) { ac2[mt][0] = (f32x4){0.f, 0.f, 0.f, 0.f}; ac2[mt][1] = (f32x4){0.f, 0.f, 0.f, 0.f}; }
#pragma unroll
            for (int ks = 0; ks < 4; ++ks)
#pragma unroll
                for (int mt = 0; mt < 4; ++mt) { const h16x8 a = *(const LAS h16x8*)(Qs + (16 * mt + fr) * 136 + ks * 32 + fq * 8);
                    ac2[mt][0] = __builtin_amdgcn_mfma_f32_16x16x32_f16(a, sf[0][ks], ac2[mt][0], 0, 0, 0); ac2[mt][1] = __builtin_amdgcn_mfma_f32_16x16x32_f16(a, sf[1][ks], ac2[mt][1], 0, 0, 0); }
#pragma unroll
            for (int mt = 0; mt < 4; ++mt)
#pragma unroll
                for (int jj = 0; jj < 4; ++jj) { const int Lg = 64 * ib + 16 * mt + fq * 4 + jj; const float rs = exp2f((float)(Lg + 1) * lg2);
                    const int p = c * 256 + Lg, t = dir ? T - 1 - p : p; h16* op = outp + ((size_t)b * T + t) * ldo + h * 256 + 32 * w + fr;
                    op[0] = (h16)(acc[mt][0][jj] + ac2[mt][0][jj] * rs); op[16] = (h16)(acc[mt][1][jj] + ac2[mt][1][jj] * rs); }
        }
    }
}
__device__ __forceinline__ void mamba_final(Ctx& C) {
    const int lane = C.lane, j = C.j, c0 = lane * 16;
    const h16* U = (const h16*)(C.ws + WS_U); h16* MIX = (h16*)(C.ws + WS_MIX); const h16* O = (const h16*)(C.ws + WS_O); const h16* XS = (const h16*)(C.ws + WS_ST + 32 * MiB);
    const float dsk = IN(I_SSMD)[j * 16 + (lane >> 2)];
    for (int tok = C.gw; tok < MG; tok += C.ngw) {
        float y[16]; float ss = 0.f;
#pragma unroll
        for (int hf = 0; hf < 2; ++hf) {
            const int c = c0 + hf * 8;
            const h16x8 xs = *(const h16x8*)(XS + (size_t)tok * 1024 + c), yf = *(const h16x8*)(MIX + (size_t)tok * MIXW + 512 + c), yb = *(const h16x8*)(O + (size_t)tok * 1024 + c), z = *(const h16x8*)(U + (size_t)tok * LDB_ + c);
#pragma unroll
            for (int e = 0; e < 8; ++e) { const float v = ((float)yf[e] + (float)yb[e] + (float)xs[e] * dsk) * silu((float)z[e]); y[hf * 8 + e] = v; ss += v * v; }
        }
#pragma unroll
        for (int o = 1; o < 32; o <<= 1) ss += __shfl_xor(ss, o);
        const float rstd = rsqrtf(ss * (1.f / 512.f) + 1e-5f);
#pragma unroll
        for (int hf = 0; hf < 2; ++hf) { h16x8 w;
#pragma unroll
            for (int e = 0; e < 8; ++e) w[e] = (h16)(y[hf * 8 + e] * rstd * IN(I_SSMNW)[j * 1024 + c0 + hf * 8 + e]);
            *(h16x8*)(MIX + (size_t)tok * MIXW + 512 + c0 + hf * 8) = w; }
    }
}
__device__ __forceinline__ void hgrn_final(Ctx& C) {
    const int lane = C.lane, j = C.j, c0 = lane * 8;
    const h16* U = (const h16*)(C.ws + WS_U); h16* MIX = (h16*)(C.ws + WS_MIX); const h16* O = (const h16*)(C.ws + WS_O);
    for (int tok = C.gw; tok < MG; tok += C.ngw) {
        const h16x8 of = *(const h16x8*)(MIX + (size_t)tok * MIXW + c0), ob = *(const h16x8*)(O + (size_t)tok * 512 + c0), gg = *(const h16x8*)(U + (size_t)tok * LDC_ + 3584 + c0);
        float o[8], ss = 0.f;
#pragma unroll
        for (int e = 0; e < 8; ++e) { o[e] = (float)of[e] + (float)ob[e]; ss += o[e] * o[e]; }
        ss += __shfl_xor(ss, 1); ss += __shfl_xor(ss, 2); ss += __shfl_xor(ss, 4);
        const float rstd = rsqrtf(ss * (1.f / 64.f) + 1e-5f);
        h16x8 w;
#pragma unroll
        for (int e = 0; e < 8; ++e) w[e] = (h16)(o[e] * rstd * IN(I_HGNW)[j * 512 + c0 + e] * sigm((float)gg[e]));
        *(h16x8*)(MIX + (size_t)tok * MIXW + c0) = w;
    }
}
__device__ __forceinline__ void ret_final(Ctx& C) {
    const int lane = C.lane, j = C.j, c0 = lane * 16;
    const h16* U = (const h16*)(C.ws + WS_U); h16* MIX = (h16*)(C.ws + WS_MIX); const h16* O = (const h16*)(C.ws + WS_O);
    for (int tok = C.gw; tok < MG; tok += C.ngw) {
        float o[16], s = 0.f;
#pragma unroll
        for (int hf = 0; hf < 2; ++hf) { const h16x8 of = *(const h16x8*)(MIX + (size_t)tok * MIXW + 512 + c0 + hf * 8), ob = *(const h16x8*)(O + (size_t)tok * 1024 + c0 + hf * 8);
#pragma unroll
            for (int e = 0; e < 8; ++e) { o[hf * 8 + e] = (float)of[e] + (float)ob[e]; s += o[hf * 8 + e]; } }
#pragma unroll
        for (int q = 1; q < 16; q <<= 1) s += __shfl_xor(s, q);
        const float mean = s * (1.f / 256.f); float v2 = 0.f;
#pragma unroll
        for (int e = 0; e < 16; ++e) { o[e] -= mean; v2 += o[e] * o[e]; }
#pragma unroll
        for (int q = 1; q < 16; q <<= 1) v2 += __shfl_xor(v2, q);
        const float rstd = rsqrtf(v2 * (1.f / 256.f) + 1e-5f);
#pragma unroll
        for (int hf = 0; hf < 2; ++hf) { const h16x8 gg = *(const h16x8*)(U + (size_t)tok * LDD_ + 2048 + c0 + hf * 8); h16x8 w;
#pragma unroll
            for (int e = 0; e < 8; ++e) { const int cc = c0 + hf * 8 + e; w[e] = (h16)((o[hf * 8 + e] * rstd * IN(I_RETGW)[j * 1024 + cc] + IN(I_RETGB)[j * 1024 + cc]) * silu((float)gg[e])); }
            *(h16x8*)(MIX + (size_t)tok * MIXW + 512 + c0 + hf * 8) = w; }
    }
}

template <class Epi> __device__ __forceinline__ void run_gemm(Ctx& C, const h16* A, const h16* Bt, int N, int K, const Epi& E) {
    pg8::Gemm g{A, Bt, MG, N, K}; pg8::StaticOrder S; S.init(MG, N, (int)gridDim.x, (int)blockIdx.x);
    pg8::gemm_phase<Epi, pg8::StaticOrder>(C.lds, g, S, E, C.tid);
}

__global__ void __launch_bounds__(NTHR, 2) mega(Args args) {
    extern __shared__ __attribute__((aligned(16))) unsigned char lds_raw[];
    cg::grid_group grid = cg::this_grid();
    Ctx C;
#pragma unroll
    for (int i = 0; i < 32; ++i) C.in[i] = args.in[i];
    C.lds = (LAS unsigned char*)lds_raw; C.tid = threadIdx.x; C.lane = C.tid & 63; C.wave = __builtin_amdgcn_readfirstlane(C.tid >> 6);
    C.gw = blockIdx.x * NWAVES + C.wave; C.ngw = gridDim.x * NWAVES; C.gtid = blockIdx.x * NTHR + C.tid; C.ngt = gridDim.x * NTHR; C.ws = args.ws;
    h16* HN = (h16*)(C.ws + WS_HN); h16* MIX = (h16*)(C.ws + WS_MIX); h16* U = (h16*)(C.ws + WS_U);
    volatile LAS unsigned* bst = (volatile LAS unsigned*)(C.lds + LDS_BYTES - 16);
    if (threadIdx.x < 4) bst[threadIdx.x] = 0u;
    __syncthreads();
    const XcdBarrier xbar = xcd_barrier_post((unsigned*)(C.ws + WS_BAR), bst);
#define SYNC() xcd_barrier(xbar)
#ifndef PH
#define PH 0xFFFF
#endif
#ifndef DUP
#define DUP 0
#endif
#define P_(b, ...) do { for (int rep_ = 0; rep_ < 1 + ((DUP >> (b)) & 1); ++rep_) if (PH & (1 << (b))) { int t_ = threadIdx.x; asm volatile("" : "+v"(t_)); C.tid = t_; C.lane = t_ & 63; C.wave = __builtin_amdgcn_readfirstlane(t_ >> 6); C.gw = blockIdx.x * NWAVES + C.wave; C.gtid = blockIdx.x * NTHR + t_; __VA_ARGS__; } } while (0)
#pragma unroll 1
    for (int layer = 0; layer < 4; ++layer) {
        C.layer = layer; C.j = layer >> 1;
        P_(0, phase_weights(C)); if (layer == 0) grid.sync(); else SYNC();
#pragma unroll 1
        for (int grp = 0; grp < 2; ++grp) {
            C.grp = grp; C.nseq = grp == 0 ? 2 : 1; C.T = grp == 0 ? 8192 : 16384;
            C.hdst = args.out + (size_t)grp * MG * D; C.hsrc = (layer == 0) ? args.in[grp == 0 ? I_XP : I_XS] : C.hdst;
            P_(1, phase_norm(C, C.hsrc, IN(I_LNMIX) + layer * D, HN)); SYNC();
            if ((layer & 1) == 0) {
                P_(2, run_gemm(C, HN, (const h16*)(C.ws + W_IN1), LDA_, D, pg8::EpiF16<0>{U, LDA_})); SYNC();
                P_(3, rwkv_pre(C)); SYNC();
                P_(4, rwkv_scan<1>(C)); SYNC();
                P_(5, rwkv_cross(C)); SYNC();
                P_(6, rwkv_scan<2>(C)); SYNC();
                P_(7, rwkv_final(C)); SYNC();
                P_(2, run_gemm(C, HN, (const h16*)(C.ws + W_IN2), LDB_, D, pg8::EpiF16<0>{U, LDB_})); SYNC();
                P_(8, mamba_pre(C)); SYNC();
                P_(9, mamba_mfma_pass1(C)); SYNC();
                P_(5, mamba_mfma_cross(C)); SYNC();
                P_(9, mamba_mfma_pass2(C)); SYNC();
                P_(10, mamba_final(C)); SYNC();
            } else {
                P_(2, run_gemm(C, HN, (const h16*)(C.ws + W_IN1), LDC_, D, pg8::EpiF16<0>{U, LDC_})); SYNC();
                P_(11, diag_scan<MX_HGRN, 1>(C)); SYNC();
                P_(5, diag_cross<MX_HGRN>(C)); SYNC();
                P_(11, diag_scan<MX_HGRN, 2>(C)); SYNC();
                P_(12, hgrn_final(C)); SYNC();
                P_(2, run_gemm(C, HN, (const h16*)(C.ws + W_IN2), LDD_, D, pg8::EpiF16<0>{U, LDD_})); SYNC();
                P_(13, ret_mfma_pass1(C)); SYNC();
                P_(5, ret_mfma_cross(C)); SYNC();
                P_(13, ret_mfma_pass2(C)); SYNC();
                P_(14, ret_final(C)); SYNC();
            }
            P_(15, run_gemm(C, MIX, (const h16*)(C.ws + W_OUT), D, MIXW, pg8::EpiRes{C.hsrc, C.hdst, D})); SYNC();
            P_(1, phase_norm(C, C.hdst, IN(I_LNFFN) + layer * D, HN)); SYNC();
            P_(2, run_gemm(C, HN, (const h16*)(C.ws + W_F1), FF, D, pg8::EpiF16<1>{U, FF})); SYNC();
            P_(15, run_gemm(C, U, (const h16*)(C.ws + W_F2), D, FF, pg8::EpiRes{C.hdst, C.hdst, D})); SYNC();
        }
    }
    P_(1, phase_final_norm(C, args.out, IN(I_LNFINAL)));
}

extern "C" void kernel_launch(void* const* d_in, const int* in_sizes, int n_in, void* d_out, int out_size, void* d_ws, size_t ws_size, hipStream_t stream) {
    static int grid = 0;
    if (grid == 0) {
        if (n_in != 32 || ws_size < WS_END) { fprintf(stderr, "kernel_launch: unexpected n_in %d or ws_size %zu (< %zu)\n", n_in, ws_size, (size_t)WS_END); grid = -1; return; }
        int dev = 0, cus = 0, per_cu = 0;
        hipGetDevice(&dev); hipDeviceGetAttribute(&cus, hipDeviceAttributeMultiprocessorCount, dev);
        if (hipFuncSetAttribute((const void*)mega, hipFuncAttributeMaxDynamicSharedMemorySize, LDS_BYTES) != hipSuccess) { fprintf(stderr, "kernel_launch: hipFuncSetAttribute failed\n"); grid = -1; return; }
        if (hipOccupancyMaxActiveBlocksPerMultiprocessor(&per_cu, (const void*)mega, NTHR, LDS_BYTES) != hipSuccess || per_cu < 1) { fprintf(stderr, "kernel_launch: occupancy query says %d\n", per_cu); per_cu = 1; }
        (void)hipGetLastError();
        grid = cus * per_cu;
    }
    if (grid < 0) return;
    if (hipMemsetAsync((char*)d_ws + WS_BAR, 0, XCD_BAR_WORDS * 4, stream) != hipSuccess) { fprintf(stderr, "kernel_launch: memset failed\n"); return; }
    Args a{};
    for (int i = 0; i < 32; ++i) a.in[i] = (const float*)d_in[i];
    a.out = (float*)d_out; a.ws = (unsigned char*)d_ws;
    void* params[] = {&a};
    hipError_t e = hipLaunchCooperativeKernel((const void*)mega, dim3(grid), dim3(NTHR), params, LDS_BYTES, stream);
    if (e != hipSuccess) fprintf(stderr, "kernel_launch: cooperative launch failed: %s (grid %d)\n", hipGetErrorString(e), grid);
}
```

```cpp
#include <hip/hip_runtime.h>
#include <hip/hip_cooperative_groups.h>
#include <cstdio>
#include <cstdint>
namespace cg = cooperative_groups;

#define LAS __attribute__((address_space(3)))
typedef _Float16 h16;
typedef _Float16 h16x8 __attribute__((ext_vector_type(8)));
typedef _Float16 h16x4 __attribute__((ext_vector_type(4)));
typedef float f32x4 __attribute__((ext_vector_type(4)));

constexpr int D = 1024, FF = 4096, MIXW = 1536, MG = 16384;
constexpr int A_IN = 1920, B_IN = 2592, AB_IN = 4512, C_IN = 4096, D_IN = 3072, CD_IN = 7168;
constexpr int LDA_ = 2048, LDB_ = 2816, LDC_ = 4096, LDD_ = 3072;
constexpr int CH_R = 128, CH_M = 256, CH_H = 128, CH_T = 256;
constexpr int SUB = 8;
constexpr int NWAVES = 8, NTHR = 512;
constexpr int LDS_BYTES = 147456;
constexpr size_t MiB = 1u << 20;
constexpr size_t WS_ROT = 0, WS_DEC = 8 * MiB, WS_W = 10 * MiB, WS_HN = 43 * MiB, WS_MIX = 75 * MiB, WS_U = 123 * MiB, WS_ST = 251 * MiB, WS_O = 315 * MiB, WS_BAR = 347 * MiB, WS_END = 348 * MiB;
constexpr size_t W_IN1 = WS_W, W_IN2 = WS_W + 8 * MiB, W_OUT = WS_W + 14 * MiB, W_F1 = WS_W + 17 * MiB, W_F2 = WS_W + 25 * MiB;

struct Args { const float* in[32]; float* out; unsigned char* ws; };
enum { I_XP = 0, I_XS, I_LNMIX, I_LNFFN, I_LNFINAL, I_WOUT, I_W1, I_W2, I_ABW, I_MU, I_W0, I_RW2, I_A0, I_A2, I_G2, I_KK, I_KA, I_RK, I_GNW, I_GNB,
       I_CONVW, I_CONVB, I_DTB, I_ALOG, I_SSMD, I_SSMNW, I_CDW, I_HGLB, I_HGNW, I_RETLD, I_RETGW, I_RETGB };

__device__ __forceinline__ float sigm(float x) { return 1.f / (1.f + __expf(-x)); }
__device__ __forceinline__ float silu(float x) { return x / (1.f + __expf(-x)); }
__device__ __forceinline__ float wave_sum(float v) {
#pragma unroll
    for (int o = 1; o < 64; o <<= 1) v += __shfl_xor(v, o);
    return v;
}
#define WAVE_SYNC() do { asm volatile("s_waitcnt lgkmcnt(0)" ::: "memory"); __builtin_amdgcn_wave_barrier(); } while (0)

namespace pg8 {
constexpr int BM = 256, BK = 64, HALF = 128, HTB = HALF * BK * 2, STAGE_BYTES = 8 * HTB, NXCD = 8, WGM = 8;
__host__ __device__ __forceinline__ int lds_byte(int r, int c) { const int st = (r >> 4) * 2 + (c >> 5), rr = r & 15, cc = c & 31, ob = rr * 64 + cc * 2; return st * 1024 + (ob ^ (((ob >> 9) & 1) << 5)); }
__host__ __device__ __forceinline__ void stage_rc(int b, int& R, int& C) { const int st = b / 1024, sb = b % 1024, swz = sb ^ (((sb >> 9) & 1) << 5); R = (st >> 1) * 16 + swz / 64; C = (st & 1) * 32 + (swz % 64) / 2; }
__host__ __device__ __forceinline__ int perm32(int rho) { const int n = rho >> 4, i = rho & 15; return 8 * (i >> 2) + 4 * n + (i & 3); }
struct Unit { int pm, pn; };
struct Gemm { const h16* A; const h16* Bt; int M, N, K; };
struct StaticOrder {
    int nM, nN, nwg, G, c;
    __device__ void init(int M, int N, int G_, int c_) { nM = M / BM; nN = N / BM; nwg = nM * nN; G = G_; c = c_; }
    __device__ bool next(int i, Unit& u) const {
        const long L = (long)i * G + c; if (L >= nwg) return false;
        int wgid = (int)L; { const int q = nwg / NXCD, r = nwg % NXCD, xcd = wgid % NXCD, off = wgid / NXCD; wgid = (xcd < r ? xcd * (q + 1) : r * (q + 1) + (xcd - r) * q) + off; }
        const int nig = WGM * nN, gid = wgid / nig, fm = gid * WGM, gsz = (nM - fm) < WGM ? (nM - fm) : WGM;
        u.pm = fm + ((wgid % nig) % gsz); u.pn = (wgid % nig) / gsz; return true;
    }
};
template <int ACT> struct EpiF16 {
    h16* O; int ldc;
    __device__ __forceinline__ void operator()(const f32x4 (&acc)[2][2][4][2], const Unit& u, int wr, int wc, int fr, int fq) const {
        const int row0 = u.pm * BM + wr * 64 + fr; const int col0 = u.pn * BM + wc * 32 + 8 * fq;
#pragma unroll
        for (int ai = 0; ai < 2; ++ai)
#pragma unroll
            for (int m = 0; m < 4; ++m) { h16* rowp = O + (size_t)(row0 + ai * HALF + m * 16) * ldc + col0;
#pragma unroll
                for (int bj = 0; bj < 2; ++bj) { f32x4 v0 = acc[ai][bj][m][0], v1 = acc[ai][bj][m][1];
                    if (ACT == 1) {
#pragma unroll
                        for (int e = 0; e < 4; ++e) { float a = fmaxf(v0[e], 0.f), b = fmaxf(v1[e], 0.f); v0[e] = a * a; v1[e] = b * b; } }
                    h16x8 w; w[0] = (h16)v0[0]; w[1] = (h16)v0[1]; w[2] = (h16)v0[2]; w[3] = (h16)v0[3]; w[4] = (h16)v1[0]; w[5] = (h16)v1[1]; w[6] = (h16)v1[2]; w[7] = (h16)v1[3];
                    *(h16x8*)(rowp + bj * HALF) = w; } }
    }
};
struct EpiRes {
    const float* src; float* dst; int ldc;
    __device__ __forceinline__ void operator()(const f32x4 (&acc)[2][2][4][2], const Unit& u, int wr, int wc, int fr, int fq) const {
        const int row0 = u.pm * BM + wr * 64 + fr; const int col0 = u.pn * BM + wc * 32 + 8 * fq;
#pragma unroll
        for (int ai = 0; ai < 2; ++ai)
#pragma unroll
            for (int m = 0; m < 4; ++m) { const size_t off = (size_t)(row0 + ai * HALF + m * 16) * ldc + col0;
#pragma unroll
                for (int bj = 0; bj < 2; ++bj) {
                    const f32x4 s0 = *(const f32x4*)(src + off + bj * HALF), s1 = *(const f32x4*)(src + off + bj * HALF + 4);
                    *(f32x4*)(dst + off + bj * HALF) = s0 + acc[ai][bj][m][0]; *(f32x4*)(dst + off + bj * HALF + 4) = s1 + acc[ai][bj][m][1]; } }
    }
};

template <class Epi, class Sched>
__device__ __forceinline__ void gemm_phase(LAS unsigned char* lds, const Gemm g, const Sched& S, const Epi& E, const int tid) {
    const int wid = __builtin_amdgcn_readfirstlane(tid >> 6), lane = tid & 63, wr = wid >> 2, wc = wid & 3, fr = lane & 15, fq = lane >> 4;
    const int K = g.K, nt = K / BK;
    unsigned voffA[2], voffB[2];
#pragma unroll
    for (int i = 0; i < 2; ++i) { int R, C; stage_rc(tid * 16 + i * 8192, R, C); const int Rb = (R & ~31) + perm32(R & 31);
        voffA[i] = (unsigned)(R * K + C) * 2u; voffB[i] = (unsigned)(Rb * K + C) * 2u; }
    const size_t kstep = (size_t)(BK * 2);
    const size_t hstep = (size_t)HALF * K * 2;
    const size_t tstep = 2 * hstep;
    const unsigned ldsw = (unsigned)wid * 1024u;
    const int aoff = lds_byte(wr * 64 + fr, fq * 8), boff = lds_byte(wc * 32 + fr, fq * 8);
#define PG8_SA(b, h) (((b) * 2 + (h)) * HTB)
#define PG8_SB(b, h) ((4 + (b) * 2 + (h)) * HTB)
#define PG8_STAGE(bufoff, gbase, voff) do { _Pragma("unroll") for (int _i = 0; _i < 2; ++_i) \
        __builtin_amdgcn_global_load_lds((const unsigned*)((const char*)(gbase) + (voff)[_i]), (LAS unsigned*)(lds + (bufoff) + ldsw + _i * 8192), 16, 0, 0); } while (0)
#define PG8_LDA(dst, b, h) do { _Pragma("unroll") for (int m = 0; m < 4; ++m) _Pragma("unroll") for (int k = 0; k < 2; ++k) dst[m][k] = *(const LAS h16x8*)(lds + PG8_SA(b, h) + aoff + m * 2048 + k * 1024); } while (0)
#define PG8_LDB(dst, b, h) do { _Pragma("unroll") for (int n = 0; n < 2; ++n) _Pragma("unroll") for (int k = 0; k < 2; ++k) dst[n][k] = *(const LAS h16x8*)(lds + PG8_SB(b, h) + boff + n * 2048 + k * 1024); } while (0)
#define PG8_MMA(ai, bj, At, Bt) do { __builtin_amdgcn_s_setprio(1); _Pragma("unroll") for (int m = 0; m < 4; ++m) _Pragma("unroll") for (int n = 0; n < 2; ++n) _Pragma("unroll") for (int k = 0; k < 2; ++k) \
        acc[ai][bj][m][n] = __builtin_amdgcn_mfma_f32_16x16x32_f16(Bt[n][k], At[m][k], acc[ai][bj][m][n], 0, 0, 0); __builtin_amdgcn_s_setprio(0); } while (0)
#define PG8_WAIT_V(n) asm volatile("s_waitcnt vmcnt(" #n ")" ::: "memory")
#define PG8_WAIT_L(n) asm volatile("s_waitcnt lgkmcnt(" #n ")" ::: "memory")
#define PG8_BAR __builtin_amdgcn_s_barrier()
#define PG8_SCHED __builtin_amdgcn_sched_barrier(0)
    Unit cur, nxt; int ui = 0;
    if (!S.next(0, cur)) return;
    f32x4 acc[2][2][4][2];
#pragma unroll
    for (int a = 0; a < 2; ++a)
#pragma unroll
        for (int b = 0; b < 2; ++b)
#pragma unroll
            for (int m = 0; m < 4; ++m)
#pragma unroll
                for (int n = 0; n < 2; ++n) acc[a][b][m][n] = (f32x4){0.f, 0.f, 0.f, 0.f};
    h16x8 At[4][2], B0[2][2], B1[2][2];
    const char* cA = (const char*)g.A + (size_t)cur.pm * tstep; const char* cB = (const char*)g.Bt + (size_t)cur.pn * tstep;
    PG8_STAGE(PG8_SB(0, 0), cB, voffB); PG8_STAGE(PG8_SB(0, 1), cB + hstep, voffB); PG8_STAGE(PG8_SA(0, 0), cA, voffA); PG8_STAGE(PG8_SA(0, 1), cA + hstep, voffA);
    if (wr == 1) PG8_BAR;
    PG8_WAIT_V(2); PG8_BAR;
    PG8_STAGE(PG8_SB(1, 0), cB + kstep, voffB); PG8_STAGE(PG8_SA(1, 0), cA + kstep, voffA); PG8_STAGE(PG8_SB(1, 1), cB + hstep + kstep, voffB);
    PG8_WAIT_V(6); PG8_BAR;
    for (;;) {
        const bool has_next = S.next(ui + 1, nxt);
        const char* nA = has_next ? (const char*)g.A + (size_t)nxt.pm * tstep : cA; const char* nB = has_next ? (const char*)g.Bt + (size_t)nxt.pn * tstep : cB;
        for (int t = 0; t < nt; t += 2) {
            const bool last = (t == nt - 2);
            const char* a1 = cA + (size_t)(t + 1) * kstep;
            const char* a2 = last ? nA : cA + (size_t)(t + 2) * kstep; const char* b2 = last ? nB : cB + (size_t)(t + 2) * kstep;
            const char* a3 = a2 + kstep; const char* b3 = b2 + kstep;
            PG8_LDB(B0, 0, 0); PG8_LDB(B1, 0, 1); PG8_SCHED; PG8_LDA(At, 0, 0); PG8_STAGE(PG8_SA(1, 1), a1 + hstep, voffA);
            PG8_WAIT_V(8); PG8_WAIT_L(0); PG8_BAR; PG8_MMA(0, 0, At, B0); PG8_MMA(0, 1, At, B1); PG8_BAR; PG8_SCHED;
            PG8_LDA(At, 0, 1); PG8_STAGE(PG8_SB(0, 0), b2, voffB); PG8_STAGE(PG8_SB(0, 1), b2 + hstep, voffB); PG8_STAGE(PG8_SA(0, 0), a2, voffA);
            PG8_WAIT_V(8); PG8_WAIT_L(0); PG8_BAR; PG8_MMA(1, 0, At, B0); PG8_MMA(1, 1, At, B1); PG8_BAR; PG8_SCHED;
            PG8_LDB(B0, 1, 0); PG8_LDB(B1, 1, 1); PG8_SCHED; PG8_LDA(At, 1, 0); PG8_STAGE(PG8_SA(0, 1), a2 + hstep, voffA);
            PG8_WAIT_V(8); PG8_WAIT_L(0); PG8_BAR; PG8_MMA(0, 0, At, B0); PG8_MMA(0, 1, At, B1); PG8_BAR; PG8_SCHED;
            PG8_LDA(At, 1, 1); PG8_STAGE(PG8_SB(1, 0), b3, voffB); PG8_STAGE(PG8_SB(1, 1), b3 + hstep, voffB); PG8_STAGE(PG8_SA(1, 0), a3, voffA);
            PG8_WAIT_V(8); PG8_WAIT_L(0); PG8_BAR; PG8_MMA(1, 0, At, B0); PG8_MMA(1, 1, At, B1); PG8_BAR; PG8_SCHED;
        }
        if (wr == 0) PG8_BAR;
        E(acc, cur, wr, wc, fr, fq);
        if (!has_next) break;
#pragma unroll
        for (int a = 0; a < 2; ++a)
#pragma unroll
            for (int b = 0; b < 2; ++b)
#pragma unroll
                for (int m = 0; m < 4; ++m)
#pragma unroll
                    for (int n = 0; n < 2; ++n) acc[a][b][m][n] = (f32x4){0.f, 0.f, 0.f, 0.f};
        cur = nxt; cA = nA; cB = nB; ++ui;
        if (wr == 1) PG8_BAR;
    }
    PG8_WAIT_V(0);
    PG8_BAR;
#undef PG8_SA
#undef PG8_SB
#undef PG8_STAGE
#undef PG8_LDA
#undef PG8_LDB
#undef PG8_MMA
#undef PG8_WAIT_V
#undef PG8_WAIT_L
#undef PG8_BAR
#undef PG8_SCHED
}
}


#define XB_TMO      128
#define XB_XCNT(j)  (256  + 64 * (j))
#define XB_XSUB(j)  (1280 + 64 * (j))
#define XB_XGEN(j)  (2304 + 64 * (j))
#define XB_TOP      3328
#define XB_TOPGEN   3392
#define XCD_BAR_WORDS 3456
#define XB_SPIN_CAP (1u << 22)
__device__ __forceinline__ unsigned xb_ld(unsigned* p)              { return __hip_atomic_load(p, __ATOMIC_RELAXED, __HIP_MEMORY_SCOPE_AGENT); }
__device__ __forceinline__ unsigned xb_add(unsigned* p, unsigned v) { return __hip_atomic_fetch_add(p, v, __ATOMIC_RELAXED, __HIP_MEMORY_SCOPE_AGENT); }
__device__ __forceinline__ unsigned xb_xcc_id() { return (unsigned)__builtin_amdgcn_s_getreg((3 << 11) | 20) & 0xFu; }
#define XB_SPIN(cond, bar) do { unsigned _sp = 0; while (cond) { __builtin_amdgcn_s_sleep(1); \
    if ((++_sp & 255u) == 0u) { if (xb_ld(&(bar)[XB_TMO])) break; if (_sp > XB_SPIN_CAP) { atomicAdd(&(bar)[XB_TMO], 1u); break; } } } } while (0)
struct XcdBarrier { unsigned* bar; unsigned x; volatile LAS unsigned* st; };
__device__ __forceinline__ XcdBarrier xcd_barrier_post(unsigned* bar, volatile LAS unsigned* st) {
    XcdBarrier b; b.bar = bar; b.x = xb_xcc_id(); b.st = st;
    if (threadIdx.x == 0) (void)xb_add(&bar[XB_XCNT(b.x)], 1u);
    return b;
}
__device__ __forceinline__ void xcd_barrier_complete(unsigned* bar, unsigned x, unsigned& nloc, unsigned& nx) {
    const unsigned G = gridDim.x * gridDim.y * gridDim.z;
    unsigned sum, cnt, mine, sp = 0u;
    for (;;) {
        sum = 0u; cnt = 0u; mine = 0u;
#pragma unroll
        for (unsigned j = 0; j < 16; ++j) { const unsigned c = xb_ld(&bar[XB_XCNT(j)]); sum += c; cnt += (c > 0u) ? 1u : 0u; mine = (j == x) ? c : mine; }
        if (sum == G) break;
        __builtin_amdgcn_s_sleep(1);
        if ((++sp & 255u) == 0u) { if (xb_ld(&bar[XB_TMO])) break; if (sp > XB_SPIN_CAP) { atomicAdd(&bar[XB_TMO], 1u); break; } }
    }
    nloc = mine > 0u ? mine : 1u; nx = cnt > 0u ? cnt : 1u;
}
__device__ __forceinline__ void xcd_barrier(const XcdBarrier& b) {
    asm volatile("s_waitcnt vmcnt(0)" ::: "memory");
    __syncthreads();
    if (threadIdx.x == 0) {
        unsigned* bar = b.bar;
        __builtin_amdgcn_s_waitcnt(0);
        unsigned nloc = b.st[0], nx = b.st[1];
        if (nloc == 0u) { xcd_barrier_complete(bar, b.x, nloc, nx); b.st[0] = nloc; b.st[1] = nx; }
        const unsigned old = xb_add(&bar[XB_XSUB(b.x)], 1u);
        const unsigned gen = old / nloc;
        if (old + 1u == (gen + 1u) * nloc) {
            __builtin_amdgcn_fence(__ATOMIC_RELEASE, "agent");
            asm volatile("s_waitcnt vmcnt(0)" ::: "memory");
            const unsigned og = xb_add(&bar[XB_TOP], 1u);
            const unsigned tg = og / nx;
            if (og + 1u == (tg + 1u) * nx) xb_add(&bar[XB_TOPGEN], 1u);
            else XB_SPIN(xb_ld(&bar[XB_TOPGEN]) == tg, bar);
            __builtin_amdgcn_fence(__ATOMIC_ACQUIRE, "agent");
            xb_add(&bar[XB_XGEN(b.x)], 1u);
            asm volatile("s_waitcnt vmcnt(0)" ::: "memory");
        } else {
            XB_SPIN(xb_ld(&bar[XB_XGEN(b.x)]) == gen, bar);
            __builtin_amdgcn_fence(__ATOMIC_ACQUIRE, "agent");
            asm volatile("s_waitcnt vmcnt(0)" ::: "memory");
        }
    }
    __syncthreads();
}

struct Ctx {
    const float* in[32]; LAS unsigned char* lds; int tid, lane, wave, gw, ngw, gtid, ngt;
    int layer, j, grp, nseq, T;
    const float* hsrc; float* hdst;
    unsigned char* ws;
};
#define IN(k) (C.in[k])

__device__ __forceinline__ void transpose_item(const float* W, int ldw, int c0, int nvalid, int K, int Npad, h16* WT, LAS float* scr, int item, int lane) {
    const int nblk = Npad / 32, kb = item / nblk, nb = item % nblk, k0 = 64 * kb, n0 = 32 * nb;
    const int n = n0 + (lane & 31);
#pragma unroll 8
    for (int i = 0; i < 32; ++i) { const int kk = 2 * i + (lane >> 5); scr[kk * 33 + (lane & 31)] = (n < nvalid) ? W[(size_t)(k0 + kk) * ldw + c0 + n] : 0.f; }
    WAVE_SYNC();
    const int c = lane & 7;
#pragma unroll
    for (int jj = 0; jj < 4; ++jj) { const int nn = (lane >> 3) + 8 * jj; const LAS float* s = scr + (8 * c) * 33 + nn;
        h16x8 o;
#pragma unroll
        for (int e = 0; e < 8; ++e) o[e] = (h16)s[e * 33];
        *(h16x8*)(WT + (size_t)(n0 + nn) * K + k0 + 8 * c) = o; }
    WAVE_SYNC();
}
__device__ __forceinline__ void phase_weights(Ctx& C) {
    LAS float* scr = (LAS float*)(C.lds + C.wave * 12288);
    const int layer = C.layer, j = C.j;
    const bool ab = (layer & 1) == 0;
    const float* Win = ab ? IN(I_ABW) + (size_t)j * D * AB_IN : IN(I_CDW) + (size_t)j * D * CD_IN;
    const int ldw = ab ? AB_IN : CD_IN;
    const int n1 = ab ? A_IN : C_IN, n1p = ab ? LDA_ : LDC_, n2 = ab ? B_IN : D_IN, n2p = ab ? LDB_ : LDD_;
    const int it1 = (D / 64) * (n1p / 32), it2 = (D / 64) * (n2p / 32), it3 = (MIXW / 64) * (D / 32), it4 = (D / 64) * (FF / 32), it5 = (FF / 64) * (D / 32);
    const int total = it1 + it2 + it3 + it4 + it5;
    for (int it = C.gw; it < total; it += C.ngw) {
        int r = it;
        if (r < it1) { transpose_item(Win, ldw, 0, n1, D, n1p, (h16*)(C.ws + W_IN1), scr, r, C.lane); continue; } r -= it1;
        if (r < it2) { transpose_item(Win, ldw, n1, n2, D, n2p, (h16*)(C.ws + W_IN2), scr, r, C.lane); continue; } r -= it2;
        if (r < it3) { transpose_item(IN(I_WOUT) + (size_t)layer * MIXW * D, D, 0, D, MIXW, D, (h16*)(C.ws + W_OUT), scr, r, C.lane); continue; } r -= it3;
        if (r < it4) { transpose_item(IN(I_W1) + (size_t)layer * D * FF, FF, 0, FF, D, FF, (h16*)(C.ws + W_F1), scr, r, C.lane); continue; } r -= it4;
        transpose_item(IN(I_W2) + (size_t)layer * FF * D, D, 0, D, FF, D, (h16*)(C.ws + W_F2), scr, r, C.lane);
    }
    if (layer == 0) {
        float* rot = (float*)(C.ws + WS_ROT);
        for (int idx = C.gtid; idx < 16384 * 64; idx += C.ngt) { const int t = idx >> 6, i = idx & 63;
            const float invf = exp2f(-(float)i * (13.287712379549449f / 64.f)); const float ang = (float)t * invf;
            rot[t * 128 + i] = cosf(ang); rot[t * 128 + 64 + i] = sinf(ang); }
    }
}
__device__ __forceinline__ void phase_norm(Ctx& C, const float* src, const float* gain, h16* dst) {
    const f32x4 g0 = ((const f32x4*)gain)[C.lane], g1 = ((const f32x4*)gain)[64 + C.lane], g2 = ((const f32x4*)gain)[128 + C.lane], g3 = ((const f32x4*)gain)[192 + C.lane];
    for (int m = C.gw; m < MG; m += C.ngw) {
        const f32x4* xr = (const f32x4*)(src + (size_t)m * D) + C.lane;
        f32x4 v[4]; float s = 0.f;
#pragma unroll
        for (int q = 0; q < 4; ++q) { v[q] = xr[64 * q]; s += (v[q].x * v[q].x + v[q].y * v[q].y) + (v[q].z * v[q].z + v[q].w * v[q].w); }
        const float rstd = rsqrtf(wave_sum(s) * (1.f / D) + 1e-5f);
        v[0] = v[0] * g0 * rstd; v[1] = v[1] * g1 * rstd; v[2] = v[2] * g2 * rstd; v[3] = v[3] * g3 * rstd;
        h16x4* o = (h16x4*)(dst + (size_t)m * D) + C.lane;
#pragma unroll
        for (int q = 0; q < 4; ++q) { h16x4 w; w[0] = (h16)v[q].x; w[1] = (h16)v[q].y; w[2] = (h16)v[q].z; w[3] = (h16)v[q].w; o[64 * q] = w; }
    }
}
__device__ __forceinline__ void phase_final_norm(Ctx& C, float* io, const float* gain) {
    const f32x4 g0 = ((const f32x4*)gain)[C.lane], g1 = ((const f32x4*)gain)[64 + C.lane], g2 = ((const f32x4*)gain)[128 + C.lane], g3 = ((const f32x4*)gain)[192 + C.lane];
    for (int m = C.gw; m < 2 * MG; m += C.ngw) {
        f32x4* xr = (f32x4*)(io + (size_t)m * D) + C.lane;
        f32x4 v[4]; float s = 0.f;
#pragma unroll
        for (int q = 0; q < 4; ++q) { v[q] = xr[64 * q]; s += (v[q].x * v[q].x + v[q].y * v[q].y) + (v[q].z * v[q].z + v[q].w * v[q].w); }
        const float rstd = rsqrtf(wave_sum(s) * (1.f / D) + 1e-5f);
        xr[0] = v[0] * g0 * rstd; xr[64] = v[1] * g1 * rstd; xr[128] = v[2] * g2 * rstd; xr[192] = v[3] * g3 * rstd;
    }
}

template <int KS, int MODE, int NT>
__device__ __forceinline__ void rwkv_lora(Ctx& C, int col0, const float* Wl, const float* bias, h16* outp, int ldo, int noff) {
    const int lane = C.lane, fr = lane & 15, fq = lane >> 4, w = C.wave, T = C.T;
    const h16* U = (const h16*)(C.ws + WS_U);
    const float* mu0p = IN(I_MU) + (size_t)C.j * 2 * A_IN, *mu1p = mu0p + A_IN;
    h16x8 bf[NT][KS];
#pragma unroll
    for (int nt = 0; nt < NT; ++nt)
#pragma unroll
        for (int ks = 0; ks < KS; ++ks)
#pragma unroll
            for (int e = 0; e < 8; ++e) bf[nt][ks][e] = (h16)Wl[(size_t)(ks * 32 + fq * 8 + e) * 512 + w * 64 + noff + nt * 16 + fr];
    float bv[NT];
#pragma unroll
    for (int nt = 0; nt < NT; ++nt) bv[nt] = bias ? bias[w * 64 + noff + nt * 16 + fr] : 0.f;
    for (int tile = blockIdx.x; tile < MG / 16; tile += gridDim.x) {
        f32x4 acc[NT];
#pragma unroll
        for (int nt = 0; nt < NT; ++nt) acc[nt] = (f32x4){0.f, 0.f, 0.f, 0.f};
        const int tok = tile * 16 + fr, t = tok % T;
#pragma unroll
        for (int ks = 0; ks < KS; ++ks) {
            const int c = col0 + ks * 32 + fq * 8;
            const h16* up = U + (size_t)tok * LDA_ + c;
            const h16x8 cur = *(const h16x8*)up;
            h16x8 prv, nxt;
#pragma unroll
            for (int e = 0; e < 8; ++e) { prv[e] = (h16)0.f; nxt[e] = (h16)0.f; }
            if (t > 0) prv = *(const h16x8*)(up - LDA_);
            if (t < T - 1) nxt = *(const h16x8*)(up + LDA_);
            h16x8 af;
#pragma unroll
            for (int e = 0; e < 8; ++e) { const float x = (float)cur[e]; float y = x + mu0p[c + e] * ((float)prv[e] - x) + mu1p[c + e] * ((float)nxt[e] - x);
                if (MODE == 0) y = tanhf(y); else if (MODE == 2) y = sigm(y);
                af[e] = (h16)y; }
#pragma unroll
            for (int nt = 0; nt < NT; ++nt) acc[nt] = __builtin_amdgcn_mfma_f32_16x16x32_f16(af, bf[nt][ks], acc[nt], 0, 0, 0);
        }
#pragma unroll
        for (int nt = 0; nt < NT; ++nt)
#pragma unroll
            for (int e = 0; e < 4; ++e) { const int otok = tile * 16 + fq * 4 + e, n = w * 64 + noff + nt * 16 + fr; float y = acc[nt][e] + bv[nt];
                if (MODE == 0) y = sigm(y) * 0.6065306597126334f; else if (MODE == 1) y = sigm(y);
                outp[(size_t)otok * ldo + n] = (h16)y; }
    }
}
__device__ __forceinline__ void rwkv_pre(Ctx& C) {
    h16* U2 = (h16*)(C.ws + WS_U + 64 * MiB); h16* G = (h16*)(C.ws + WS_MIX) + 512;
    const int j = C.j;
    for (int d = 0; d < 2; ++d) {
        rwkv_lora<2, 0, 4>(C, 1536 + 64 * d, IN(I_RW2) + (size_t)(j * 2 + d) * 64 * 512, IN(I_W0) + (size_t)(j * 2 + d) * 512, U2 + d * 1024, 2048, 0);
        rwkv_lora<2, 1, 4>(C, 1664 + 64 * d, IN(I_A2) + (size_t)(j * 2 + d) * 64 * 512, IN(I_A0) + (size_t)(j * 2 + d) * 512, U2 + d * 1024 + 512, 2048, 0);
    }
    for (int hf = 0; hf < 2; ++hf) rwkv_lora<4, 2, 2>(C, 1792, IN(I_G2) + (size_t)j * 128 * 512, nullptr, G, MIXW, hf * 32);
}
template <int PASS>
__device__ __forceinline__ void rwkv_scan(Ctx& C) {
    const int lane = C.lane, T = C.T, NC = T / CH_R, j = C.j;
    const int nunits = C.nseq * 2 * NC * 8;
    const h16* U = (const h16*)(C.ws + WS_U); const h16* U2 = (const h16*)(C.ws + WS_U + 64 * MiB);
    LAS float* wl = (LAS float*)(C.lds + C.wave * 12288);
    const float* mu0p = IN(I_MU) + (size_t)j * 2 * A_IN, *mu1p = mu0p + A_IN;
    for (int unit = C.gw; unit < nunits; unit += C.ngw) {
        const int hd = unit & 7; int r = unit >> 3; const int c = r % NC; r /= NC; const int dir = r & 1, b = r >> 1;
        const int col = hd * 64 + lane;
        const float m0r = mu0p[col], m1r = mu1p[col], m0k = mu0p[512 + col], m1k = mu1p[512 + col], m0v = mu0p[1024 + col], m1v = mu1p[1024 + col];
        const float kkw = IN(I_KK)[j * 512 + col], kaw = IN(I_KA)[j * 512 + col];
        float* slot = (float*)(C.ws + WS_ST) + (size_t)((((b * 2 + dir) * NC + c) * 8) + hd) * 8192;
        float S[64], P[64];
        if (PASS == 1) {
            int ln = lane; asm volatile("" : "+v"(ln));
#pragma unroll
            for (int q = 0; q < 64; ++q) { S[q] = 0.f; P[q] = (q == ln) ? 1.f : 0.f; }
        } else {
#pragma unroll
            for (int q = 0; q < 16; ++q) { const f32x4 v = *(const f32x4*)(slot + lane * 64 + q * 4); S[4 * q] = v.x; S[4 * q + 1] = v.y; S[4 * q + 2] = v.z; S[4 * q + 3] = v.w; }
        }
        h16* outp = (dir == 0) ? (h16*)(C.ws + WS_MIX) : (h16*)(C.ws + WS_O);
        const int ldo = (dir == 0) ? MIXW : 512;
#pragma unroll 1
        for (int sub = 0; sub < CH_R / SUB; ++sub) {
#pragma unroll 1
            for (int s = 0; s < SUB; ++s) {
                const int p = c * CH_R + sub * SUB + s, t = dir ? T - 1 - p : p; const size_t tok = (size_t)b * T + t;
                const h16* ur = U + tok * LDA_ + col;
                const float rc = (float)ur[0], kc = (float)ur[512], vc = (float)ur[1024];
                float rp = 0.f, kp = 0.f, vp = 0.f, rn = 0.f, kn = 0.f, vn = 0.f;
                if (t > 0) { rp = (float)ur[-LDA_]; kp = (float)ur[512 - LDA_]; vp = (float)ur[1024 - LDA_]; }
                if (t < T - 1) { rn = (float)ur[LDA_]; kn = (float)ur[512 + LDA_]; vn = (float)ur[1024 + LDA_]; }
                const float rr = rc + m0r * (rp - rc) + m1r * (rn - rc), kk_ = kc + m0k * (kp - kc) + m1k * (kn - kc), vv = vc + m0v * (vp - vc) + m1v * (vn - vc);
                const float e = (float)U2[tok * 2048 + dir * 1024 + col], av = (float)U2[tok * 2048 + dir * 1024 + 512 + col];
                const float wdec = __expf(-e);
                const float kx = kk_ * kkw; const float n2 = wave_sum(kx * kx); const float kkn = kx / fmaxf(sqrtf(n2), 1e-12f);
                LAS float* q = wl + s * 384;
                q[lane] = wdec; q[64 + lane] = kkn; q[128 + lane] = kkn * av; q[192 + lane] = kk_ * (1.f + (av - 1.f) * kaw); q[256 + lane] = rr; q[320 + lane] = vv;
            }
            WAVE_SYNC();
#pragma unroll 1
            for (int s = 0; s < SUB; ++s) {
                const LAS f32x4* q = (const LAS f32x4*)(wl + s * 384);
                const float vv = wl[s * 384 + 320 + lane];
                float sa0 = 0.f, sa1 = 0.f, sp0 = 0.f, sp1 = 0.f;
#pragma unroll
                for (int k4 = 0; k4 < 16; ++k4) { const f32x4 kk4 = q[16 + k4];
                    sa0 += S[4 * k4] * kk4.x + S[4 * k4 + 2] * kk4.z; sa1 += S[4 * k4 + 1] * kk4.y + S[4 * k4 + 3] * kk4.w;
                    if (PASS == 1) { sp0 += P[4 * k4] * kk4.x + P[4 * k4 + 2] * kk4.z; sp1 += P[4 * k4 + 1] * kk4.y + P[4 * k4 + 3] * kk4.w; }
                    if ((k4 & 3) == 3) __builtin_amdgcn_sched_barrier(0); }
                const float sa = -(sa0 + sa1), sp = -(sp0 + sp1);
                float o0 = 0.f, o1 = 0.f;
#pragma unroll
                for (int k4 = 0; k4 < 16; ++k4) { const f32x4 w4 = q[k4], b4 = q[32 + k4], d4 = q[48 + k4];
                    S[4 * k4] = S[4 * k4] * w4.x + sa * b4.x + vv * d4.x; S[4 * k4 + 1] = S[4 * k4 + 1] * w4.y + sa * b4.y + vv * d4.y;
                    S[4 * k4 + 2] = S[4 * k4 + 2] * w4.z + sa * b4.z + vv * d4.z; S[4 * k4 + 3] = S[4 * k4 + 3] * w4.w + sa * b4.w + vv * d4.w;
                    if (PASS == 1) { P[4 * k4] = P[4 * k4] * w4.x + sp * b4.x; P[4 * k4 + 1] = P[4 * k4 + 1] * w4.y + sp * b4.y; P[4 * k4 + 2] = P[4 * k4 + 2] * w4.z + sp * b4.z; P[4 * k4 + 3] = P[4 * k4 + 3] * w4.w + sp * b4.w; }
                    else { const f32x4 r4 = q[64 + k4]; o0 += S[4 * k4] * r4.x + S[4 * k4 + 2] * r4.z; o1 += S[4 * k4 + 1] * r4.y + S[4 * k4 + 3] * r4.w; }
                    if ((k4 & 1) == 1) __builtin_amdgcn_sched_barrier(0); }
                if (PASS == 2) { const int p = c * CH_R + sub * SUB + s, t = dir ? T - 1 - p : p; outp[((size_t)b * T + t) * ldo + col] = (h16)(o0 + o1); }
            }
            WAVE_SYNC();
        }
        if (PASS == 1) {
#pragma unroll
            for (int q = 0; q < 16; ++q) { *(f32x4*)(slot + lane * 64 + q * 4) = (f32x4){S[4 * q], S[4 * q + 1], S[4 * q + 2], S[4 * q + 3]};
                *(f32x4*)(slot + 4096 + lane * 64 + q * 4) = (f32x4){P[4 * q], P[4 * q + 1], P[4 * q + 2], P[4 * q + 3]}; }
        }
    }
}
__device__ __forceinline__ void rwkv_cross(Ctx& C) {
    const int T = C.T, NC = T / CH_R, nunits = C.nseq * 16 * 8, tid = C.tid;
    LAS float* Cs = (LAS float*)C.lds; LAS float* Ps = Cs + 512;
    const int il = tid >> 6, jc = tid & 63;
    for (int unit = blockIdx.x; unit < nunits; unit += gridDim.x) {
        const int chain = unit >> 3, rg = unit & 7, hd = chain & 7, dir = (chain >> 3) & 1, b = chain >> 4;
        const int i = rg * 8 + il;
        float* base = (float*)(C.ws + WS_ST) + (size_t)((((b * 2 + dir) * NC) * 8) + hd) * 8192;
        float cr = 0.f;
        f32x4 p0 = *(const f32x4*)(base + 4096 + tid * 8), p1 = *(const f32x4*)(base + 4096 + tid * 8 + 4); float sl = base[i * 64 + jc];
        __syncthreads();
        for (int c = 0; c < NC; ++c) {
            float* cb = base + (size_t)c * 8 * 8192;
            *(LAS f32x4*)(Ps + tid * 8) = p0; *(LAS f32x4*)(Ps + tid * 8 + 4) = p1; Cs[il * 64 + jc] = cr;
            cb[i * 64 + jc] = cr;
            __syncthreads();
            float nr = sl;
            if (c + 1 < NC) { const float* nb = cb + 8 * 8192; p0 = *(const f32x4*)(nb + 4096 + tid * 8); p1 = *(const f32x4*)(nb + 4096 + tid * 8 + 4); sl = nb[i * 64 + jc]; }
#pragma unroll
            for (int m4 = 0; m4 < 16; ++m4) { const f32x4 cm = *(const LAS f32x4*)(Cs + il * 64 + m4 * 4);
                nr += cm.x * Ps[(m4 * 4) * 64 + jc]; nr += cm.y * Ps[(m4 * 4 + 1) * 64 + jc]; nr += cm.z * Ps[(m4 * 4 + 2) * 64 + jc]; nr += cm.w * Ps[(m4 * 4 + 3) * 64 + jc]; }
            __syncthreads();
            cr = nr;
        }
    }
}
__device__ __forceinline__ void rwkv_final(Ctx& C) {
    const int lane = C.lane, T = C.T, j = C.j, c0 = lane * 8;
    const h16* U = (const h16*)(C.ws + WS_U); h16* MIX = (h16*)(C.ws + WS_MIX); const h16* O = (const h16*)(C.ws + WS_O);
    const float* mu0p = IN(I_MU) + (size_t)j * 2 * A_IN, *mu1p = mu0p + A_IN;
    for (int tok = C.gw; tok < MG; tok += C.ngw) {
        const int t = tok % T;
        const h16x8 of = *(const h16x8*)(MIX + (size_t)tok * MIXW + c0), ob = *(const h16x8*)(O + (size_t)tok * 512 + c0), gg = *(const h16x8*)(MIX + (size_t)tok * MIXW + 512 + c0);
        float o[8], s = 0.f;
#pragma unroll
        for (int e = 0; e < 8; ++e) { o[e] = (float)of[e] + (float)ob[e]; s += o[e]; }
        s += __shfl_xor(s, 1); s += __shfl_xor(s, 2); s += __shfl_xor(s, 4);
        const float mean = s * (1.f / 64.f); float v2 = 0.f;
#pragma unroll
        for (int e = 0; e < 8; ++e) { o[e] -= mean; v2 += o[e] * o[e]; }
        v2 += __shfl_xor(v2, 1); v2 += __shfl_xor(v2, 2); v2 += __shfl_xor(v2, 4);
        const float rstd = rsqrtf(v2 * (1.f / 64.f) + 64e-5f);
        float rv[3][8];
#pragma unroll
        for (int part = 0; part < 3; ++part) {
            const h16* up = U + (size_t)tok * LDA_ + part * 512 + c0;
            const h16x8 cur = *(const h16x8*)up; h16x8 prv, nxt;
#pragma unroll
            for (int e = 0; e < 8; ++e) { prv[e] = (h16)0.f; nxt[e] = (h16)0.f; }
            if (t > 0) prv = *(const h16x8*)(up - LDA_);
            if (t < T - 1) nxt = *(const h16x8*)(up + LDA_);
#pragma unroll
            for (int e = 0; e < 8; ++e) { const float x = (float)cur[e]; rv[part][e] = x + mu0p[part * 512 + c0 + e] * ((float)prv[e] - x) + mu1p[part * 512 + c0 + e] * ((float)nxt[e] - x); }
        }
        float rk = 0.f;
#pragma unroll
        for (int e = 0; e < 8; ++e) rk += rv[0][e] * rv[1][e] * IN(I_RK)[j * 512 + c0 + e];
        rk += __shfl_xor(rk, 1); rk += __shfl_xor(rk, 2); rk += __shfl_xor(rk, 4);
        h16x8 w;
#pragma unroll
        for (int e = 0; e < 8; ++e) { const float y = o[e] * rstd * IN(I_GNW)[j * 512 + c0 + e] + IN(I_GNB)[j * 512 + c0 + e]; w[e] = (h16)((y + rk * rv[2][e]) * (float)gg[e]); }
        *(h16x8*)(MIX + (size_t)tok * MIXW + c0) = w;
    }
}

enum { MX_MAMBA = 0, MX_HGRN = 1, MX_RET = 2 };
template <int MX> struct MXC;
template <> struct MXC<MX_MAMBA> { static constexpr int CH = CH_M, NH = 16, LDU = LDB_; };
template <> struct MXC<MX_HGRN>  { static constexpr int CH = CH_H, NH = 8,  LDU = LDC_; };
template <> struct MXC<MX_RET>   { static constexpr int CH = CH_T, NH = 16, LDU = LDD_; };

__device__ __forceinline__ float ret_gamma(Ctx& C, int dir, int head) { return __expf(-__expf(IN(I_RETLD)[(C.j * 2 + dir) * 4 + head])); }

__device__ __forceinline__ void mamba_pre(Ctx& C) {
    const int T = C.T, j = C.j;
    const h16* U = (const h16*)(C.ws + WS_U); h16* BC = (h16*)(C.ws + WS_U + 88 * MiB); float* DT = (float*)(C.ws + WS_U + 104 * MiB); h16* XS = (h16*)(C.ws + WS_ST + 32 * MiB);
    const float* cw = IN(I_CONVW) + (size_t)j * 4 * 1536; const float* cb = IN(I_CONVB) + (size_t)j * 1536;
    for (int idx = C.gtid; idx < MG * 192; idx += C.ngt) {
        const int tok = idx / 192, q = idx - tok * 192, t = tok % T, c = q * 8;
        float acc[8];
#pragma unroll
        for (int e = 0; e < 8; ++e) acc[e] = cb[c + e];
#pragma unroll
        for (int jj = 0; jj < 4; ++jj) { const int tt = t + jj - 2;
            if (tt >= 0 && tt < T) { const h16x8 x = *(const h16x8*)(U + (size_t)(tok + jj - 2) * LDB_ + 1024 + c);
#pragma unroll
                for (int e = 0; e < 8; ++e) acc[e] += cw[jj * 1536 + c + e] * (float)x[e]; } }
        h16x8 w;
#pragma unroll
        for (int e = 0; e < 8; ++e) w[e] = (h16)silu(acc[e]);
        if (c < 1024) *(h16x8*)(XS + (size_t)tok * 1024 + c) = w; else *(h16x8*)(BC + (size_t)tok * 512 + (c - 1024)) = w;
    }
    for (int idx = C.gtid; idx < MG * 32; idx += C.ngt) { const int tok = idx >> 5, q = idx & 31;
        const float x = (float)U[(size_t)tok * LDB_ + 2560 + q] + IN(I_DTB)[j * 32 + q];
        const float dt = (x > 20.f) ? x : log1pf(expf(x)); const float da = -dt * expf(IN(I_ALOG)[j * 32 + q]);
        DT[(size_t)tok * 64 + q] = dt; DT[(size_t)tok * 64 + 32 + q] = da; }
}

constexpr int MC_OFF = 0, MB_OFF = 17408, MX_OFF = 36864, MG_OFF = 110592, MA_OFF = 119808;
__device__ __forceinline__ void mamba_stage_bc(Ctx& C, LAS h16* dst, bool transposed, int colbase, int b, int dir, int p0) {
    const int T = C.T, m = C.tid >> 3, i0 = (C.tid & 7) * 16;
    const int p = p0 + m, t = dir ? T - 1 - p : p; const size_t tok = (size_t)b * T + t;
    const h16* BC = (const h16*)(C.ws + WS_U + 88 * MiB);
    const h16x8 x1 = *(const h16x8*)(BC + tok * 512 + colbase + i0), x2 = *(const h16x8*)(BC + tok * 512 + colbase + i0 + 8);
    if (!transposed) { *(LAS h16x8*)(dst + m * 136 + i0) = x1; *(LAS h16x8*)(dst + m * 136 + i0 + 8) = x2; }
    else {
#pragma unroll
        for (int e = 0; e < 8; ++e) { dst[(i0 + e) * 72 + m] = x1[e]; dst[(i0 + 8 + e) * 72 + m] = x2[e]; } }
}
template <bool WEIGHTED>
__device__ __forceinline__ void mamba_stage_xt(Ctx& C, LAS h16* Xt, const LAS float* As, int g, int b, int dir, int p0, int lbase) {
    const int T = C.T; const h16* XS = (const h16*)(C.ws + WS_ST + 32 * MiB); const float* DT = (const float*)(C.ws + WS_U + 104 * MiB);
#pragma unroll 2
    for (int q = 0; q < 8; ++q) { const int it = C.tid + 512 * q, m = it >> 6, cb = it & 63, hl = cb >> 3;
        const int p = p0 + m, t = dir ? T - 1 - p : p; const size_t tok = (size_t)b * T + t;
        const h16x8 x = *(const h16x8*)(XS + tok * 1024 + g * 512 + cb * 8);
        float sc = DT[tok * 64 + dir * 16 + g * 8 + hl];
        if (WEIGHTED) sc *= __expf(As[hl * 256 + 255] - As[hl * 256 + lbase + m]);
#pragma unroll
        for (int e = 0; e < 8; ++e) Xt[(cb * 8 + e) * 72 + m] = (h16)((float)x[e] * sc); }
}
__device__ __forceinline__ void mamba_cum_decay(Ctx& C, LAS float* As, int g, int b, int dir, int c) {
    const int T = C.T, lane = C.lane, w = C.wave; const float* DT = (const float*)(C.ws + WS_U + 104 * MiB);
    float d[4]; float s = 0.f;
#pragma unroll
    for (int i = 0; i < 4; ++i) { const int p = c * 256 + 4 * lane + i, t = dir ? T - 1 - p : p; d[i] = DT[((size_t)b * T + t) * 64 + 32 + dir * 16 + g * 8 + w]; s += d[i]; d[i] = s; }
    float inc = s;
#pragma unroll
    for (int off = 1; off < 64; off <<= 1) { const float tv = __shfl_up(inc, off); if (lane >= off) inc += tv; }
    const float ex = inc - s;
#pragma unroll
    for (int i = 0; i < 4; ++i) As[w * 256 + 4 * lane + i] = ex + d[i];
}
__device__ __forceinline__ void mamba_mfma_pass1(Ctx& C) {
    const int T = C.T, NCH = T / 256, nunits = C.nseq * 2 * NCH * 2, lane = C.lane, w = C.wave, fr = lane & 15, fq = lane >> 4;
    LAS h16* Bt = (LAS h16*)(C.lds + MB_OFF); LAS h16* Xt = (LAS h16*)(C.lds + MX_OFF); LAS float* As = (LAS float*)(C.lds + MA_OFF);
    for (int unit = blockIdx.x; unit < nunits; unit += gridDim.x) {
        const int g = unit & 1; int r = unit >> 1; const int c = r % NCH; r /= NCH; const int dir = r & 1, b = r >> 1;
        __syncthreads();
        mamba_cum_decay(C, As, g, b, dir, c);
        f32x4 acc[8][4];
#pragma unroll
        for (int mt = 0; mt < 8; ++mt)
#pragma unroll
            for (int nt = 0; nt < 4; ++nt) acc[mt][nt] = (f32x4){0.f, 0.f, 0.f, 0.f};
#pragma unroll 1
        for (int jb = 0; jb < 4; ++jb) {
            __syncthreads();
            mamba_stage_bc(C, Bt, true, g * 128, b, dir, c * 256 + 64 * jb);
            mamba_stage_xt<true>(C, Xt, As, g, b, dir, c * 256 + 64 * jb, 64 * jb);
            __syncthreads();
#pragma unroll
            for (int ks = 0; ks < 2; ++ks) {
                h16x8 bx[4];
#pragma unroll
                for (int nt = 0; nt < 4; ++nt) bx[nt] = *(const LAS h16x8*)(Xt + (64 * w + 16 * nt + fr) * 72 + ks * 32 + fq * 8);
#pragma unroll
                for (int mt = 0; mt < 8; ++mt) { const h16x8 a = *(const LAS h16x8*)(Bt + (16 * mt + fr) * 72 + ks * 32 + fq * 8);
#pragma unroll
                    for (int nt = 0; nt < 4; ++nt) acc[mt][nt] = __builtin_amdgcn_mfma_f32_16x16x32_f16(a, bx[nt], acc[mt][nt], 0, 0, 0); }
            }
        }
        const int slot = (((b * 2 + dir) * NCH + c) * 16) + g * 8 + w;
        h16* Hg = (h16*)(C.ws + WS_ST) + (size_t)slot * 8192;
#pragma unroll
        for (int mt = 0; mt < 8; ++mt)
#pragma unroll
            for (int nt = 0; nt < 4; ++nt) { h16x4 v; v[0] = (h16)acc[mt][nt][0]; v[1] = (h16)acc[mt][nt][1]; v[2] = (h16)acc[mt][nt][2]; v[3] = (h16)acc[mt][nt][3];
                *(h16x4*)(Hg + (size_t)(16 * nt + fr) * 128 + 16 * mt + fq * 4) = v; }
        if (lane == 0) ((float*)(C.ws + WS_DEC))[slot] = __expf(As[w * 256 + 255]);
    }
}
__device__ __forceinline__ void mamba_mfma_cross(Ctx& C) {
    const int T = C.T, NCH = T / 256, nchains = C.nseq * 2 * 16;
    const float* DEC = (const float*)(C.ws + WS_DEC);
    for (int idx = C.gtid; idx < nchains * 1024; idx += C.ngt) {
        const int chain = idx >> 10, e8 = (idx & 1023) * 8, hd = chain & 15, dir = (chain >> 4) & 1, b = chain >> 5;
        float carry[8];
#pragma unroll
        for (int e = 0; e < 8; ++e) carry[e] = 0.f;
#pragma unroll 2
        for (int c = 0; c < NCH; ++c) { const int slot = (((b * 2 + dir) * NCH + c) * 16) + hd; h16* p = (h16*)(C.ws + WS_ST) + (size_t)slot * 8192 + e8;
            const h16x8 sl = *(const h16x8*)p; const float d = DEC[slot]; h16x8 o;
#pragma unroll
            for (int e = 0; e < 8; ++e) { o[e] = (h16)carry[e]; carry[e] = d * carry[e] + (float)sl[e]; }
            *(h16x8*)p = o; }
    }
}
__device__ __forceinline__ void mamba_mfma_pass2(Ctx& C) {
    const int T = C.T, NCH = T / 256, nunits = C.nseq * 2 * NCH * 2, lane = C.lane, w = C.wave, fr = lane & 15, fq = lane >> 4;
    LAS h16* Cs = (LAS h16*)(C.lds + MC_OFF); LAS h16* Bs = (LAS h16*)(C.lds + MB_OFF); LAS h16* Xt = (LAS h16*)(C.lds + MX_OFF); LAS h16* Gs = (LAS h16*)(C.lds + MG_OFF); LAS float* As = (LAS float*)(C.lds + MA_OFF);
    for (int unit = blockIdx.x; unit < nunits; unit += gridDim.x) {
        const int g = unit & 1; int r = unit >> 1; const int c = r % NCH; r /= NCH; const int dir = r & 1, b = r >> 1;
        const int hd = g * 8 + w;
        __syncthreads();
        mamba_cum_decay(C, As, g, b, dir, c);
        const int slot = (((b * 2 + dir) * NCH + c) * 16) + hd;
        const h16* Hg = (const h16*)(C.ws + WS_ST) + (size_t)slot * 8192;
        h16* outp; int ldo; if (dir == 0) { outp = (h16*)(C.ws + WS_MIX) + 512; ldo = MIXW; } else { outp = (h16*)(C.ws + WS_O); ldo = 1024; }
#pragma unroll 1
        for (int ib = 0; ib < 4; ++ib) {
            f32x4 acc[4][4];
#pragma unroll
            for (int mt = 0; mt < 4; ++mt)
#pragma unroll
                for (int nt = 0; nt < 4; ++nt) acc[mt][nt] = (f32x4){0.f, 0.f, 0.f, 0.f};
#pragma unroll 1
            for (int jb = 0; jb <= ib; ++jb) {
                __syncthreads();
                if (jb == 0) mamba_stage_bc(C, Cs, false, 256 + g * 128, b, dir, c * 256 + 64 * ib);
                mamba_stage_bc(C, Bs, false, g * 128, b, dir, c * 256 + 64 * jb);
                mamba_stage_xt<false>(C, Xt, As, g, b, dir, c * 256 + 64 * jb, 0);
                __syncthreads();
                if (jb == 0) {
#pragma unroll
                    for (int ks = 0; ks < 4; ++ks) { h16x8 hf[4];
#pragma unroll
                        for (int nt = 0; nt < 4; ++nt) hf[nt] = *(const h16x8*)(Hg + (size_t)(16 * nt + fr) * 128 + ks * 32 + fq * 8);
#pragma unroll
                        for (int mt = 0; mt < 4; ++mt) { const h16x8 a = *(const LAS h16x8*)(Cs + (16 * mt + fr) * 136 + ks * 32 + fq * 8);
#pragma unroll
                            for (int nt = 0; nt < 4; ++nt) acc[mt][nt] = __builtin_amdgcn_mfma_f32_16x16x32_f16(a, hf[nt], acc[mt][nt], 0, 0, 0); } }
#pragma unroll
                    for (int mt = 0; mt < 4; ++mt)
#pragma unroll
                        for (int jj = 0; jj < 4; ++jj) { const float rs = __expf(As[w * 256 + 64 * ib + 16 * mt + fq * 4 + jj]);
#pragma unroll
                            for (int nt = 0; nt < 4; ++nt) acc[mt][nt][jj] *= rs; }
                }
                {
                    const int gm = w >> 1, gn = w & 1;
                    f32x4 g0 = (f32x4){0.f, 0.f, 0.f, 0.f}, g1 = (f32x4){0.f, 0.f, 0.f, 0.f};
#pragma unroll
                    for (int ks = 0; ks < 4; ++ks) { const h16x8 a = *(const LAS h16x8*)(Cs + (16 * gm + fr) * 136 + ks * 32 + fq * 8);
                        const h16x8 k0 = *(const LAS h16x8*)(Bs + (32 * gn + fr) * 136 + ks * 32 + fq * 8), k1 = *(const LAS h16x8*)(Bs + (32 * gn + 16 + fr) * 136 + ks * 32 + fq * 8);
                        g0 = __builtin_amdgcn_mfma_f32_16x16x32_f16(a, k0, g0, 0, 0, 0); g1 = __builtin_amdgcn_mfma_f32_16x16x32_f16(a, k1, g1, 0, 0, 0); }
#pragma unroll
                    for (int jj = 0; jj < 4; ++jj) { const int l = 16 * gm + fq * 4 + jj; Gs[l * 72 + 32 * gn + fr] = (h16)g0[jj]; Gs[l * 72 + 32 * gn + 16 + fr] = (h16)g1[jj]; }
                }
                __syncthreads();
#pragma unroll
                for (int ks = 0; ks < 2; ++ks) {
                    h16x8 bx[4];
#pragma unroll
                    for (int nt = 0; nt < 4; ++nt) bx[nt] = *(const LAS h16x8*)(Xt + (64 * w + 16 * nt + fr) * 72 + ks * 32 + fq * 8);
                    const LAS float* Am = As + w * 256 + 64 * jb + ks * 32 + fq * 8;
                    const f32x4 am0 = *(const LAS f32x4*)Am, am1 = *(const LAS f32x4*)(Am + 4);
                    const float am[8] = {am0.x, am0.y, am0.z, am0.w, am1.x, am1.y, am1.z, am1.w};
                    const int Mb = 64 * jb + ks * 32 + fq * 8;
#pragma unroll
                    for (int mt = 0; mt < 4; ++mt) { const int l = 16 * mt + fr, Lg = 64 * ib + l; const float Al = As[w * 256 + Lg];
                        const h16x8 gr = *(const LAS h16x8*)(Gs + l * 72 + ks * 32 + fq * 8); h16x8 a;
#pragma unroll
                        for (int e = 0; e < 8; ++e) a[e] = (h16)((Mb + e <= Lg) ? (float)gr[e] * __expf(Al - am[e]) : 0.f);
#pragma unroll
                        for (int nt = 0; nt < 4; ++nt) acc[mt][nt] = __builtin_amdgcn_mfma_f32_16x16x32_f16(a, bx[nt], acc[mt][nt], 0, 0, 0); }
                }
            }
#pragma unroll
            for (int mt = 0; mt < 4; ++mt)
#pragma unroll
                for (int jj = 0; jj < 4; ++jj) { const int Lg = 64 * ib + 16 * mt + fq * 4 + jj; const int p = c * 256 + Lg, t = dir ? T - 1 - p : p; h16* op = outp + ((size_t)b * T + t) * ldo + hd * 64 + fr;
#pragma unroll
                    for (int nt = 0; nt < 4; ++nt) op[16 * nt] = (h16)acc[mt][nt][jj]; }
        }
    }
}

template <int MX, int PASS>
__device__ __forceinline__ void diag_scan(Ctx& C) {
    constexpr int CH = MXC<MX>::CH, NH = MXC<MX>::NH, LDU = MXC<MX>::LDU;
    const int lane = C.lane, T = C.T, NC = T / CH, j = C.j;
    const int nunits = C.nseq * 2 * NC * NH;
    const h16* U = (const h16*)(C.ws + WS_U);
    const h16* BC = (const h16*)(C.ws + WS_U + 88 * MiB); const float* DT = (const float*)(C.ws + WS_U + 104 * MiB);
    const float* ROT = (const float*)(C.ws + WS_ROT);
    float* DEC = (float*)(C.ws + WS_DEC);
    LAS float* wl = (LAS float*)(C.lds + C.wave * 12288);
    for (int unit = C.gw; unit < nunits; unit += C.ngw) {
        const int hd = unit % NH; int r = unit / NH; const int c = r % NC; r /= NC; const int dir = r & 1, b = r >> 1;
        const int slotid = ((b * 2 + dir) * NC + c) * NH + hd;
        float* slot = (float*)(C.ws + WS_ST) + (size_t)slotid * 8192;
        float S[128];
        if (PASS == 1) {
#pragma unroll
            for (int q = 0; q < 128; ++q) S[q] = 0.f;
        } else {
#pragma unroll
            for (int q = 0; q < 128; ++q) S[q] = slot[q * 64 + lane];
        }
        float k0 = 0.f, k1 = 0.f, k2 = 0.f, k3 = 0.f, k4c = 0.f, gam = 1.f, dprod = 1.f, D0 = 1.f, D1 = 1.f;
        h16* outp; int ldo, ocol;
        if (MX == MX_MAMBA) { const int cc = hd * 64 + lane; const float* cw = IN(I_CONVW) + (size_t)j * 4 * 1536; k0 = cw[cc]; k1 = cw[1536 + cc]; k2 = cw[2 * 1536 + cc]; k3 = cw[3 * 1536 + cc]; k4c = IN(I_CONVB)[j * 1536 + cc];
            ocol = hd * 64 + lane; if (dir == 0) { outp = (h16*)(C.ws + WS_MIX) + 512; ldo = MIXW; } else { outp = (h16*)(C.ws + WS_O); ldo = 1024; } }
        else if (MX == MX_HGRN) {
            if (j == 1) { const float* lb = IN(I_HGLB); const int f0 = hd * 128 + lane;
                k0 = sigm(lb[(dir * 2 + 1) * 1024 + f0] - lb[(dir * 2 + 0) * 1024 + f0]); k1 = sigm(lb[(dir * 2 + 1) * 1024 + f0 + 64] - lb[(dir * 2 + 0) * 1024 + f0 + 64]); }
            ocol = hd * 64 + lane; if (dir == 0) { outp = (h16*)(C.ws + WS_MIX); ldo = MIXW; } else { outp = (h16*)(C.ws + WS_O); ldo = 512; } }
        else { gam = ret_gamma(C, dir, hd >> 2);
            ocol = hd * 64 + lane; if (dir == 0) { outp = (h16*)(C.ws + WS_MIX) + 512; ldo = MIXW; } else { outp = (h16*)(C.ws + WS_O); ldo = 1024; } }
#pragma unroll 1
        for (int sub = 0; sub < CH / SUB; ++sub) {
#pragma unroll
            for (int s = 0; s < SUB; ++s) {
                const int p = c * CH + sub * SUB + s, t = dir ? T - 1 - p : p; const size_t tok = (size_t)b * T + t;
                const h16* ur = U + tok * LDU;
                LAS float* q = wl + s * 384;
                if (MX == MX_MAMBA) {
                    const int g = hd >> 3; const h16* bc = BC + tok * 512 + g * 128 + lane;
                    q[lane] = (float)bc[0]; q[64 + lane] = (float)bc[64];
                    if (PASS == 2) { q[128 + lane] = (float)bc[256]; q[192 + lane] = (float)bc[320]; }
                    const h16* xp = ur + 1024 + hd * 64 + lane;
                    float acc = k4c + k2 * (float)xp[0];
                    if (t >= 2) acc += k0 * (float)xp[-2 * LDU];
                    if (t >= 1) acc += k1 * (float)xp[-LDU];
                    if (t < T - 1) acc += k3 * (float)xp[LDU];
                    const float dt = DT[tok * 64 + dir * 16 + hd], dA = DT[tok * 64 + 32 + dir * 16 + hd];
                    q[256 + lane] = silu(acc) * dt; q[320] = dA; dprod *= dA;
                } else if (MX == MX_HGRN) {
                    const h16* fp = ur + 1024 + dir * 1024 + hd * 128 + lane;
                    const float f0 = k0 + (1.f - k0) * sigm((float)fp[0]), f1 = k1 + (1.f - k1) * sigm((float)fp[64]);
                    q[lane] = f0; q[64 + lane] = f1; D0 *= f0; D1 *= f1;
                    if (PASS == 2) { q[128 + lane] = (float)ur[hd * 128 + lane]; q[192 + lane] = (float)ur[hd * 128 + 64 + lane]; }
                    q[256 + lane] = (float)ur[3072 + hd * 64 + lane];
                } else {
                    const int h = hd >> 2; const float cs = ROT[t * 128 + lane], sn = ROT[t * 128 + 64 + lane];
                    const float x1 = (float)ur[512 + h * 128 + lane], x2 = (float)ur[512 + h * 128 + 64 + lane];
                    q[lane] = (x1 * cs - x2 * sn) * 0.08838834764831845f; q[64 + lane] = (x2 * cs + x1 * sn) * 0.08838834764831845f;
                    if (PASS == 2) { const float y1 = (float)ur[h * 128 + lane], y2 = (float)ur[h * 128 + 64 + lane]; q[128 + lane] = y1 * cs - y2 * sn; q[192 + lane] = y2 * cs + y1 * sn; }
                    q[256 + lane] = (float)ur[1024 + hd * 64 + lane];
                }
            }
            WAVE_SYNC();
#pragma unroll 1
            for (int s = 0; s < SUB; ++s) {
                const LAS f32x4* q = (const LAS f32x4*)(wl + s * 384);
                const float vv = wl[s * 384 + 256 + lane];
                const float dec = (MX == MX_MAMBA) ? wl[s * 384 + 320] : gam;
                float o0 = 0.f, o1 = 0.f, o2 = 0.f, o3 = 0.f;
#pragma unroll
                for (int k4 = 0; k4 < 32; ++k4) { const f32x4 a4 = q[k4];
                    if (MX == MX_HGRN) { S[4 * k4] = a4.x * (S[4 * k4] - vv) + vv; S[4 * k4 + 1] = a4.y * (S[4 * k4 + 1] - vv) + vv; S[4 * k4 + 2] = a4.z * (S[4 * k4 + 2] - vv) + vv; S[4 * k4 + 3] = a4.w * (S[4 * k4 + 3] - vv) + vv; }
                    else { S[4 * k4] = S[4 * k4] * dec + a4.x * vv; S[4 * k4 + 1] = S[4 * k4 + 1] * dec + a4.y * vv; S[4 * k4 + 2] = S[4 * k4 + 2] * dec + a4.z * vv; S[4 * k4 + 3] = S[4 * k4 + 3] * dec + a4.w * vv; }
                    if (PASS == 2) { const f32x4 q4 = q[32 + k4]; o0 += S[4 * k4] * q4.x; o1 += S[4 * k4 + 1] * q4.y; o2 += S[4 * k4 + 2] * q4.z; o3 += S[4 * k4 + 3] * q4.w; } }
                if (PASS == 2) { const int p = c * CH + sub * SUB + s, t = dir ? T - 1 - p : p; outp[((size_t)b * T + t) * ldo + ocol] = (h16)((o0 + o1) + (o2 + o3)); }
            }
            WAVE_SYNC();
        }
        if (PASS == 1) {
#pragma unroll
            for (int q = 0; q < 128; ++q) slot[q * 64 + lane] = S[q];
            if (MX == MX_MAMBA) { if (lane == 0) DEC[slotid] = dprod; }
            if (MX == MX_HGRN) { DEC[(size_t)slotid * 128 + lane] = D0; DEC[(size_t)slotid * 128 + 64 + lane] = D1; }
        }
    }
}
template <int MX>
__device__ __forceinline__ void diag_cross(Ctx& C) {
    constexpr int CH = MXC<MX>::CH, NH = MXC<MX>::NH;
    const int T = C.T, NC = T / CH, nchains = C.nseq * 2 * NH;
    const float* DEC = (const float*)(C.ws + WS_DEC);
    for (int idx = C.gtid; idx < nchains * 8192; idx += C.ngt) {
        const int chain = idx >> 13, e = idx & 8191, hd = chain % NH; int r = chain / NH; const int dir = r & 1, b = r >> 1;
        float gch = 1.f;
        if (MX == MX_RET) { const float lg = -__expf(IN(I_RETLD)[(C.j * 2 + dir) * 4 + (hd >> 2)]); gch = __expf(lg * (float)CH); }
        float carry = 0.f;
#pragma unroll 4
        for (int c = 0; c < NC; ++c) {
            const int slotid = ((b * 2 + dir) * NC + c) * NH + hd;
            float* p = (float*)(C.ws + WS_ST) + (size_t)slotid * 8192 + e;
            const float sl = *p; *p = carry;
            const float d = (MX == MX_HGRN) ? DEC[(size_t)slotid * 128 + (e >> 6)] : (MX == MX_MAMBA) ? DEC[slotid] : gch;
            carry = d * carry + sl;
        }
    }
}

constexpr int RQ_OFF = 0, RK_OFF = 17408, RV_OFF = 36864, RM_OFF = 73728;
__device__ __forceinline__ void ret_stage_qk(Ctx& C, LAS h16* dst, bool transposed, int colbase, float scale, float lg2, int wbase, int b, int dir, int p0) {
    const int T = C.T, m = C.tid >> 3, i0 = (C.tid & 7) * 8;
    const int p = p0 + m, t = dir ? T - 1 - p : p; const size_t tok = (size_t)b * T + t;
    const h16* U = (const h16*)(C.ws + WS_U); const float* ROT = (const float*)(C.ws + WS_ROT);
    const h16x8 x1 = *(const h16x8*)(U + tok * LDD_ + colbase + i0), x2 = *(const h16x8*)(U + tok * LDD_ + colbase + 64 + i0);
    const f32x4 c0 = *(const f32x4*)(ROT + t * 128 + i0), c1 = *(const f32x4*)(ROT + t * 128 + i0 + 4), s0 = *(const f32x4*)(ROT + t * 128 + 64 + i0), s1 = *(const f32x4*)(ROT + t * 128 + 64 + i0 + 4);
    const float cs[8] = {c0.x, c0.y, c0.z, c0.w, c1.x, c1.y, c1.z, c1.w}, sn[8] = {s0.x, s0.y, s0.z, s0.w, s1.x, s1.y, s1.z, s1.w};
    const float sc = transposed ? scale * exp2f((float)(wbase - m) * lg2) : scale;
    h16x8 y1, y2;
#pragma unroll
    for (int e = 0; e < 8; ++e) { const float a = (float)x1[e], bb = (float)x2[e]; y1[e] = (h16)((a * cs[e] - bb * sn[e]) * sc); y2[e] = (h16)((bb * cs[e] + a * sn[e]) * sc); }
    if (!transposed) { *(LAS h16x8*)(dst + m * 136 + i0) = y1; *(LAS h16x8*)(dst + m * 136 + 64 + i0) = y2; }
    else {
#pragma unroll
        for (int e = 0; e < 8; ++e) { dst[(i0 + e) * 72 + m] = y1[e]; dst[(64 + i0 + e) * 72 + m] = y2[e]; } }
}
__device__ __forceinline__ void ret_stage_vt(Ctx& C, LAS h16* Vt, int h, int b, int dir, int p0) {
    const int T = C.T; const h16* U = (const h16*)(C.ws + WS_U);
#pragma unroll
    for (int q = 0; q < 4; ++q) { const int it = C.tid + 512 * q, m = it >> 5, cb = it & 31;
        const int p = p0 + m, t = dir ? T - 1 - p : p; const size_t tok = (size_t)b * T + t;
        const h16x8 x = *(const h16x8*)(U + tok * LDD_ + 1024 + h * 256 + cb * 8);
#pragma unroll
        for (int e = 0; e < 8; ++e) Vt[(cb * 8 + e) * 72 + m] = x[e]; }
}
__device__ __forceinline__ void ret_mfma_pass1(Ctx& C) {
    const int T = C.T, NCH = T / 256, nunits = C.nseq * 2 * NCH * 4, lane = C.lane, w = C.wave, fr = lane & 15, fq = lane >> 4;
    LAS h16* Kt = (LAS h16*)(C.lds + RK_OFF); LAS h16* Vt = (LAS h16*)(C.lds + RV_OFF);
    for (int unit = blockIdx.x; unit < nunits; unit += gridDim.x) {
        const int h = unit & 3; int r = unit >> 2; const int c = r % NCH; r /= NCH; const int dir = r & 1, b = r >> 1;
        const float lg2 = -__expf(IN(I_RETLD)[(C.j * 2 + dir) * 4 + h]) * 1.4426950408889634f;
        f32x4 acc[8][2];
#pragma unroll
        for (int mt = 0; mt < 8; ++mt) { acc[mt][0] = (f32x4){0.f, 0.f, 0.f, 0.f}; acc[mt][1] = (f32x4){0.f, 0.f, 0.f, 0.f}; }
#pragma unroll 1
        for (int jb = 0; jb < 4; ++jb) {
            __syncthreads();
            ret_stage_qk(C, Kt, true, 512 + h * 128, 0.08838834764831845f, lg2, 255 - 64 * jb, b, dir, c * 256 + 64 * jb);
            ret_stage_vt(C, Vt, h, b, dir, c * 256 + 64 * jb);
            __syncthreads();
#pragma unroll
            for (int ks = 0; ks < 2; ++ks) {
                const h16x8 b0 = *(const LAS h16x8*)(Vt + (32 * w + fr) * 72 + ks * 32 + fq * 8), b1 = *(const LAS h16x8*)(Vt + (32 * w + 16 + fr) * 72 + ks * 32 + fq * 8);
#pragma unroll
                for (int mt = 0; mt < 8; ++mt) { const h16x8 a = *(const LAS h16x8*)(Kt + (16 * mt + fr) * 72 + ks * 32 + fq * 8);
                    acc[mt][0] = __builtin_amdgcn_mfma_f32_16x16x32_f16(a, b0, acc[mt][0], 0, 0, 0); acc[mt][1] = __builtin_amdgcn_mfma_f32_16x16x32_f16(a, b1, acc[mt][1], 0, 0, 0); }
            }
        }
        float* Sg = (float*)(C.ws + WS_ST) + (size_t)unit * 32768;
#pragma unroll
        for (int mt = 0; mt < 8; ++mt)
#pragma unroll
            for (int nt = 0; nt < 2; ++nt) *(f32x4*)(Sg + (size_t)(32 * w + 16 * nt + fr) * 128 + 16 * mt + fq * 4) = acc[mt][nt];
    }
}
__device__ __forceinline__ void ret_mfma_cross(Ctx& C) {
    const int T = C.T, NCH = T / 256, nchains = C.nseq * 2 * 4;
    for (int idx = C.gtid; idx < nchains * 32768; idx += C.ngt) {
        const int chain = idx >> 15, e = idx & 32767, h = chain & 3, dir = (chain >> 2) & 1, b = chain >> 3;
        const float gch = __expf(-__expf(IN(I_RETLD)[(C.j * 2 + dir) * 4 + h]) * 256.f);
        float carry = 0.f;
#pragma unroll 4
        for (int c = 0; c < NCH; ++c) { float* p = (float*)(C.ws + WS_ST) + (size_t)((((b * 2 + dir) * NCH + c) * 4) + h) * 32768 + e; const float sl = *p; *p = carry; carry = gch * carry + sl; }
    }
}
__device__ __forceinline__ void ret_mfma_pass2(Ctx& C) {
    const int T = C.T, NCH = T / 256, nunits = C.nseq * 2 * NCH * 4, lane = C.lane, w = C.wave, fr = lane & 15, fq = lane >> 4;
    LAS h16* Qs = (LAS h16*)(C.lds + RQ_OFF); LAS h16* Ks = (LAS h16*)(C.lds + RK_OFF); LAS h16* Vt = (LAS h16*)(C.lds + RV_OFF); LAS h16* Ms = (LAS h16*)(C.lds + RM_OFF);
    for (int unit = blockIdx.x; unit < nunits; unit += gridDim.x) {
        const int h = unit & 3; int r = unit >> 2; const int c = r % NCH; r /= NCH; const int dir = r & 1, b = r >> 1;
        const float lg2 = -__expf(IN(I_RETLD)[(C.j * 2 + dir) * 4 + h]) * 1.4426950408889634f;
        const float* Sg = (const float*)(C.ws + WS_ST) + (size_t)unit * 32768;
        h16x8 sf[2][4];
#pragma unroll
        for (int nt = 0; nt < 2; ++nt)
#pragma unroll
            for (int ks = 0; ks < 4; ++ks) { const float* p = Sg + (size_t)(32 * w + 16 * nt + fr) * 128 + ks * 32 + fq * 8; const f32x4 a = *(const f32x4*)p, bb = *(const f32x4*)(p + 4);
                sf[nt][ks][0] = (h16)a.x; sf[nt][ks][1] = (h16)a.y; sf[nt][ks][2] = (h16)a.z; sf[nt][ks][3] = (h16)a.w; sf[nt][ks][4] = (h16)bb.x; sf[nt][ks][5] = (h16)bb.y; sf[nt][ks][6] = (h16)bb.z; sf[nt][ks][7] = (h16)bb.w; }
        h16* outp; int ldo; if (dir == 0) { outp = (h16*)(C.ws + WS_MIX) + 512; ldo = MIXW; } else { outp = (h16*)(C.ws + WS_O); ldo = 1024; }
#pragma unroll 1
        for (int ib = 0; ib < 4; ++ib) {
            f32x4 acc[4][2];
#pragma unroll
            for (int mt = 0; mt < 4; ++mt) { acc[mt][0] = (f32x4){0.f, 0.f, 0.f, 0.f}; acc[mt][1] = (f32x4){0.f, 0.f, 0.f, 0.f}; }
#pragma unroll 1
            for (int jb = 0; jb <= ib; ++jb) {
                __syncthreads();
                if (jb == 0) ret_stage_qk(C, Qs, false, h * 128, 1.f, lg2, 0, b, dir, c * 256 + 64 * ib);
                ret_stage_qk(C, Ks, false, 512 + h * 128, 0.08838834764831845f, lg2, 0, b, dir, c * 256 + 64 * jb);
                ret_stage_vt(C, Vt, h, b, dir, c * 256 + 64 * jb);
                __syncthreads();
                {
                    const int gm = w >> 1, gn = w & 1;
                    f32x4 g0 = (f32x4){0.f, 0.f, 0.f, 0.f}, g1 = (f32x4){0.f, 0.f, 0.f, 0.f};
#pragma unroll
                    for (int ks = 0; ks < 4; ++ks) { const h16x8 a = *(const LAS h16x8*)(Qs + (16 * gm + fr) * 136 + ks * 32 + fq * 8);
                        const h16x8 k0 = *(const LAS h16x8*)(Ks + (32 * gn + fr) * 136 + ks * 32 + fq * 8), k1 = *(const LAS h16x8*)(Ks + (32 * gn + 16 + fr) * 136 + ks * 32 + fq * 8);
                        g0 = __builtin_amdgcn_mfma_f32_16x16x32_f16(a, k0, g0, 0, 0, 0); g1 = __builtin_amdgcn_mfma_f32_16x16x32_f16(a, k1, g1, 0, 0, 0); }
#pragma unroll
                    for (int jj = 0; jj < 4; ++jj) { const int l = 16 * gm + fq * 4 + jj, Lg = 64 * ib + l;
                        const int m0 = 32 * gn + fr, M0 = 64 * jb + m0, M1 = M0 + 16;
                        Ms[l * 72 + m0] = (h16)((M0 <= Lg) ? g0[jj] * exp2f((float)(Lg - M0) * lg2) : 0.f);
                        Ms[l * 72 + m0 + 16] = (h16)((M1 <= Lg) ? g1[jj] * exp2f((float)(Lg - M1) * lg2) : 0.f); }
                }
                __syncthreads();
#pragma unroll
                for (int ks = 0; ks < 2; ++ks) {
                    const h16x8 b0 = *(const LAS h16x8*)(Vt + (32 * w + fr) * 72 + ks * 32 + fq * 8), b1 = *(const LAS h16x8*)(Vt + (32 * w + 16 + fr) * 72 + ks * 32 + fq * 8);
#pragma unroll
                    for (int mt = 0; mt < 4; ++mt) { const h16x8 a = *(const LAS h16x8*)(Ms + (16 * mt + fr) * 72 + ks * 32 + fq * 8);
                        acc[mt][0] = __builtin_amdgcn_mfma_f32_16x16x32_f16(a, b0, acc[mt][0], 0, 0, 0); acc[mt][1] = __builtin_amdgcn_mfma_f32_16x16x32_f16(a, b1, acc[mt][1], 0, 0, 0); }
                }
            }
            f32x4 ac2[4][2];
#pragma unroll
            for (int mt = 0; mt < 4; ++mt) { ac2[mt][0] = (f32x4){0.f, 0.f, 0.f, 0.f}; ac2[mt][1] = (f32x4){0.f, 0.f, 0.f, 0.f}; }
#pragma unroll
            for (int ks = 0; ks < 4; ++ks)
#pragma unroll
                for (int mt = 0; mt < 4; ++mt) { const h16x8 a = *(const LAS h16x8*)(Qs + (16 * mt + fr) * 136 + ks * 32 + fq * 8);
                    ac2[mt][0] = __builtin_amdgcn_mfma_f32_16x16x32_f16(a, sf[0][ks], ac2[mt][0], 0, 0, 0); ac2[mt][1] = __builtin_amdgcn_mfma_f32_16x16x32_f16(a, sf[1][ks], ac2[mt][1], 0, 0, 0); }
#pragma unroll
            for (int mt = 0; mt < 4; ++mt)
#pragma unroll
                for (int jj = 0; jj < 4; ++jj) { const int Lg = 64 * ib + 16 * mt + fq * 4 + jj; const float rs = exp2f((float)(Lg + 1) * lg2);
                    const int p = c * 256 + Lg, t = dir ? T - 1 - p : p; h16* op = outp + ((size_t)b * T + t) * ldo + h * 256 + 32 * w + fr;
                    op[0] = (h16)(acc[mt][0][jj] + ac2[mt][0][jj] * rs); op[16] = (h16)(acc[mt][1][jj] + ac2[mt][1][jj] * rs); }
        }
    }
}

typedef short s16x4 __attribute__((ext_vector_type(4)));
typedef __bf16 b16x8 __attribute__((ext_vector_type(8)));
typedef unsigned u32x2 __attribute__((ext_vector_type(2)));
typedef float f32x2_t __attribute__((ext_vector_type(2)));
typedef __bf16 bf16x2_t __attribute__((ext_vector_type(2)));
__device__ __forceinline__ unsigned cvt_pk_bf16(float lo, float hi) { const f32x2_t v = {lo, hi}; const bf16x2_t b = __builtin_convertvector(v, bf16x2_t); return __builtin_bit_cast(unsigned, b); }
__device__ __forceinline__ s16x4 cvt4_bf16(f32x4 v) { const unsigned a = cvt_pk_bf16(v.x, v.y), b = cvt_pk_bf16(v.z, v.w); s16x4 r; r[0] = (short)(a & 0xffff); r[1] = (short)(a >> 16); r[2] = (short)(b & 0xffff); r[3] = (short)(b >> 16); return r; }
constexpr int HQ_OFF = 0, HK_OFF = 4352, HT_OFF = 8704, HV_OFF = 13824, HE8_OFF = 16384, HE15_OFF = 16896, HWAVE_LDS = 18432;
template <int PASS>
__device__ __forceinline__ void hgrn_mfma(Ctx& C) {
    const int lane = C.lane, T = C.T, NC = T / CH_H, j = C.j, fr = lane & 15, fq = lane >> 4;
    const int nunits = C.nseq * 2 * NC * 8;
    const h16* U = (const h16*)(C.ws + WS_U);
    float* DEC = (float*)(C.ws + WS_DEC);
    LAS unsigned char* wl = C.lds + C.wave * HWAVE_LDS;
    LAS unsigned short* QB = (LAS unsigned short*)(wl + HQ_OFF); LAS unsigned short* KB = (LAS unsigned short*)(wl + HK_OFF);
    LAS unsigned short* KT = (LAS unsigned short*)(wl + HT_OFF); LAS unsigned short* VT = (LAS unsigned short*)(wl + HV_OFF);
    LAS float* E8 = (LAS float*)(wl + HE8_OFF); LAS float* E15 = (LAS float*)(wl + HE15_OFF);
    for (int unit = C.gw; unit < nunits; unit += C.ngw) {
        const int hd = unit & 7; int r_ = unit >> 3; const int c = r_ % NC; r_ /= NC; const int dir = r_ & 1, b = r_ >> 1;
        float* Sg = (float*)(C.ws + WS_ST) + (size_t)unit * 8192;
        float lb0 = 0.f, lb1 = 0.f;
        if (j == 1) { const float* lbp = IN(I_HGLB); const int f0 = hd * 128 + lane;
            lb0 = sigm(lbp[(dir * 2 + 1) * 1024 + f0] - lbp[(dir * 2 + 0) * 1024 + f0]); lb1 = sigm(lbp[(dir * 2 + 1) * 1024 + f0 + 64] - lbp[(dir * 2 + 0) * 1024 + f0 + 64]); }
        f32x4 S[8][4];
#pragma unroll
        for (int mt = 0; mt < 8; ++mt)
#pragma unroll
            for (int nt = 0; nt < 4; ++nt) S[mt][nt] = (PASS == 1) ? (f32x4){0.f, 0.f, 0.f, 0.f} : *(const f32x4*)(Sg + (size_t)(16 * nt + fr) * 128 + 16 * mt + 4 * fq);
        float dlog0 = 0.f, dlog1 = 0.f;
        h16* outp; int ldo; if (dir == 0) { outp = (h16*)(C.ws + WS_MIX); ldo = MIXW; } else { outp = (h16*)(C.ws + WS_O); ldo = 512; }
#pragma unroll 1
        for (int sb = 0; sb < CH_H / 16; ++sb) {
            const int p0 = c * CH_H + sb * 16;
            {
                unsigned pk[8];
#pragma unroll
                for (int r = 0; r < 16; r += 2) { const int pa = p0 + r, ta = dir ? T - 1 - pa : pa, tb = dir ? ta - 1 : ta + 1;
                    const float va = (float)U[((size_t)b * T + ta) * LDC_ + 3072 + hd * 64 + lane], vb = (float)U[((size_t)b * T + tb) * LDC_ + 3072 + hd * 64 + lane];
                    pk[r >> 1] = cvt_pk_bf16(va, vb); }
#pragma unroll
                for (int q = 0; q < 4; ++q) *(LAS u32x2*)(VT + lane * 20 + 4 * q) = (u32x2){pk[2 * q], pk[2 * q + 1]};
            }
#pragma unroll 1
            for (int ch = 0; ch < 2; ++ch) {
                const int k = lane + 64 * ch; const float lb = ch ? lb1 : lb0;
                float bb[16], kv[16]; float run = 0.f;
#pragma unroll
                for (int r = 0; r < 16; ++r) { const int pp = p0 + r, t = dir ? T - 1 - pp : pp;
                    const float x = (float)U[((size_t)b * T + t) * LDC_ + 1024 + dir * 1024 + hd * 128 + k];
                    const float om = (1.f - lb) / (1.f + __expf(x));
                    const float ff = lb + (1.f - lb) / (1.f + __expf(-x));
                    kv[r] = om; run += __logf(ff); bb[r] = run; }
                const float b8 = bb[8], b15 = bb[15];
                unsigned pk[8];
#pragma unroll
                for (int r = 0; r < 16; r += 2) {
                    const float ka = kv[r] * __expf(b8 - bb[r]), kb2 = kv[r + 1] * __expf(b8 - bb[r + 1]);
                    const unsigned pkk = cvt_pk_bf16(ka, kb2); pk[r >> 1] = pkk;
                    if (PASS == 2) {
                        const int pa = p0 + r, ta = dir ? T - 1 - pa : pa, tb = dir ? ta - 1 : ta + 1;
                        const float qa = (float)U[((size_t)b * T + ta) * LDC_ + hd * 128 + k] * __expf(bb[r] - b8), qb = (float)U[((size_t)b * T + tb) * LDC_ + hd * 128 + k] * __expf(bb[r + 1] - b8);
                        const unsigned pkq = cvt_pk_bf16(qa, qb);
                        QB[r * 136 + k] = (unsigned short)(pkq & 0xffff); QB[(r + 1) * 136 + k] = (unsigned short)(pkq >> 16);
                        KB[r * 136 + k] = (unsigned short)(pkk & 0xffff); KB[(r + 1) * 136 + k] = (unsigned short)(pkk >> 16);
                    }
                }
#pragma unroll
                for (int q = 0; q < 4; ++q) *(LAS u32x2*)(KT + k * 20 + 4 * q) = (u32x2){pk[2 * q], pk[2 * q + 1]};
                E8[k] = __expf(b8); E15[k] = __expf(b15 - b8);
                if (ch == 0) dlog0 += b15; else dlog1 += b15;
            }
            WAVE_SYNC();
#pragma unroll
            for (int mt = 0; mt < 8; ++mt) { const f32x4 e4 = *(const LAS f32x4*)(E8 + 16 * mt + 4 * fq);
#pragma unroll
                for (int nt = 0; nt < 4; ++nt) S[mt][nt] = S[mt][nt] * e4; }
            s16x4 vt[4];
#pragma unroll
            for (int nt = 0; nt < 4; ++nt) vt[nt] = *(const LAS s16x4*)(VT + (16 * nt + fr) * 20 + 4 * fq);
            if (PASS == 2) {
                f32x4 oT[4];
#pragma unroll
                for (int nt = 0; nt < 4; ++nt) oT[nt] = (f32x4){0.f, 0.f, 0.f, 0.f};
#pragma unroll
                for (int mt = 0; mt < 8; ++mt) { const s16x4 qf = *(const LAS s16x4*)(QB + fr * 136 + 16 * mt + 4 * fq);
#pragma unroll
                    for (int nt = 0; nt < 4; ++nt) oT[nt] = __builtin_amdgcn_mfma_f32_16x16x16bf16_1k(cvt4_bf16(S[mt][nt]), qf, oT[nt], 0, 0, 0); }
                f32x4 sT = (f32x4){0.f, 0.f, 0.f, 0.f};
#pragma unroll
                for (int ks = 0; ks < 4; ++ks) { const b16x8 ka = *(const LAS b16x8*)(KB + fr * 136 + 32 * ks + 8 * fq), qb = *(const LAS b16x8*)(QB + fr * 136 + 32 * ks + 8 * fq);
                    sT = __builtin_amdgcn_mfma_f32_16x16x32_bf16(ka, qb, sT, 0, 0, 0); }
#pragma unroll
                for (int jj = 0; jj < 4; ++jj) if (4 * fq + jj > fr) sT[jj] = 0.f;
                const s16x4 sb4 = cvt4_bf16(sT);
#pragma unroll
                for (int nt = 0; nt < 4; ++nt) oT[nt] = __builtin_amdgcn_mfma_f32_16x16x16bf16_1k(vt[nt], sb4, oT[nt], 0, 0, 0);
                const int pp = p0 + fr, t = dir ? T - 1 - pp : pp; h16* op = outp + ((size_t)b * T + t) * ldo + hd * 64 + 4 * fq;
#pragma unroll
                for (int nt = 0; nt < 4; ++nt) { h16x4 w; w[0] = (h16)oT[nt][0]; w[1] = (h16)oT[nt][1]; w[2] = (h16)oT[nt][2]; w[3] = (h16)oT[nt][3]; *(h16x4*)(op + 16 * nt) = w; }
            }
#pragma unroll
            for (int mt = 0; mt < 8; ++mt) { const s16x4 kf = *(const LAS s16x4*)(KT + (16 * mt + fr) * 20 + 4 * fq); const f32x4 e4 = *(const LAS f32x4*)(E15 + 16 * mt + 4 * fq);
#pragma unroll
                for (int nt = 0; nt < 4; ++nt) { S[mt][nt] = __builtin_amdgcn_mfma_f32_16x16x16bf16_1k(kf, vt[nt], S[mt][nt], 0, 0, 0); S[mt][nt] = S[mt][nt] * e4; } }
            WAVE_SYNC();
        }
        if (PASS == 1) {
#pragma unroll
            for (int mt = 0; mt < 8; ++mt)
#pragma unroll
                for (int nt = 0; nt < 4; ++nt) *(f32x4*)(Sg + (size_t)(16 * nt + fr) * 128 + 16 * mt + 4 * fq) = S[mt][nt];
            DEC[(size_t)unit * 128 + lane] = __expf(dlog0); DEC[(size_t)unit * 128 + 64 + lane] = __expf(dlog1);
        }
    }
}
__device__ __forceinline__ void hgrn_cross(Ctx& C) {
    const int T = C.T, NC = T / CH_H, nchains = C.nseq * 2 * 8;
    const float* DEC = (const float*)(C.ws + WS_DEC);
    for (int idx = C.gtid; idx < nchains * 8192; idx += C.ngt) {
        const int chain = idx >> 13, e = idx & 8191, hd = chain & 7, dir = (chain >> 3) & 1, b = chain >> 4;
        float carry = 0.f;
#pragma unroll 4
        for (int c = 0; c < NC; ++c) { const int slotid = ((b * 2 + dir) * NC + c) * 8 + hd; float* p = (float*)(C.ws + WS_ST) + (size_t)slotid * 8192 + e;
            const float sl = *p; *p = carry; carry = DEC[(size_t)slotid * 128 + (e & 127)] * carry + sl; }
    }
}
__device__ __forceinline__ void mamba_final(Ctx& C) {
    const int lane = C.lane, j = C.j, c0 = lane * 16;
    const h16* U = (const h16*)(C.ws + WS_U); h16* MIX = (h16*)(C.ws + WS_MIX); const h16* O = (const h16*)(C.ws + WS_O); const h16* XS = (const h16*)(C.ws + WS_ST + 32 * MiB);
    const float dsk = IN(I_SSMD)[j * 16 + (lane >> 2)];
    for (int tok = C.gw; tok < MG; tok += C.ngw) {
        float y[16]; float ss = 0.f;
#pragma unroll
        for (int hf = 0; hf < 2; ++hf) {
            const int c = c0 + hf * 8;
            const h16x8 xs = *(const h16x8*)(XS + (size_t)tok * 1024 + c), yf = *(const h16x8*)(MIX + (size_t)tok * MIXW + 512 + c), yb = *(const h16x8*)(O + (size_t)tok * 1024 + c), z = *(const h16x8*)(U + (size_t)tok * LDB_ + c);
#pragma unroll
            for (int e = 0; e < 8; ++e) { const float v = ((float)yf[e] + (float)yb[e] + (float)xs[e] * dsk) * silu((float)z[e]); y[hf * 8 + e] = v; ss += v * v; }
        }
#pragma unroll
        for (int o = 1; o < 32; o <<= 1) ss += __shfl_xor(ss, o);
        const float rstd = rsqrtf(ss * (1.f / 512.f) + 1e-5f);
#pragma unroll
        for (int hf = 0; hf < 2; ++hf) { h16x8 w;
#pragma unroll
            for (int e = 0; e < 8; ++e) w[e] = (h16)(y[hf * 8 + e] * rstd * IN(I_SSMNW)[j * 1024 + c0 + hf * 8 + e]);
            *(h16x8*)(MIX + (size_t)tok * MIXW + 512 + c0 + hf * 8) = w; }
    }
}
__device__ __forceinline__ void hgrn_final(Ctx& C) {
    const int lane = C.lane, j = C.j, c0 = lane * 8;
    const h16* U = (const h16*)(C.ws + WS_U); h16* MIX = (h16*)(C.ws + WS_MIX); const h16* O = (const h16*)(C.ws + WS_O);
    for (int tok = C.gw; tok < MG; tok += C.ngw) {
        const h16x8 of = *(const h16x8*)(MIX + (size_t)tok * MIXW + c0), ob = *(const h16x8*)(O + (size_t)tok * 512 + c0), gg = *(const h16x8*)(U + (size_t)tok * LDC_ + 3584 + c0);
        float o[8], ss = 0.f;
#pragma unroll
        for (int e = 0; e < 8; ++e) { o[e] = (float)of[e] + (float)ob[e]; ss += o[e] * o[e]; }
        ss += __shfl_xor(ss, 1); ss += __shfl_xor(ss, 2); ss += __shfl_xor(ss, 4);
        const float rstd = rsqrtf(ss * (1.f / 64.f) + 1e-5f);
        h16x8 w;
#pragma unroll
        for (int e = 0; e < 8; ++e) w[e] = (h16)(o[e] * rstd * IN(I_HGNW)[j * 512 + c0 + e] * sigm((float)gg[e]));
        *(h16x8*)(MIX + (size_t)tok * MIXW + c0) = w;
    }
}
__device__ __forceinline__ void ret_final(Ctx& C) {
    const int lane = C.lane, j = C.j, c0 = lane * 16;
    const h16* U = (const h16*)(C.ws + WS_U); h16* MIX = (h16*)(C.ws + WS_MIX); const h16* O = (const h16*)(C.ws + WS_O);
    for (int tok = C.gw; tok < MG; tok += C.ngw) {
        float o[16], s = 0.f;
#pragma unroll
        for (int hf = 0; hf < 2; ++hf) { const h16x8 of = *(const h16x8*)(MIX + (size_t)tok * MIXW + 512 + c0 + hf * 8), ob = *(const h16x8*)(O + (size_t)tok * 1024 + c0 + hf * 8);
#pragma unroll
            for (int e = 0; e < 8; ++e) { o[hf * 8 + e] = (float)of[e] + (float)ob[e]; s += o[hf * 8 + e]; } }
#pragma unroll
        for (int q = 1; q < 16; q <<= 1) s += __shfl_xor(s, q);
        const float mean = s * (1.f / 256.f); float v2 = 0.f;
#pragma unroll
        for (int e = 0; e < 16; ++e) { o[e] -= mean; v2 += o[e] * o[e]; }
#pragma unroll
        for (int q = 1; q < 16; q <<= 1) v2 += __shfl_xor(v2, q);
        const float rstd = rsqrtf(v2 * (1.f / 256.f) + 1e-5f);
#pragma unroll
        for (int hf = 0; hf < 2; ++hf) { const h16x8 gg = *(const h16x8*)(U + (size_t)tok * LDD_ + 2048 + c0 + hf * 8); h16x8 w;
#pragma unroll
            for (int e = 0; e < 8; ++e) { const int cc = c0 + hf * 8 + e; w[e] = (h16)((o[hf * 8 + e] * rstd * IN(I_RETGW)[j * 1024 + cc] + IN(I_RETGB)[j * 1024 + cc]) * silu((float)gg[e])); }
            *(h16x8*)(MIX + (size_t)tok * MIXW + 512 + c0 + hf * 8) = w; }
    }
}

template <class Epi> __device__ __forceinline__ void run_gemm(Ctx& C, const h16* A, const h16* Bt, int N, int K, const Epi& E) {
    pg8::Gemm g{A, Bt, MG, N, K}; pg8::StaticOrder S; S.init(MG, N, (int)gridDim.x, (int)blockIdx.x);
    pg8::gemm_phase<Epi, pg8::StaticOrder>(C.lds, g, S, E, C.tid);
}

__global__ void __launch_bounds__(NTHR, 2) mega(Args args) {
    extern __shared__ __attribute__((aligned(16))) unsigned char lds_raw[];
    cg::grid_group grid = cg::this_grid();
    Ctx C;
#pragma unroll
    for (int i = 0; i < 32; ++i) C.in[i] = args.in[i];
    C.lds = (LAS unsigned char*)lds_raw; C.tid = threadIdx.x; C.lane = C.tid & 63; C.wave = __builtin_amdgcn_readfirstlane(C.tid >> 6);
    C.gw = blockIdx.x * NWAVES + C.wave; C.ngw = gridDim.x * NWAVES; C.gtid = blockIdx.x * NTHR + C.tid; C.ngt = gridDim.x * NTHR; C.ws = args.ws;
    h16* HN = (h16*)(C.ws + WS_HN); h16* MIX = (h16*)(C.ws + WS_MIX); h16* U = (h16*)(C.ws + WS_U);
    volatile LAS unsigned* bst = (volatile LAS unsigned*)(C.lds + LDS_BYTES - 16);
    if (threadIdx.x < 4) bst[threadIdx.x] = 0u;
    __syncthreads();
    const XcdBarrier xbar = xcd_barrier_post((unsigned*)(C.ws + WS_BAR), bst);
#define SYNC() xcd_barrier(xbar)
#ifndef PH
#define PH 0xFFFF
#endif
#ifndef DUP
#define DUP 0
#endif
#define P_(b, ...) do { for (int rep_ = 0; rep_ < 1 + ((DUP >> (b)) & 1); ++rep_) if (PH & (1 << (b))) { int t_ = threadIdx.x; asm volatile("" : "+v"(t_)); C.tid = t_; C.lane = t_ & 63; C.wave = __builtin_amdgcn_readfirstlane(t_ >> 6); C.gw = blockIdx.x * NWAVES + C.wave; C.gtid = blockIdx.x * NTHR + t_; __VA_ARGS__; } } while (0)
#pragma unroll 1
    for (int layer = 0; layer < 4; ++layer) {
        C.layer = layer; C.j = layer >> 1;
        P_(0, phase_weights(C)); if (layer == 0) grid.sync(); else SYNC();
#pragma unroll 1
        for (int grp = 0; grp < 2; ++grp) {
            C.grp = grp; C.nseq = grp == 0 ? 2 : 1; C.T = grp == 0 ? 8192 : 16384;
            C.hdst = args.out + (size_t)grp * MG * D; C.hsrc = (layer == 0) ? args.in[grp == 0 ? I_XP : I_XS] : C.hdst;
            P_(1, phase_norm(C, C.hsrc, IN(I_LNMIX) + layer * D, HN)); SYNC();
            if ((layer & 1) == 0) {
                P_(2, run_gemm(C, HN, (const h16*)(C.ws + W_IN1), LDA_, D, pg8::EpiF16<0>{U, LDA_})); SYNC();
                P_(3, rwkv_pre(C)); SYNC();
                P_(4, rwkv_scan<1>(C)); SYNC();
                P_(5, rwkv_cross(C)); SYNC();
                P_(6, rwkv_scan<2>(C)); SYNC();
                P_(7, rwkv_final(C)); SYNC();
                P_(2, run_gemm(C, HN, (const h16*)(C.ws + W_IN2), LDB_, D, pg8::EpiF16<0>{U, LDB_})); SYNC();
                P_(8, mamba_pre(C)); SYNC();
                P_(9, mamba_mfma_pass1(C)); SYNC();
                P_(5, mamba_mfma_cross(C)); SYNC();
                P_(9, mamba_mfma_pass2(C)); SYNC();
                P_(10, mamba_final(C)); SYNC();
            } else {
                P_(2, run_gemm(C, HN, (const h16*)(C.ws + W_IN1), LDC_, D, pg8::EpiF16<0>{U, LDC_})); SYNC();
                P_(11, hgrn_mfma<1>(C)); SYNC();
                P_(5, hgrn_cross(C)); SYNC();
                P_(11, hgrn_mfma<2>(C)); SYNC();
                P_(12, hgrn_final(C)); SYNC();
                P_(2, run_gemm(C, HN, (const h16*)(C.ws + W_IN2), LDD_, D, pg8::EpiF16<0>{U, LDD_})); SYNC();
                P_(13, ret_mfma_pass1(C)); SYNC();
                P_(5, ret_mfma_cross(C)); SYNC();
                P_(13, ret_mfma_pass2(C)); SYNC();
                P_(14, ret_final(C)); SYNC();
            }
            P_(15, run_gemm(C, MIX, (const h16*)(C.ws + W_OUT), D, MIXW, pg8::EpiRes{C.hsrc, C.hdst, D})); SYNC();
            P_(1, phase_norm(C, C.hdst, IN(I_LNFFN) + layer * D, HN)); SYNC();
            P_(2, run_gemm(C, HN, (const h16*)(C.ws + W_F1), FF, D, pg8::EpiF16<1>{U, FF})); SYNC();
            P_(15, run_gemm(C, U, (const h16*)(C.ws + W_F2), D, FF, pg8::EpiRes{C.hdst, C.hdst, D})); SYNC();
        }
    }
    P_(1, phase_final_norm(C, args.out, IN(I_LNFINAL)));
}

extern "C" void kernel_launch(void* const* d_in, const int* in_sizes, int n_in, void* d_out, int out_size, void* d_ws, size_t ws_size, hipStream_t stream) {
    static int grid = 0;
    if (grid == 0) {
        if (n_in != 32 || ws_size < WS_END) { fprintf(stderr, "kernel_launch: unexpected n_in %d or ws_size %zu (< %zu)\n", n_in, ws_size, (size_t)WS_END); grid = -1; return; }
        int dev = 0, cus = 0, per_cu = 0;
        hipGetDevice(&dev); hipDeviceGetAttribute(&cus, hipDeviceAttributeMultiprocessorCount, dev);
        if (hipFuncSetAttribute((const void*)mega, hipFuncAttributeMaxDynamicSharedMemorySize, LDS_BYTES) != hipSuccess) { fprintf(stderr, "kernel_launch: hipFuncSetAttribute failed\n"); grid = -1; return; }
        if (hipOccupancyMaxActiveBlocksPerMultiprocessor(&per_cu, (const void*)mega, NTHR, LDS_BYTES) != hipSuccess || per_cu < 1) { fprintf(stderr, "kernel_launch: occupancy query says %d\n", per_cu); per_cu = 1; }
        (void)hipGetLastError();
        grid = cus * per_cu;
    }
    if (grid < 0) return;
    if (hipMemsetAsync((char*)d_ws + WS_BAR, 0, XCD_BAR_WORDS * 4, stream) != hipSuccess) { fprintf(stderr, "kernel_launch: memset failed\n"); return; }
    Args a{};
    for (int i = 0; i < 32; ++i) a.in[i] = (const float*)d_in[i];
    a.out = (float*)d_out; a.ws = (unsigned char*)d_ws;
    void* params[] = {&a};
    hipError_t e = hipLaunchCooperativeKernel((const void*)mega, dim3(grid), dim3(NTHR), params, LDS_BYTES, stream);
    if (e != hipSuccess) fprintf(stderr, "kernel_launch: cooperative launch failed: %s (grid %d)\n", hipGetErrorString(e), grid);
}
```

```cpp
#include <hip/hip_runtime.h>
#include <hip/hip_cooperative_groups.h>
#include <cstdio>
#include <cstdint>
namespace cg = cooperative_groups;

#define LAS __attribute__((address_space(3)))
typedef _Float16 h16;
typedef _Float16 h16x8 __attribute__((ext_vector_type(8)));
typedef _Float16 h16x4 __attribute__((ext_vector_type(4)));
typedef float f32x4 __attribute__((ext_vector_type(4)));

constexpr int D = 1024, FF = 4096, MIXW = 1536, MG = 16384;
constexpr int A_IN = 1920, B_IN = 2592, AB_IN = 4512, C_IN = 4096, D_IN = 3072, CD_IN = 7168;
constexpr int LDA_ = 2048, LDB_ = 2816, LDC_ = 4096, LDD_ = 3072;
constexpr int CH_R = 128, CH_M = 256, CH_H = 128, CH_T = 256;
constexpr int SUB = 8;
constexpr int NWAVES = 8, NTHR = 512;
constexpr int LDS_BYTES = 147456;
constexpr size_t MiB = 1u << 20;
constexpr size_t WS_ROT = 0, WS_DEC = 8 * MiB, WS_W = 10 * MiB, WS_HN = 43 * MiB, WS_MIX = 75 * MiB, WS_U = 123 * MiB, WS_ST = 251 * MiB, WS_O = 315 * MiB, WS_BAR = 347 * MiB, WS_END = 348 * MiB;
constexpr size_t W_IN1 = WS_W, W_IN2 = WS_W + 8 * MiB, W_OUT = WS_W + 14 * MiB, W_F1 = WS_W + 17 * MiB, W_F2 = WS_W + 25 * MiB;

struct Args { const float* in[32]; float* out; unsigned char* ws; };
enum { I_XP = 0, I_XS, I_LNMIX, I_LNFFN, I_LNFINAL, I_WOUT, I_W1, I_W2, I_ABW, I_MU, I_W0, I_RW2, I_A0, I_A2, I_G2, I_KK, I_KA, I_RK, I_GNW, I_GNB,
       I_CONVW, I_CONVB, I_DTB, I_ALOG, I_SSMD, I_SSMNW, I_CDW, I_HGLB, I_HGNW, I_RETLD, I_RETGW, I_RETGB };

__device__ __forceinline__ float sigm(float x) { return 1.f / (1.f + __expf(-x)); }
__device__ __forceinline__ float silu(float x) { return x / (1.f + __expf(-x)); }
__device__ __forceinline__ float wave_sum(float v) {
#pragma unroll
    for (int o = 1; o < 64; o <<= 1) v += __shfl_xor(v, o);
    return v;
}
__device__ __forceinline__ float afma(float a, float b, float c) { float r; asm("v_fma_f32 %0, %1, %2, %3" : "=v"(r) : "v"(a), "v"(b), "v"(c)); return r; }
__device__ __forceinline__ float amul(float a, float b) { float r; asm("v_mul_f32 %0, %1, %2" : "=v"(r) : "v"(a), "v"(b)); return r; }
template <int CTRL> __device__ __forceinline__ float dpp_mov(float v) { return __builtin_bit_cast(float, __builtin_amdgcn_update_dpp(0, __builtin_bit_cast(int, v), CTRL, 0xF, 0xF, true)); }
__device__ __forceinline__ float wave_sum_dpp(float v) {
    v += dpp_mov<0xB1>(v); v += dpp_mov<0x4E>(v); v += dpp_mov<0x141>(v); v += dpp_mov<0x140>(v);
    const int b = __builtin_bit_cast(int, v);
    const float r0 = __builtin_bit_cast(float, __builtin_amdgcn_readlane(b, 0)), r1 = __builtin_bit_cast(float, __builtin_amdgcn_readlane(b, 16)), r2 = __builtin_bit_cast(float, __builtin_amdgcn_readlane(b, 32)), r3 = __builtin_bit_cast(float, __builtin_amdgcn_readlane(b, 48));
    return (r0 + r1) + (r2 + r3);
}
#define WAVE_SYNC() do { asm volatile("s_waitcnt lgkmcnt(0)" ::: "memory"); __builtin_amdgcn_wave_barrier(); } while (0)

namespace pg8 {
constexpr int BM = 256, BK = 64, HALF = 128, HTB = HALF * BK * 2, STAGE_BYTES = 8 * HTB, NXCD = 8, WGM = 8;
__host__ __device__ __forceinline__ int lds_byte(int r, int c) { const int st = (r >> 4) * 2 + (c >> 5), rr = r & 15, cc = c & 31, ob = rr * 64 + cc * 2; return st * 1024 + (ob ^ (((ob >> 9) & 1) << 5)); }
__host__ __device__ __forceinline__ void stage_rc(int b, int& R, int& C) { const int st = b / 1024, sb = b % 1024, swz = sb ^ (((sb >> 9) & 1) << 5); R = (st >> 1) * 16 + swz / 64; C = (st & 1) * 32 + (swz % 64) / 2; }
__host__ __device__ __forceinline__ int perm32(int rho) { const int n = rho >> 4, i = rho & 15; return 8 * (i >> 2) + 4 * n + (i & 3); }
struct Unit { int pm, pn; };
struct Gemm { const h16* A; const h16* Bt; int M, N, K; };
struct StaticOrder {
    int nM, nN, nwg, G, c;
    __device__ void init(int M, int N, int G_, int c_) { nM = M / BM; nN = N / BM; nwg = nM * nN; G = G_; c = c_; }
    __device__ bool next(int i, Unit& u) const {
        const long L = (long)i * G + c; if (L >= nwg) return false;
        int wgid = (int)L; { const int q = nwg / NXCD, r = nwg % NXCD, xcd = wgid % NXCD, off = wgid / NXCD; wgid = (xcd < r ? xcd * (q + 1) : r * (q + 1) + (xcd - r) * q) + off; }
        const int nig = WGM * nN, gid = wgid / nig, fm = gid * WGM, gsz = (nM - fm) < WGM ? (nM - fm) : WGM;
        u.pm = fm + ((wgid % nig) % gsz); u.pn = (wgid % nig) / gsz; return true;
    }
};
template <int ACT> struct EpiF16 {
    h16* O; int ldc;
    __device__ __forceinline__ void operator()(const f32x4 (&acc)[2][2][4][2], const Unit& u, int wr, int wc, int fr, int fq) const {
        const int row0 = u.pm * BM + wr * 64 + fr; const int col0 = u.pn * BM + wc * 32 + 8 * fq;
#pragma unroll
        for (int ai = 0; ai < 2; ++ai)
#pragma unroll
            for (int m = 0; m < 4; ++m) { h16* rowp = O + (size_t)(row0 + ai * HALF + m * 16) * ldc + col0;
#pragma unroll
                for (int bj = 0; bj < 2; ++bj) { f32x4 v0 = acc[ai][bj][m][0], v1 = acc[ai][bj][m][1];
                    if (ACT == 1) {
#pragma unroll
                        for (int e = 0; e < 4; ++e) { float a = fmaxf(v0[e], 0.f), b = fmaxf(v1[e], 0.f); v0[e] = a * a; v1[e] = b * b; } }
                    h16x8 w; w[0] = (h16)v0[0]; w[1] = (h16)v0[1]; w[2] = (h16)v0[2]; w[3] = (h16)v0[3]; w[4] = (h16)v1[0]; w[5] = (h16)v1[1]; w[6] = (h16)v1[2]; w[7] = (h16)v1[3];
                    *(h16x8*)(rowp + bj * HALF) = w; } }
    }
};
struct EpiRes {
    const float* src; float* dst; int ldc;
    __device__ __forceinline__ void operator()(const f32x4 (&acc)[2][2][4][2], const Unit& u, int wr, int wc, int fr, int fq) const {
        const int row0 = u.pm * BM + wr * 64 + fr; const int col0 = u.pn * BM + wc * 32 + 8 * fq;
#pragma unroll
        for (int ai = 0; ai < 2; ++ai)
#pragma unroll
            for (int m = 0; m < 4; ++m) { const size_t off = (size_t)(row0 + ai * HALF + m * 16) * ldc + col0;
#pragma unroll
                for (int bj = 0; bj < 2; ++bj) {
                    const f32x4 s0 = *(const f32x4*)(src + off + bj * HALF), s1 = *(const f32x4*)(src + off + bj * HALF + 4);
                    *(f32x4*)(dst + off + bj * HALF) = s0 + acc[ai][bj][m][0]; *(f32x4*)(dst + off + bj * HALF + 4) = s1 + acc[ai][bj][m][1]; } }
    }
};

template <class Epi, class Sched>
__device__ __forceinline__ void gemm_phase(LAS unsigned char* lds, const Gemm g, const Sched& S, const Epi& E, const int tid) {
    const int wid = __builtin_amdgcn_readfirstlane(tid >> 6), lane = tid & 63, wr = wid >> 2, wc = wid & 3, fr = lane & 15, fq = lane >> 4;
    const int K = g.K, nt = K / BK;
    unsigned voffA[2], voffB[2];
#pragma unroll
    for (int i = 0; i < 2; ++i) { int R, C; stage_rc(tid * 16 + i * 8192, R, C); const int Rb = (R & ~31) + perm32(R & 31);
        voffA[i] = (unsigned)(R * K + C) * 2u; voffB[i] = (unsigned)(Rb * K + C) * 2u; }
    const size_t kstep = (size_t)(BK * 2);
    const size_t hstep = (size_t)HALF * K * 2;
    const size_t tstep = 2 * hstep;
    const unsigned ldsw = (unsigned)wid * 1024u;
    const int aoff = lds_byte(wr * 64 + fr, fq * 8), boff = lds_byte(wc * 32 + fr, fq * 8);
#define PG8_SA(b, h) (((b) * 2 + (h)) * HTB)
#define PG8_SB(b, h) ((4 + (b) * 2 + (h)) * HTB)
#define PG8_STAGE(bufoff, gbase, voff) do { _Pragma("unroll") for (int _i = 0; _i < 2; ++_i) \
        __builtin_amdgcn_global_load_lds((const unsigned*)((const char*)(gbase) + (voff)[_i]), (LAS unsigned*)(lds + (bufoff) + ldsw + _i * 8192), 16, 0, 0); } while (0)
#define PG8_LDA(dst, b, h) do { _Pragma("unroll") for (int m = 0; m < 4; ++m) _Pragma("unroll") for (int k = 0; k < 2; ++k) dst[m][k] = *(const LAS h16x8*)(lds + PG8_SA(b, h) + aoff + m * 2048 + k * 1024); } while (0)
#define PG8_LDB(dst, b, h) do { _Pragma("unroll") for (int n = 0; n < 2; ++n) _Pragma("unroll") for (int k = 0; k < 2; ++k) dst[n][k] = *(const LAS h16x8*)(lds + PG8_SB(b, h) + boff + n * 2048 + k * 1024); } while (0)
#define PG8_MMA(ai, bj, At, Bt) do { __builtin_amdgcn_s_setprio(1); _Pragma("unroll") for (int m = 0; m < 4; ++m) _Pragma("unroll") for (int n = 0; n < 2; ++n) _Pragma("unroll") for (int k = 0; k < 2; ++k) \
        acc[ai][bj][m][n] = __builtin_amdgcn_mfma_f32_16x16x32_f16(Bt[n][k], At[m][k], acc[ai][bj][m][n], 0, 0, 0); __builtin_amdgcn_s_setprio(0); } while (0)
#define PG8_WAIT_V(n) asm volatile("s_waitcnt vmcnt(" #n ")" ::: "memory")
#define PG8_WAIT_L(n) asm volatile("s_waitcnt lgkmcnt(" #n ")" ::: "memory")
#define PG8_BAR __builtin_amdgcn_s_barrier()
#define PG8_SCHED __builtin_amdgcn_sched_barrier(0)
    Unit cur, nxt; int ui = 0;
    if (!S.next(0, cur)) return;
    f32x4 acc[2][2][4][2];
#pragma unroll
    for (int a = 0; a < 2; ++a)
#pragma unroll
        for (int b = 0; b < 2; ++b)
#pragma unroll
            for (int m = 0; m < 4; ++m)
#pragma unroll
                for (int n = 0; n < 2; ++n) acc[a][b][m][n] = (f32x4){0.f, 0.f, 0.f, 0.f};
    h16x8 At[4][2], B0[2][2], B1[2][2];
    const char* cA = (const char*)g.A + (size_t)cur.pm * tstep; const char* cB = (const char*)g.Bt + (size_t)cur.pn * tstep;
    PG8_STAGE(PG8_SB(0, 0), cB, voffB); PG8_STAGE(PG8_SB(0, 1), cB + hstep, voffB); PG8_STAGE(PG8_SA(0, 0), cA, voffA); PG8_STAGE(PG8_SA(0, 1), cA + hstep, voffA);
    if (wr == 1) PG8_BAR;
    PG8_WAIT_V(2); PG8_BAR;
    PG8_STAGE(PG8_SB(1, 0), cB + kstep, voffB); PG8_STAGE(PG8_SA(1, 0), cA + kstep, voffA); PG8_STAGE(PG8_SB(1, 1), cB + hstep + kstep, voffB);
    PG8_WAIT_V(6); PG8_BAR;
    for (;;) {
        const bool has_next = S.next(ui + 1, nxt);
        const char* nA = has_next ? (const char*)g.A + (size_t)nxt.pm * tstep : cA; const char* nB = has_next ? (const char*)g.Bt + (size_t)nxt.pn * tstep : cB;
        for (int t = 0; t < nt; t += 2) {
            const bool last = (t == nt - 2);
            const char* a1 = cA + (size_t)(t + 1) * kstep;
            const char* a2 = last ? nA : cA + (size_t)(t + 2) * kstep; const char* b2 = last ? nB : cB + (size_t)(t + 2) * kstep;
            const char* a3 = a2 + kstep; const char* b3 = b2 + kstep;
            PG8_LDB(B0, 0, 0); PG8_LDB(B1, 0, 1); PG8_SCHED; PG8_LDA(At, 0, 0); PG8_STAGE(PG8_SA(1, 1), a1 + hstep, voffA);
            PG8_WAIT_V(8); PG8_WAIT_L(0); PG8_BAR; PG8_MMA(0, 0, At, B0); PG8_MMA(0, 1, At, B1); PG8_BAR; PG8_SCHED;
            PG8_LDA(At, 0, 1); PG8_STAGE(PG8_SB(0, 0), b2, voffB); PG8_STAGE(PG8_SB(0, 1), b2 + hstep, voffB); PG8_STAGE(PG8_SA(0, 0), a2, voffA);
            PG8_WAIT_V(8); PG8_WAIT_L(0); PG8_BAR; PG8_MMA(1, 0, At, B0); PG8_MMA(1, 1, At, B1); PG8_BAR; PG8_SCHED;
            PG8_LDB(B0, 1, 0); PG8_LDB(B1, 1, 1); PG8_SCHED; PG8_LDA(At, 1, 0); PG8_STAGE(PG8_SA(0, 1), a2 + hstep, voffA);
            PG8_WAIT_V(8); PG8_WAIT_L(0); PG8_BAR; PG8_MMA(0, 0, At, B0); PG8_MMA(0, 1, At, B1); PG8_BAR; PG8_SCHED;
            PG8_LDA(At, 1, 1); PG8_STAGE(PG8_SB(1, 0), b3, voffB); PG8_STAGE(PG8_SB(1, 1), b3 + hstep, voffB); PG8_STAGE(PG8_SA(1, 0), a3, voffA);
            PG8_WAIT_V(8); PG8_WAIT_L(0); PG8_BAR; PG8_MMA(1, 0, At, B0); PG8_MMA(1, 1, At, B1); PG8_BAR; PG8_SCHED;
        }
        if (wr == 0) PG8_BAR;
        E(acc, cur, wr, wc, fr, fq);
        if (!has_next) break;
#pragma unroll
        for (int a = 0; a < 2; ++a)
#pragma unroll
            for (int b = 0; b < 2; ++b)
#pragma unroll
                for (int m = 0; m < 4; ++m)
#pragma unroll
                    for (int n = 0; n < 2; ++n) acc[a][b][m][n] = (f32x4){0.f, 0.f, 0.f, 0.f};
        cur = nxt; cA = nA; cB = nB; ++ui;
        if (wr == 1) PG8_BAR;
    }
    PG8_WAIT_V(0);
    PG8_BAR;
#undef PG8_SA
#undef PG8_SB
#undef PG8_STAGE
#undef PG8_LDA
#undef PG8_LDB
#undef PG8_MMA
#undef PG8_WAIT_V
#undef PG8_WAIT_L
#undef PG8_BAR
#undef PG8_SCHED
}
}


#define XB_TMO      128
#define XB_XCNT(j)  (256  + 64 * (j))
#define XB_XSUB(j)  (1280 + 64 * (j))
#define XB_XGEN(j)  (2304 + 64 * (j))
#define XB_TOP      3328
#define XB_TOPGEN   3392
#define XCD_BAR_WORDS 3456
#define XB_SPIN_CAP (1u << 22)
__device__ __forceinline__ unsigned xb_ld(unsigned* p)              { return __hip_atomic_load(p, __ATOMIC_RELAXED, __HIP_MEMORY_SCOPE_AGENT); }
__device__ __forceinline__ unsigned xb_add(unsigned* p, unsigned v) { return __hip_atomic_fetch_add(p, v, __ATOMIC_RELAXED, __HIP_MEMORY_SCOPE_AGENT); }
__device__ __forceinline__ unsigned xb_xcc_id() { return (unsigned)__builtin_amdgcn_s_getreg((3 << 11) | 20) & 0xFu; }
#define XB_SPIN(cond, bar) do { unsigned _sp = 0; while (cond) { __builtin_amdgcn_s_sleep(1); \
    if ((++_sp & 255u) == 0u) { if (xb_ld(&(bar)[XB_TMO])) break; if (_sp > XB_SPIN_CAP) { atomicAdd(&(bar)[XB_TMO], 1u); break; } } } } while (0)
struct XcdBarrier { unsigned* bar; unsigned x; volatile LAS unsigned* st; };
__device__ __forceinline__ XcdBarrier xcd_barrier_post(unsigned* bar, volatile LAS unsigned* st) {
    XcdBarrier b; b.bar = bar; b.x = xb_xcc_id(); b.st = st;
    if (threadIdx.x == 0) (void)xb_add(&bar[XB_XCNT(b.x)], 1u);
    return b;
}
__device__ __forceinline__ void xcd_barrier_complete(unsigned* bar, unsigned x, unsigned& nloc, unsigned& nx) {
    const unsigned G = gridDim.x * gridDim.y * gridDim.z;
    unsigned sum, cnt, mine, sp = 0u;
    for (;;) {
        sum = 0u; cnt = 0u; mine = 0u;
#pragma unroll
        for (unsigned j = 0; j < 16; ++j) { const unsigned c = xb_ld(&bar[XB_XCNT(j)]); sum += c; cnt += (c > 0u) ? 1u : 0u; mine = (j == x) ? c : mine; }
        if (sum == G) break;
        __builtin_amdgcn_s_sleep(1);
        if ((++sp & 255u) == 0u) { if (xb_ld(&bar[XB_TMO])) break; if (sp > XB_SPIN_CAP) { atomicAdd(&bar[XB_TMO], 1u); break; } }
    }
    nloc = mine > 0u ? mine : 1u; nx = cnt > 0u ? cnt : 1u;
}
__device__ __forceinline__ void xcd_barrier(const XcdBarrier& b) {
    asm volatile("s_waitcnt vmcnt(0)" ::: "memory");
    __syncthreads();
    if (threadIdx.x == 0) {
        unsigned* bar = b.bar;
        __builtin_amdgcn_s_waitcnt(0);
        unsigned nloc = b.st[0], nx = b.st[1];
        if (nloc == 0u) { xcd_barrier_complete(bar, b.x, nloc, nx); b.st[0] = nloc; b.st[1] = nx; }
        const unsigned old = xb_add(&bar[XB_XSUB(b.x)], 1u);
        const unsigned gen = old / nloc;
        if (old + 1u == (gen + 1u) * nloc) {
            __builtin_amdgcn_fence(__ATOMIC_RELEASE, "agent");
            asm volatile("s_waitcnt vmcnt(0)" ::: "memory");
            const unsigned og = xb_add(&bar[XB_TOP], 1u);
            const unsigned tg = og / nx;
            if (og + 1u == (tg + 1u) * nx) xb_add(&bar[XB_TOPGEN], 1u);
            else XB_SPIN(xb_ld(&bar[XB_TOPGEN]) == tg, bar);
            __builtin_amdgcn_fence(__ATOMIC_ACQUIRE, "agent");
            xb_add(&bar[XB_XGEN(b.x)], 1u);
            asm volatile("s_waitcnt vmcnt(0)" ::: "memory");
        } else {
            XB_SPIN(xb_ld(&bar[XB_XGEN(b.x)]) == gen, bar);
            __builtin_amdgcn_fence(__ATOMIC_ACQUIRE, "agent");
            asm volatile("s_waitcnt vmcnt(0)" ::: "memory");
        }
    }
    __syncthreads();
}

struct Ctx {
    const float* in[32]; LAS unsigned char* lds; int tid, lane, wave, gw, ngw, gtid, ngt;
    int layer, j, grp, nseq, T;
    const float* hsrc; float* hdst;
    unsigned char* ws;
};
#define IN(k) (C.in[k])

__device__ __forceinline__ void transpose_item(const float* W, int ldw, int c0, int nvalid, int K, int Npad, h16* WT, LAS float* scr, int item, int lane) {
    const int nblk = Npad / 32, kb = item / nblk, nb = item % nblk, k0 = 64 * kb, n0 = 32 * nb;
    const int n = n0 + (lane & 31);
#pragma unroll 8
    for (int i = 0; i < 32; ++i) { const int kk = 2 * i + (lane >> 5); scr[kk * 33 + (lane & 31)] = (n < nvalid) ? W[(size_t)(k0 + kk) * ldw + c0 + n] : 0.f; }
    WAVE_SYNC();
    const int c = lane & 7;
#pragma unroll
    for (int jj = 0; jj < 4; ++jj) { const int nn = (lane >> 3) + 8 * jj; const LAS float* s = scr + (8 * c) * 33 + nn;
        h16x8 o;
#pragma unroll
        for (int e = 0; e < 8; ++e) o[e] = (h16)s[e * 33];
        *(h16x8*)(WT + (size_t)(n0 + nn) * K + k0 + 8 * c) = o; }
    WAVE_SYNC();
}
__device__ __forceinline__ void phase_weights(Ctx& C) {
    LAS float* scr = (LAS float*)(C.lds + C.wave * 12288);
    const int layer = C.layer, j = C.j;
    const bool ab = (layer & 1) == 0;
    const float* Win = ab ? IN(I_ABW) + (size_t)j * D * AB_IN : IN(I_CDW) + (size_t)j * D * CD_IN;
    const int ldw = ab ? AB_IN : CD_IN;
    const int n1 = ab ? A_IN : C_IN, n1p = ab ? LDA_ : LDC_, n2 = ab ? B_IN : D_IN, n2p = ab ? LDB_ : LDD_;
    const int it1 = (D / 64) * (n1p / 32), it2 = (D / 64) * (n2p / 32), it3 = (MIXW / 64) * (D / 32), it4 = (D / 64) * (FF / 32), it5 = (FF / 64) * (D / 32);
    const int total = it1 + it2 + it3 + it4 + it5;
    for (int it = C.gw; it < total; it += C.ngw) {
        int r = it;
        if (r < it1) { transpose_item(Win, ldw, 0, n1, D, n1p, (h16*)(C.ws + W_IN1), scr, r, C.lane); continue; } r -= it1;
        if (r < it2) { transpose_item(Win, ldw, n1, n2, D, n2p, (h16*)(C.ws + W_IN2), scr, r, C.lane); continue; } r -= it2;
        if (r < it3) { transpose_item(IN(I_WOUT) + (size_t)layer * MIXW * D, D, 0, D, MIXW, D, (h16*)(C.ws + W_OUT), scr, r, C.lane); continue; } r -= it3;
        if (r < it4) { transpose_item(IN(I_W1) + (size_t)layer * D * FF, FF, 0, FF, D, FF, (h16*)(C.ws + W_F1), scr, r, C.lane); continue; } r -= it4;
        transpose_item(IN(I_W2) + (size_t)layer * FF * D, D, 0, D, FF, D, (h16*)(C.ws + W_F2), scr, r, C.lane);
    }
    if (layer == 0) {
        float* rot = (float*)(C.ws + WS_ROT);
        for (int idx = C.gtid; idx < 16384 * 64; idx += C.ngt) { const int t = idx >> 6, i = idx & 63;
            const float invf = exp2f(-(float)i * (13.287712379549449f / 64.f)); const float ang = (float)t * invf;
            rot[t * 128 + i] = cosf(ang); rot[t * 128 + 64 + i] = sinf(ang); }
    }
}
__device__ __forceinline__ void phase_norm(Ctx& C, const float* src, const float* gain, h16* dst) {
    const f32x4 g0 = ((const f32x4*)gain)[C.lane], g1 = ((const f32x4*)gain)[64 + C.lane], g2 = ((const f32x4*)gain)[128 + C.lane], g3 = ((const f32x4*)gain)[192 + C.lane];
    for (int m = C.gw; m < MG; m += C.ngw) {
        const f32x4* xr = (const f32x4*)(src + (size_t)m * D) + C.lane;
        f32x4 v[4]; float s = 0.f;
#pragma unroll
        for (int q = 0; q < 4; ++q) { v[q] = xr[64 * q]; s += (v[q].x * v[q].x + v[q].y * v[q].y) + (v[q].z * v[q].z + v[q].w * v[q].w); }
        const float rstd = rsqrtf(wave_sum(s) * (1.f / D) + 1e-5f);
        v[0] = v[0] * g0 * rstd; v[1] = v[1] * g1 * rstd; v[2] = v[2] * g2 * rstd; v[3] = v[3] * g3 * rstd;
        h16x4* o = (h16x4*)(dst + (size_t)m * D) + C.lane;
#pragma unroll
        for (int q = 0; q < 4; ++q) { h16x4 w; w[0] = (h16)v[q].x; w[1] = (h16)v[q].y; w[2] = (h16)v[q].z; w[3] = (h16)v[q].w; o[64 * q] = w; }
    }
}
__device__ __forceinline__ void phase_final_norm(Ctx& C, float* io, const float* gain) {
    const f32x4 g0 = ((const f32x4*)gain)[C.lane], g1 = ((const f32x4*)gain)[64 + C.lane], g2 = ((const f32x4*)gain)[128 + C.lane], g3 = ((const f32x4*)gain)[192 + C.lane];
    for (int m = C.gw; m < 2 * MG; m += C.ngw) {
        f32x4* xr = (f32x4*)(io + (size_t)m * D) + C.lane;
        f32x4 v[4]; float s = 0.f;
#pragma unroll
        for (int q = 0; q < 4; ++q) { v[q] = xr[64 * q]; s += (v[q].x * v[q].x + v[q].y * v[q].y) + (v[q].z * v[q].z + v[q].w * v[q].w); }
        const float rstd = rsqrtf(wave_sum(s) * (1.f / D) + 1e-5f);
        xr[0] = v[0] * g0 * rstd; xr[64] = v[1] * g1 * rstd; xr[128] = v[2] * g2 * rstd; xr[192] = v[3] * g3 * rstd;
    }
}

template <int KS, int MODE, int NT>
__device__ __forceinline__ void rwkv_lora(Ctx& C, int col0, const float* Wl, const float* bias, h16* outp, int ldo, int noff) {
    const int lane = C.lane, fr = lane & 15, fq = lane >> 4, w = C.wave, T = C.T;
    const h16* U = (const h16*)(C.ws + WS_U);
    const float* mu0p = IN(I_MU) + (size_t)C.j * 2 * A_IN, *mu1p = mu0p + A_IN;
    h16x8 bf[NT][KS];
#pragma unroll
    for (int nt = 0; nt < NT; ++nt)
#pragma unroll
        for (int ks = 0; ks < KS; ++ks)
#pragma unroll
            for (int e = 0; e < 8; ++e) bf[nt][ks][e] = (h16)Wl[(size_t)(ks * 32 + fq * 8 + e) * 512 + w * 64 + noff + nt * 16 + fr];
    float bv[NT];
#pragma unroll
    for (int nt = 0; nt < NT; ++nt) bv[nt] = bias ? bias[w * 64 + noff + nt * 16 + fr] : 0.f;
    for (int tile = blockIdx.x; tile < MG / 16; tile += gridDim.x) {
        f32x4 acc[NT];
#pragma unroll
        for (int nt = 0; nt < NT; ++nt) acc[nt] = (f32x4){0.f, 0.f, 0.f, 0.f};
        const int tok = tile * 16 + fr, t = tok % T;
#pragma unroll
        for (int ks = 0; ks < KS; ++ks) {
            const int c = col0 + ks * 32 + fq * 8;
            const h16* up = U + (size_t)tok * LDA_ + c;
            const h16x8 cur = *(const h16x8*)up;
            h16x8 prv, nxt;
#pragma unroll
            for (int e = 0; e < 8; ++e) { prv[e] = (h16)0.f; nxt[e] = (h16)0.f; }
            if (t > 0) prv = *(const h16x8*)(up - LDA_);
            if (t < T - 1) nxt = *(const h16x8*)(up + LDA_);
            h16x8 af;
#pragma unroll
            for (int e = 0; e < 8; ++e) { const float x = (float)cur[e]; float y = x + mu0p[c + e] * ((float)prv[e] - x) + mu1p[c + e] * ((float)nxt[e] - x);
                if (MODE == 0) y = tanhf(y); else if (MODE == 2) y = sigm(y);
                af[e] = (h16)y; }
#pragma unroll
            for (int nt = 0; nt < NT; ++nt) acc[nt] = __builtin_amdgcn_mfma_f32_16x16x32_f16(af, bf[nt][ks], acc[nt], 0, 0, 0);
        }
#pragma unroll
        for (int nt = 0; nt < NT; ++nt)
#pragma unroll
            for (int e = 0; e < 4; ++e) { const int otok = tile * 16 + fq * 4 + e, n = w * 64 + noff + nt * 16 + fr; float y = acc[nt][e] + bv[nt];
                if (MODE == 0) y = sigm(y) * 0.6065306597126334f; else if (MODE == 1) y = sigm(y);
                outp[(size_t)otok * ldo + n] = (h16)y; }
    }
}
__device__ __forceinline__ void rwkv_pre(Ctx& C) {
    h16* U2 = (h16*)(C.ws + WS_U + 64 * MiB); h16* G = (h16*)(C.ws + WS_MIX) + 512;
    const int j = C.j;
    for (int d = 0; d < 2; ++d) {
        rwkv_lora<2, 0, 4>(C, 1536 + 64 * d, IN(I_RW2) + (size_t)(j * 2 + d) * 64 * 512, IN(I_W0) + (size_t)(j * 2 + d) * 512, U2 + d * 1024, 2048, 0);
        rwkv_lora<2, 1, 4>(C, 1664 + 64 * d, IN(I_A2) + (size_t)(j * 2 + d) * 64 * 512, IN(I_A0) + (size_t)(j * 2 + d) * 512, U2 + d * 1024 + 512, 2048, 0);
    }
    for (int hf = 0; hf < 2; ++hf) rwkv_lora<4, 2, 2>(C, 1792, IN(I_G2) + (size_t)j * 128 * 512, nullptr, G, MIXW, hf * 32);
}
template <int PASS>
__device__ __forceinline__ void rwkv_scan(Ctx& C) {
    const int lane = C.lane, T = C.T, NC = T / CH_R, j = C.j;
    const int nunits = C.nseq * 2 * NC * 8;
    const h16* U = (const h16*)(C.ws + WS_U); const h16* U2 = (const h16*)(C.ws + WS_U + 64 * MiB);
    LAS float* wl = (LAS float*)(C.lds + C.wave * 12288);
    const float* mu0p = IN(I_MU) + (size_t)j * 2 * A_IN, *mu1p = mu0p + A_IN;
    for (int unit = C.gw; unit < nunits; unit += C.ngw) {
        const int hd = unit & 7; int r = unit >> 3; const int c = r % NC; r /= NC; const int dir = r & 1, b = r >> 1;
        const int col = hd * 64 + lane;
        const float m0r = mu0p[col], m1r = mu1p[col], m0k = mu0p[512 + col], m1k = mu1p[512 + col], m0v = mu0p[1024 + col], m1v = mu1p[1024 + col];
        const float kkw = IN(I_KK)[j * 512 + col], kaw = IN(I_KA)[j * 512 + col];
        float* slot = (float*)(C.ws + WS_ST) + (size_t)((((b * 2 + dir) * NC + c) * 8) + hd) * 8192;
        float S[64], P[64];
        if (PASS == 1) {
            int ln = lane; asm volatile("" : "+v"(ln));
#pragma unroll
            for (int q = 0; q < 64; ++q) { S[q] = 0.f; P[q] = (q == ln) ? 1.f : 0.f; }
        } else {
#pragma unroll
            for (int q = 0; q < 16; ++q) { const f32x4 v = *(const f32x4*)(slot + lane * 64 + q * 4); S[4 * q] = v.x; S[4 * q + 1] = v.y; S[4 * q + 2] = v.z; S[4 * q + 3] = v.w; }
        }
        h16* outp = (dir == 0) ? (h16*)(C.ws + WS_MIX) : (h16*)(C.ws + WS_O);
        const int ldo = (dir == 0) ? MIXW : 512;
#pragma unroll 1
        for (int sub = 0; sub < CH_R / SUB; ++sub) {
            {
                const int pbase = c * CH_R + sub * SUB;
                float Rr[SUB + 2], Rk[SUB + 2], Rv[SUB + 2], Ee[SUB], Aa[SUB];
#pragma unroll
                for (int i = 0; i < SUB + 2; ++i) { const int p = pbase - 1 + i; const bool ok = (p >= 0) && (p < T); const int t = dir ? T - 1 - p : p;
                    const h16* ur = U + ((size_t)b * T + (ok ? t : 0)) * LDA_ + col;
                    const float a0 = (float)ur[0], a1 = (float)ur[512], a2 = (float)ur[1024];
                    Rr[i] = ok ? a0 : 0.f; Rk[i] = ok ? a1 : 0.f; Rv[i] = ok ? a2 : 0.f; }
#pragma unroll
                for (int s2 = 0; s2 < SUB; ++s2) { const int p = pbase + s2, t = dir ? T - 1 - p : p; const size_t tok = (size_t)b * T + t;
                    Ee[s2] = (float)U2[tok * 2048 + dir * 1024 + col]; Aa[s2] = (float)U2[tok * 2048 + dir * 1024 + 512 + col]; }
#pragma unroll
                for (int s2 = 0; s2 < SUB; ++s2) {
                    const float rc = Rr[s2 + 1], kc = Rk[s2 + 1], vc = Rv[s2 + 1];
                    const float rp = dir ? Rr[s2 + 2] : Rr[s2], rn = dir ? Rr[s2] : Rr[s2 + 2];
                    const float kp = dir ? Rk[s2 + 2] : Rk[s2], kn = dir ? Rk[s2] : Rk[s2 + 2];
                    const float vp = dir ? Rv[s2 + 2] : Rv[s2], vn = dir ? Rv[s2] : Rv[s2 + 2];
                    const float rr = rc + m0r * (rp - rc) + m1r * (rn - rc), kk_ = kc + m0k * (kp - kc) + m1k * (kn - kc), vv = vc + m0v * (vp - vc) + m1v * (vn - vc);
                    const float av = Aa[s2]; const float wdec = __expf(-Ee[s2]);
                    const float kx = kk_ * kkw; const float n2 = wave_sum_dpp(kx * kx); const float kkn = kx * rsqrtf(fmaxf(n2, 1e-24f));
                    LAS float* q = wl + s2 * 384;
                    q[lane] = wdec; q[64 + lane] = kkn; q[128 + lane] = kkn * av; q[192 + lane] = kk_ * (1.f + (av - 1.f) * kaw); q[256 + lane] = rr; q[320 + lane] = vv;
                }
            }
            WAVE_SYNC();
#pragma unroll 1
            for (int s = 0; s < SUB; ++s) {
                const LAS f32x4* q = (const LAS f32x4*)(wl + s * 384);
                const float vv = wl[s * 384 + 320 + lane];
                float sa0 = 0.f, sa1 = 0.f, sa2 = 0.f, sa3 = 0.f, sp0 = 0.f, sp1 = 0.f, sp2 = 0.f, sp3 = 0.f;
#define SB_ __builtin_amdgcn_sched_barrier(0)
                f32x4 nk[4];
#pragma unroll
                for (int u = 0; u < 4; ++u) nk[u] = q[16 + u];
                SB_;
#pragma unroll
                for (int g = 0; g < 4; ++g) {
                    f32x4 ck[4];
#pragma unroll
                    for (int u = 0; u < 4; ++u) ck[u] = nk[u];
                    if (g < 3) {
#pragma unroll
                        for (int u = 0; u < 4; ++u) nk[u] = q[16 + 4 * (g + 1) + u]; }
                    SB_;
#pragma unroll
                    for (int u = 0; u < 4; ++u) { const int k4 = 4 * g + u; const f32x4 kk4 = ck[u];
                        sa0 = afma(S[4 * k4], kk4.x, sa0); sa1 = afma(S[4 * k4 + 1], kk4.y, sa1); sa2 = afma(S[4 * k4 + 2], kk4.z, sa2); sa3 = afma(S[4 * k4 + 3], kk4.w, sa3);
                        if (PASS == 1) { sp0 = afma(P[4 * k4], kk4.x, sp0); sp1 = afma(P[4 * k4 + 1], kk4.y, sp1); sp2 = afma(P[4 * k4 + 2], kk4.z, sp2); sp3 = afma(P[4 * k4 + 3], kk4.w, sp3); } }
                    SB_;
                }
                const float sa = -((sa0 + sa1) + (sa2 + sa3)), sp = -((sp0 + sp1) + (sp2 + sp3));
                float o0 = 0.f, o1 = 0.f, o2 = 0.f, o3 = 0.f, o4 = 0.f, o5 = 0.f, o6 = 0.f, o7 = 0.f;
                constexpr int NV = (PASS == 2) ? 4 : 3;
                f32x4 nv[2][NV];
#pragma unroll
                for (int u = 0; u < 2; ++u) { nv[u][0] = q[u]; nv[u][1] = q[32 + u]; nv[u][2] = q[48 + u]; if (PASS == 2) nv[u][NV - 1] = q[64 + u]; }
                SB_;
#pragma unroll
                for (int g = 0; g < 8; ++g) {
                    f32x4 cv[2][NV];
#pragma unroll
                    for (int u = 0; u < 2; ++u)
#pragma unroll
                        for (int e = 0; e < NV; ++e) cv[u][e] = nv[u][e];
                    if (g < 7) {
#pragma unroll
                        for (int u = 0; u < 2; ++u) { const int k4n = 2 * (g + 1) + u; nv[u][0] = q[k4n]; nv[u][1] = q[32 + k4n]; nv[u][2] = q[48 + k4n]; if (PASS == 2) nv[u][NV - 1] = q[64 + k4n]; } }
                    SB_;
                    {
                        const int kb = 8 * g;
                        const float wv[8] = {cv[0][0].x, cv[0][0].y, cv[0][0].z, cv[0][0].w, cv[1][0].x, cv[1][0].y, cv[1][0].z, cv[1][0].w};
                        const float bv8[8] = {cv[0][1].x, cv[0][1].y, cv[0][1].z, cv[0][1].w, cv[1][1].x, cv[1][1].y, cv[1][1].z, cv[1][1].w};
                        const float dv[8] = {cv[0][2].x, cv[0][2].y, cv[0][2].z, cv[0][2].w, cv[1][2].x, cv[1][2].y, cv[1][2].z, cv[1][2].w};
                        float t1[8], t2[8];
#pragma unroll
                        for (int e = 0; e < 8; ++e) t1[e] = amul(sa, bv8[e]);
                        if (PASS == 1) {
#pragma unroll
                            for (int e = 0; e < 8; ++e) t2[e] = amul(sp, bv8[e]); }
#pragma unroll
                        for (int e = 0; e < 8; ++e) t1[e] = afma(vv, dv[e], t1[e]);
                        if (PASS == 1) {
#pragma unroll
                            for (int e = 0; e < 8; ++e) P[kb + e] = afma(P[kb + e], wv[e], t2[e]); }
#pragma unroll
                        for (int e = 0; e < 8; ++e) S[kb + e] = afma(S[kb + e], wv[e], t1[e]);
                        if (PASS == 2) { const f32x4 ra = cv[0][NV - 1], rb = cv[1][NV - 1];
                            o0 = afma(S[kb], ra.x, o0); o1 = afma(S[kb + 1], ra.y, o1); o2 = afma(S[kb + 2], ra.z, o2); o3 = afma(S[kb + 3], ra.w, o3);
                            o4 = afma(S[kb + 4], rb.x, o4); o5 = afma(S[kb + 5], rb.y, o5); o6 = afma(S[kb + 6], rb.z, o6); o7 = afma(S[kb + 7], rb.w, o7); }
                    }
                    SB_;
                }
#undef SB_
                if (PASS == 2) { const int p = c * CH_R + sub * SUB + s, t = dir ? T - 1 - p : p; outp[((size_t)b * T + t) * ldo + col] = (h16)(((o0 + o1) + (o2 + o3)) + ((o4 + o5) + (o6 + o7))); }
            }
            WAVE_SYNC();
        }
        if (PASS == 1) {
#pragma unroll
            for (int q = 0; q < 16; ++q) { *(f32x4*)(slot + lane * 64 + q * 4) = (f32x4){S[4 * q], S[4 * q + 1], S[4 * q + 2], S[4 * q + 3]};
                *(f32x4*)(slot + 4096 + lane * 64 + q * 4) = (f32x4){P[4 * q], P[4 * q + 1], P[4 * q + 2], P[4 * q + 3]}; }
        }
    }
}
__device__ __forceinline__ void rwkv_cross(Ctx& C) {
    const int T = C.T, NC = T / CH_R, nunits = C.nseq * 16 * 8, tid = C.tid;
    LAS float* Cs = (LAS float*)C.lds; LAS float* Ps = Cs + 512;
    const int il = tid >> 6, jc = tid & 63;
    for (int unit = blockIdx.x; unit < nunits; unit += gridDim.x) {
        const int chain = unit >> 3, rg = unit & 7, hd = chain & 7, dir = (chain >> 3) & 1, b = chain >> 4;
        const int i = rg * 8 + il;
        float* base = (float*)(C.ws + WS_ST) + (size_t)((((b * 2 + dir) * NC) * 8) + hd) * 8192;
        float cr = 0.f;
        f32x4 p0 = *(const f32x4*)(base + 4096 + tid * 8), p1 = *(const f32x4*)(base + 4096 + tid * 8 + 4); float sl = base[i * 64 + jc];
        __syncthreads();
        for (int c = 0; c < NC; ++c) {
            float* cb = base + (size_t)c * 8 * 8192;
            *(LAS f32x4*)(Ps + tid * 8) = p0; *(LAS f32x4*)(Ps + tid * 8 + 4) = p1; Cs[il * 64 + jc] = cr;
            cb[i * 64 + jc] = cr;
            __syncthreads();
            float nr = sl;
            if (c + 1 < NC) { const float* nb = cb + 8 * 8192; p0 = *(const f32x4*)(nb + 4096 + tid * 8); p1 = *(const f32x4*)(nb + 4096 + tid * 8 + 4); sl = nb[i * 64 + jc]; }
#pragma unroll
            for (int m4 = 0; m4 < 16; ++m4) { const f32x4 cm = *(const LAS f32x4*)(Cs + il * 64 + m4 * 4);
                nr += cm.x * Ps[(m4 * 4) * 64 + jc]; nr += cm.y * Ps[(m4 * 4 + 1) * 64 + jc]; nr += cm.z * Ps[(m4 * 4 + 2) * 64 + jc]; nr += cm.w * Ps[(m4 * 4 + 3) * 64 + jc]; }
            __syncthreads();
            cr = nr;
        }
    }
}
__device__ __forceinline__ void rwkv_final(Ctx& C) {
    const int lane = C.lane, T = C.T, j = C.j, c0 = lane * 8;
    const h16* U = (const h16*)(C.ws + WS_U); h16* MIX = (h16*)(C.ws + WS_MIX); const h16* O = (const h16*)(C.ws + WS_O);
    const float* mu0p = IN(I_MU) + (size_t)j * 2 * A_IN, *mu1p = mu0p + A_IN;
    for (int tok = C.gw; tok < MG; tok += C.ngw) {
        const int t = tok % T;
        const h16x8 of = *(const h16x8*)(MIX + (size_t)tok * MIXW + c0), ob = *(const h16x8*)(O + (size_t)tok * 512 + c0), gg = *(const h16x8*)(MIX + (size_t)tok * MIXW + 512 + c0);
        float o[8], s = 0.f;
#pragma unroll
        for (int e = 0; e < 8; ++e) { o[e] = (float)of[e] + (float)ob[e]; s += o[e]; }
        s += __shfl_xor(s, 1); s += __shfl_xor(s, 2); s += __shfl_xor(s, 4);
        const float mean = s * (1.f / 64.f); float v2 = 0.f;
#pragma unroll
        for (int e = 0; e < 8; ++e) { o[e] -= mean; v2 += o[e] * o[e]; }
        v2 += __shfl_xor(v2, 1); v2 += __shfl_xor(v2, 2); v2 += __shfl_xor(v2, 4);
        const float rstd = rsqrtf(v2 * (1.f / 64.f) + 64e-5f);
        float rv[3][8];
#pragma unroll
        for (int part = 0; part < 3; ++part) {
            const h16* up = U + (size_t)tok * LDA_ + part * 512 + c0;
            const h16x8 cur = *(const h16x8*)up; h16x8 prv, nxt;
#pragma unroll
            for (int e = 0; e < 8; ++e) { prv[e] = (h16)0.f; nxt[e] = (h16)0.f; }
            if (t > 0) prv = *(const h16x8*)(up - LDA_);
            if (t < T - 1) nxt = *(const h16x8*)(up + LDA_);
#pragma unroll
            for (int e = 0; e < 8; ++e) { const float x = (float)cur[e]; rv[part][e] = x + mu0p[part * 512 + c0 + e] * ((float)prv[e] - x) + mu1p[part * 512 + c0 + e] * ((float)nxt[e] - x); }
        }
        float rk = 0.f;
#pragma unroll
        for (int e = 0; e < 8; ++e) rk += rv[0][e] * rv[1][e] * IN(I_RK)[j * 512 + c0 + e];
        rk += __shfl_xor(rk, 1); rk += __shfl_xor(rk, 2); rk += __shfl_xor(rk, 4);
        h16x8 w;
#pragma unroll
        for (int e = 0; e < 8; ++e) { const float y = o[e] * rstd * IN(I_GNW)[j * 512 + c0 + e] + IN(I_GNB)[j * 512 + c0 + e]; w[e] = (h16)((y + rk * rv[2][e]) * (float)gg[e]); }
        *(h16x8*)(MIX + (size_t)tok * MIXW + c0) = w;
    }
}

enum { MX_MAMBA = 0, MX_HGRN = 1, MX_RET = 2 };
template <int MX> struct MXC;
template <> struct MXC<MX_MAMBA> { static constexpr int CH = CH_M, NH = 16, LDU = LDB_; };
template <> struct MXC<MX_HGRN>  { static constexpr int CH = CH_H, NH = 8,  LDU = LDC_; };
template <> struct MXC<MX_RET>   { static constexpr int CH = CH_T, NH = 16, LDU = LDD_; };

__device__ __forceinline__ float ret_gamma(Ctx& C, int dir, int head) { return __expf(-__expf(IN(I_RETLD)[(C.j * 2 + dir) * 4 + head])); }

__device__ __forceinline__ void mamba_pre(Ctx& C) {
    const int T = C.T, j = C.j;
    const h16* U = (const h16*)(C.ws + WS_U); h16* BC = (h16*)(C.ws + WS_U + 88 * MiB); float* DT = (float*)(C.ws + WS_U + 104 * MiB); h16* XS = (h16*)(C.ws + WS_ST + 32 * MiB);
    const float* cw = IN(I_CONVW) + (size_t)j * 4 * 1536; const float* cb = IN(I_CONVB) + (size_t)j * 1536;
    for (int idx = C.gtid; idx < MG * 192; idx += C.ngt) {
        const int tok = idx / 192, q = idx - tok * 192, t = tok % T, c = q * 8;
        float acc[8];
#pragma unroll
        for (int e = 0; e < 8; ++e) acc[e] = cb[c + e];
#pragma unroll
        for (int jj = 0; jj < 4; ++jj) { const int tt = t + jj - 2;
            if (tt >= 0 && tt < T) { const h16x8 x = *(const h16x8*)(U + (size_t)(tok + jj - 2) * LDB_ + 1024 + c);
#pragma unroll
                for (int e = 0; e < 8; ++e) acc[e] += cw[jj * 1536 + c + e] * (float)x[e]; } }
        h16x8 w;
#pragma unroll
        for (int e = 0; e < 8; ++e) w[e] = (h16)silu(acc[e]);
        if (c < 1024) *(h16x8*)(XS + (size_t)tok * 1024 + c) = w; else *(h16x8*)(BC + (size_t)tok * 512 + (c - 1024)) = w;
    }
    for (int idx = C.gtid; idx < MG * 32; idx += C.ngt) { const int tok = idx >> 5, q = idx & 31;
        const float x = (float)U[(size_t)tok * LDB_ + 2560 + q] + IN(I_DTB)[j * 32 + q];
        const float dt = (x > 20.f) ? x : log1pf(expf(x)); const float da = -dt * expf(IN(I_ALOG)[j * 32 + q]);
        DT[(size_t)tok * 64 + q] = dt; DT[(size_t)tok * 64 + 32 + q] = da; }
}

constexpr int MC_OFF = 0, MB_OFF = 17408, MX_OFF = 36864, MG_OFF = 110592, MA_OFF = 119808;
struct MbBC { h16x8 x1, x2; };
struct MbX { h16x8 x[8]; float dt[8]; };
__device__ __forceinline__ MbBC mamba_load_bc(Ctx& C, int colbase, int b, int dir, int p0) {
    const int T = C.T, m = C.tid >> 3, i0 = (C.tid & 7) * 16;
    const int p = p0 + m, t = dir ? T - 1 - p : p; const size_t tok = (size_t)b * T + t;
    const h16* BC = (const h16*)(C.ws + WS_U + 88 * MiB);
    MbBC r; r.x1 = *(const h16x8*)(BC + tok * 512 + colbase + i0); r.x2 = *(const h16x8*)(BC + tok * 512 + colbase + i0 + 8); return r;
}
__device__ __forceinline__ void mamba_put_bc(Ctx& C, LAS h16* dst, bool transposed, const MbBC& r) {
    const int m = C.tid >> 3, i0 = (C.tid & 7) * 16;
    if (!transposed) { *(LAS h16x8*)(dst + m * 136 + i0) = r.x1; *(LAS h16x8*)(dst + m * 136 + i0 + 8) = r.x2; }
    else {
#pragma unroll
        for (int e = 0; e < 8; ++e) { dst[(i0 + e) * 72 + m] = r.x1[e]; dst[(i0 + 8 + e) * 72 + m] = r.x2[e]; } }
}
__device__ __forceinline__ MbX mamba_load_xt(Ctx& C, int g, int b, int dir, int p0) {
    const int T = C.T; const h16* XS = (const h16*)(C.ws + WS_ST + 32 * MiB); const float* DT = (const float*)(C.ws + WS_U + 104 * MiB); MbX r;
#pragma unroll
    for (int q = 0; q < 8; ++q) { const int it = C.tid + 512 * q, m = it >> 6, cb = it & 63, hl = cb >> 3;
        const int p = p0 + m, t = dir ? T - 1 - p : p; const size_t tok = (size_t)b * T + t;
        r.x[q] = *(const h16x8*)(XS + tok * 1024 + g * 512 + cb * 8); r.dt[q] = DT[tok * 64 + dir * 16 + g * 8 + hl]; }
    return r;
}
template <bool WEIGHTED>
__device__ __forceinline__ void mamba_stage_xt_w(Ctx& C, LAS h16* Xt, const LAS float* As, int g, int b, int dir, int p0, int lbase) {
    const int T = C.T; const h16* XS = (const h16*)(C.ws + WS_ST + 32 * MiB); const float* DT = (const float*)(C.ws + WS_U + 104 * MiB);
#pragma unroll 2
    for (int q = 0; q < 8; ++q) { const int it = C.tid + 512 * q, m = it >> 6, cb = it & 63, hl = cb >> 3;
        const int p = p0 + m, t = dir ? T - 1 - p : p; const size_t tok = (size_t)b * T + t;
        const h16x8 x = *(const h16x8*)(XS + tok * 1024 + g * 512 + cb * 8);
        float sc = DT[tok * 64 + dir * 16 + g * 8 + hl]; if (WEIGHTED) sc *= __expf(As[hl * 256 + 255] - As[hl * 256 + lbase + m]);
#pragma unroll
        for (int e = 0; e < 8; ++e) Xt[(cb * 8 + e) * 72 + m] = (h16)((float)x[e] * sc); }
}
template <bool WEIGHTED>
__device__ __forceinline__ void mamba_put_xt(Ctx& C, LAS h16* Xt, const LAS float* As, int lbase, const MbX& r) {
#pragma unroll
    for (int q = 0; q < 8; ++q) { const int it = C.tid + 512 * q, m = it >> 6, cb = it & 63, hl = cb >> 3;
        float sc = r.dt[q];
        if (WEIGHTED) sc *= __expf(As[hl * 256 + 255] - As[hl * 256 + lbase + m]);
#pragma unroll
        for (int e = 0; e < 8; ++e) Xt[(cb * 8 + e) * 72 + m] = (h16)((float)r.x[q][e] * sc); }
}
__device__ __forceinline__ void mamba_cum_decay(Ctx& C, LAS float* As, int g, int b, int dir, int c) {
    const int T = C.T, lane = C.lane, w = C.wave; const float* DT = (const float*)(C.ws + WS_U + 104 * MiB);
    float d[4]; float s = 0.f;
#pragma unroll
    for (int i = 0; i < 4; ++i) { const int p = c * 256 + 4 * lane + i, t = dir ? T - 1 - p : p; d[i] = DT[((size_t)b * T + t) * 64 + 32 + dir * 16 + g * 8 + w]; s += d[i]; d[i] = s; }
    float inc = s;
#pragma unroll
    for (int off = 1; off < 64; off <<= 1) { const float tv = __shfl_up(inc, off); if (lane >= off) inc += tv; }
    const float ex = inc - s;
#pragma unroll
    for (int i = 0; i < 4; ++i) As[w * 256 + 4 * lane + i] = ex + d[i];
}
__device__ __forceinline__ void mamba_mfma_pass1(Ctx& C) {
    const int T = C.T, NCH = T / 256, nunits = C.nseq * 2 * NCH * 2, lane = C.lane, w = C.wave, fr = lane & 15, fq = lane >> 4;
    LAS h16* Bt = (LAS h16*)(C.lds + MB_OFF); LAS h16* Xt = (LAS h16*)(C.lds + MX_OFF); LAS float* As = (LAS float*)(C.lds + MA_OFF);
    for (int unit = blockIdx.x; unit < nunits; unit += gridDim.x) {
        const int g = unit & 1; int r = unit >> 1; const int c = r % NCH; r /= NCH; const int dir = r & 1, b = r >> 1;
        __syncthreads();
        mamba_cum_decay(C, As, g, b, dir, c);
        f32x4 acc[8][4];
#pragma unroll
        for (int mt = 0; mt < 8; ++mt)
#pragma unroll
            for (int nt = 0; nt < 4; ++nt) acc[mt][nt] = (f32x4){0.f, 0.f, 0.f, 0.f};
        MbBC bq = mamba_load_bc(C, g * 128, b, dir, c * 256);
#pragma unroll 1
        for (int jb = 0; jb < 4; ++jb) {
            __syncthreads();
            mamba_put_bc(C, Bt, true, bq);
            mamba_stage_xt_w<true>(C, Xt, As, g, b, dir, c * 256 + 64 * jb, 64 * jb);
            __syncthreads();
            if (jb < 3) bq = mamba_load_bc(C, g * 128, b, dir, c * 256 + 64 * (jb + 1));
#pragma unroll
            for (int ks = 0; ks < 2; ++ks) {
                h16x8 bx[4];
#pragma unroll
                for (int nt = 0; nt < 4; ++nt) bx[nt] = *(const LAS h16x8*)(Xt + (64 * w + 16 * nt + fr) * 72 + ks * 32 + fq * 8);
#pragma unroll
                for (int mt = 0; mt < 8; ++mt) { const h16x8 a = *(const LAS h16x8*)(Bt + (16 * mt + fr) * 72 + ks * 32 + fq * 8);
#pragma unroll
                    for (int nt = 0; nt < 4; ++nt) acc[mt][nt] = __builtin_amdgcn_mfma_f32_16x16x32_f16(a, bx[nt], acc[mt][nt], 0, 0, 0); }
            }
        }
        const int slot = (((b * 2 + dir) * NCH + c) * 16) + g * 8 + w;
        h16* Hg = (h16*)(C.ws + WS_ST) + (size_t)slot * 8192;
#pragma unroll
        for (int mt = 0; mt < 8; ++mt)
#pragma unroll
            for (int nt = 0; nt < 4; ++nt) { h16x4 v; v[0] = (h16)acc[mt][nt][0]; v[1] = (h16)acc[mt][nt][1]; v[2] = (h16)acc[mt][nt][2]; v[3] = (h16)acc[mt][nt][3];
                *(h16x4*)(Hg + (size_t)(16 * nt + fr) * 128 + 16 * mt + fq * 4) = v; }
        if (lane == 0) ((float*)(C.ws + WS_DEC))[slot] = __expf(As[w * 256 + 255]);
    }
}
__device__ __forceinline__ void mamba_mfma_cross(Ctx& C) {
    const int T = C.T, NCH = T / 256, nchains = C.nseq * 2 * 16;
    const float* DEC = (const float*)(C.ws + WS_DEC);
    for (int idx = C.gtid; idx < nchains * 1024; idx += C.ngt) {
        const int chain = idx >> 10, e8 = (idx & 1023) * 8, hd = chain & 15, dir = (chain >> 4) & 1, b = chain >> 5;
        float carry[8];
#pragma unroll
        for (int e = 0; e < 8; ++e) carry[e] = 0.f;
#pragma unroll 2
        for (int c = 0; c < NCH; ++c) { const int slot = (((b * 2 + dir) * NCH + c) * 16) + hd; h16* p = (h16*)(C.ws + WS_ST) + (size_t)slot * 8192 + e8;
            const h16x8 sl = *(const h16x8*)p; const float d = DEC[slot]; h16x8 o;
#pragma unroll
            for (int e = 0; e < 8; ++e) { o[e] = (h16)carry[e]; carry[e] = d * carry[e] + (float)sl[e]; }
            *(h16x8*)p = o; }
    }
}
__device__ __forceinline__ void mamba_mfma_pass2(Ctx& C) {
    const int T = C.T, NCH = T / 256, nunits = C.nseq * 2 * NCH * 2, lane = C.lane, w = C.wave, fr = lane & 15, fq = lane >> 4;
    LAS h16* Cs = (LAS h16*)(C.lds + MC_OFF); LAS h16* Bs = (LAS h16*)(C.lds + MB_OFF); LAS h16* Xt = (LAS h16*)(C.lds + MX_OFF); LAS h16* Gs = (LAS h16*)(C.lds + MG_OFF); LAS float* As = (LAS float*)(C.lds + MA_OFF);
    for (int unit = blockIdx.x; unit < nunits; unit += gridDim.x) {
        const int g = unit & 1; int r = unit >> 1; const int c = r % NCH; r /= NCH; const int dir = r & 1, b = r >> 1;
        const int hd = g * 8 + w;
        __syncthreads();
        mamba_cum_decay(C, As, g, b, dir, c);
        const int slot = (((b * 2 + dir) * NCH + c) * 16) + hd;
        const h16* Hg = (const h16*)(C.ws + WS_ST) + (size_t)slot * 8192;
        h16* outp; int ldo; if (dir == 0) { outp = (h16*)(C.ws + WS_MIX) + 512; ldo = MIXW; } else { outp = (h16*)(C.ws + WS_O); ldo = 1024; }
        MbBC cq = mamba_load_bc(C, 256 + g * 128, b, dir, c * 256), bq = mamba_load_bc(C, g * 128, b, dir, c * 256);
#pragma unroll 1
        for (int ib = 0; ib < 4; ++ib) {
            f32x4 acc[4][4];
#pragma unroll
            for (int mt = 0; mt < 4; ++mt)
#pragma unroll
                for (int nt = 0; nt < 4; ++nt) acc[mt][nt] = (f32x4){0.f, 0.f, 0.f, 0.f};
#pragma unroll 1
            for (int jb = 0; jb <= ib; ++jb) {
                __syncthreads();
                if (jb == 0) mamba_put_bc(C, Cs, false, cq);
                mamba_put_bc(C, Bs, false, bq);
                mamba_stage_xt_w<false>(C, Xt, As, g, b, dir, c * 256 + 64 * jb, 0);
                __syncthreads();
                {
                    const int njb = (jb < ib) ? jb + 1 : 0, nib = (jb < ib) ? ib : ib + 1;
                    if (nib < 4) { bq = mamba_load_bc(C, g * 128, b, dir, c * 256 + 64 * njb);
                        if (njb == 0) cq = mamba_load_bc(C, 256 + g * 128, b, dir, c * 256 + 64 * nib); }
                }
                if (jb == 0) {
#pragma unroll
                    for (int ks = 0; ks < 4; ++ks) { h16x8 hf[4];
#pragma unroll
                        for (int nt = 0; nt < 4; ++nt) hf[nt] = *(const h16x8*)(Hg + (size_t)(16 * nt + fr) * 128 + ks * 32 + fq * 8);
#pragma unroll
                        for (int mt = 0; mt < 4; ++mt) { const h16x8 a = *(const LAS h16x8*)(Cs + (16 * mt + fr) * 136 + ks * 32 + fq * 8);
#pragma unroll
                            for (int nt = 0; nt < 4; ++nt) acc[mt][nt] = __builtin_amdgcn_mfma_f32_16x16x32_f16(a, hf[nt], acc[mt][nt], 0, 0, 0); } }
#pragma unroll
                    for (int mt = 0; mt < 4; ++mt)
#pragma unroll
                        for (int jj = 0; jj < 4; ++jj) { const float rs = __expf(As[w * 256 + 64 * ib + 16 * mt + fq * 4 + jj]);
#pragma unroll
                            for (int nt = 0; nt < 4; ++nt) acc[mt][nt][jj] *= rs; }
                }
                {
                    const int gm = w >> 1, gn = w & 1;
                    f32x4 g0 = (f32x4){0.f, 0.f, 0.f, 0.f}, g1 = (f32x4){0.f, 0.f, 0.f, 0.f};
#pragma unroll
                    for (int ks = 0; ks < 4; ++ks) { const h16x8 a = *(const LAS h16x8*)(Cs + (16 * gm + fr) * 136 + ks * 32 + fq * 8);
                        const h16x8 k0 = *(const LAS h16x8*)(Bs + (32 * gn + fr) * 136 + ks * 32 + fq * 8), k1 = *(const LAS h16x8*)(Bs + (32 * gn + 16 + fr) * 136 + ks * 32 + fq * 8);
                        g0 = __builtin_amdgcn_mfma_f32_16x16x32_f16(a, k0, g0, 0, 0, 0); g1 = __builtin_amdgcn_mfma_f32_16x16x32_f16(a, k1, g1, 0, 0, 0); }
#pragma unroll
                    for (int jj = 0; jj < 4; ++jj) { const int l = 16 * gm + fq * 4 + jj; Gs[l * 72 + 32 * gn + fr] = (h16)g0[jj]; Gs[l * 72 + 32 * gn + 16 + fr] = (h16)g1[jj]; }
                }
                __syncthreads();
#pragma unroll
                for (int ks = 0; ks < 2; ++ks) {
                    h16x8 bx[4];
#pragma unroll
                    for (int nt = 0; nt < 4; ++nt) bx[nt] = *(const LAS h16x8*)(Xt + (64 * w + 16 * nt + fr) * 72 + ks * 32 + fq * 8);
                    const LAS float* Am = As + w * 256 + 64 * jb + ks * 32 + fq * 8;
                    const f32x4 am0 = *(const LAS f32x4*)Am, am1 = *(const LAS f32x4*)(Am + 4);
                    const float am[8] = {am0.x, am0.y, am0.z, am0.w, am1.x, am1.y, am1.z, am1.w};
                    const int Mb = 64 * jb + ks * 32 + fq * 8;
#pragma unroll
                    for (int mt = 0; mt < 4; ++mt) { const int l = 16 * mt + fr, Lg = 64 * ib + l; const float Al = As[w * 256 + Lg];
                        const h16x8 gr = *(const LAS h16x8*)(Gs + l * 72 + ks * 32 + fq * 8); h16x8 a;
#pragma unroll
                        for (int e = 0; e < 8; ++e) a[e] = (h16)((Mb + e <= Lg) ? (float)gr[e] * __expf(Al - am[e]) : 0.f);
#pragma unroll
                        for (int nt = 0; nt < 4; ++nt) acc[mt][nt] = __builtin_amdgcn_mfma_f32_16x16x32_f16(a, bx[nt], acc[mt][nt], 0, 0, 0); }
                }
            }
#pragma unroll
            for (int mt = 0; mt < 4; ++mt)
#pragma unroll
                for (int jj = 0; jj < 4; ++jj) { const int Lg = 64 * ib + 16 * mt + fq * 4 + jj; const int p = c * 256 + Lg, t = dir ? T - 1 - p : p; h16* op = outp + ((size_t)b * T + t) * ldo + hd * 64 + fr;
#pragma unroll
                    for (int nt = 0; nt < 4; ++nt) op[16 * nt] = (h16)acc[mt][nt][jj]; }
        }
    }
}

template <int MX, int PASS>
__device__ __forceinline__ void diag_scan(Ctx& C) {
    constexpr int CH = MXC<MX>::CH, NH = MXC<MX>::NH, LDU = MXC<MX>::LDU;
    const int lane = C.lane, T = C.T, NC = T / CH, j = C.j;
    const int nunits = C.nseq * 2 * NC * NH;
    const h16* U = (const h16*)(C.ws + WS_U);
    const h16* BC = (const h16*)(C.ws + WS_U + 88 * MiB); const float* DT = (const float*)(C.ws + WS_U + 104 * MiB);
    const float* ROT = (const float*)(C.ws + WS_ROT);
    float* DEC = (float*)(C.ws + WS_DEC);
    LAS float* wl = (LAS float*)(C.lds + C.wave * 12288);
    for (int unit = C.gw; unit < nunits; unit += C.ngw) {
        const int hd = unit % NH; int r = unit / NH; const int c = r % NC; r /= NC; const int dir = r & 1, b = r >> 1;
        const int slotid = ((b * 2 + dir) * NC + c) * NH + hd;
        float* slot = (float*)(C.ws + WS_ST) + (size_t)slotid * 8192;
        float S[128];
        if (PASS == 1) {
#pragma unroll
            for (int q = 0; q < 128; ++q) S[q] = 0.f;
        } else {
#pragma unroll
            for (int q = 0; q < 128; ++q) S[q] = slot[q * 64 + lane];
        }
        float k0 = 0.f, k1 = 0.f, k2 = 0.f, k3 = 0.f, k4c = 0.f, gam = 1.f, dprod = 1.f, D0 = 1.f, D1 = 1.f;
        h16* outp; int ldo, ocol;
        if (MX == MX_MAMBA) { const int cc = hd * 64 + lane; const float* cw = IN(I_CONVW) + (size_t)j * 4 * 1536; k0 = cw[cc]; k1 = cw[1536 + cc]; k2 = cw[2 * 1536 + cc]; k3 = cw[3 * 1536 + cc]; k4c = IN(I_CONVB)[j * 1536 + cc];
            ocol = hd * 64 + lane; if (dir == 0) { outp = (h16*)(C.ws + WS_MIX) + 512; ldo = MIXW; } else { outp = (h16*)(C.ws + WS_O); ldo = 1024; } }
        else if (MX == MX_HGRN) {
            if (j == 1) { const float* lb = IN(I_HGLB); const int f0 = hd * 128 + lane;
                k0 = sigm(lb[(dir * 2 + 1) * 1024 + f0] - lb[(dir * 2 + 0) * 1024 + f0]); k1 = sigm(lb[(dir * 2 + 1) * 1024 + f0 + 64] - lb[(dir * 2 + 0) * 1024 + f0 + 64]); }
            ocol = hd * 64 + lane; if (dir == 0) { outp = (h16*)(C.ws + WS_MIX); ldo = MIXW; } else { outp = (h16*)(C.ws + WS_O); ldo = 512; } }
        else { gam = ret_gamma(C, dir, hd >> 2);
            ocol = hd * 64 + lane; if (dir == 0) { outp = (h16*)(C.ws + WS_MIX) + 512; ldo = MIXW; } else { outp = (h16*)(C.ws + WS_O); ldo = 1024; } }
#pragma unroll 1
        for (int sub = 0; sub < CH / SUB; ++sub) {
#pragma unroll
            for (int s = 0; s < SUB; ++s) {
                const int p = c * CH + sub * SUB + s, t = dir ? T - 1 - p : p; const size_t tok = (size_t)b * T + t;
                const h16* ur = U + tok * LDU;
                LAS float* q = wl + s * 384;
                if (MX == MX_MAMBA) {
                    const int g = hd >> 3; const h16* bc = BC + tok * 512 + g * 128 + lane;
                    q[lane] = (float)bc[0]; q[64 + lane] = (float)bc[64];
                    if (PASS == 2) { q[128 + lane] = (float)bc[256]; q[192 + lane] = (float)bc[320]; }
                    const h16* xp = ur + 1024 + hd * 64 + lane;
                    float acc = k4c + k2 * (float)xp[0];
                    if (t >= 2) acc += k0 * (float)xp[-2 * LDU];
                    if (t >= 1) acc += k1 * (float)xp[-LDU];
                    if (t < T - 1) acc += k3 * (float)xp[LDU];
                    const float dt = DT[tok * 64 + dir * 16 + hd], dA = DT[tok * 64 + 32 + dir * 16 + hd];
                    q[256 + lane] = silu(acc) * dt; q[320] = dA; dprod *= dA;
                } else if (MX == MX_HGRN) {
                    const h16* fp = ur + 1024 + dir * 1024 + hd * 128 + lane;
                    const float f0 = k0 + (1.f - k0) * sigm((float)fp[0]), f1 = k1 + (1.f - k1) * sigm((float)fp[64]);
                    q[lane] = f0; q[64 + lane] = f1; D0 *= f0; D1 *= f1;
                    if (PASS == 2) { q[128 + lane] = (float)ur[hd * 128 + lane]; q[192 + lane] = (float)ur[hd * 128 + 64 + lane]; }
                    q[256 + lane] = (float)ur[3072 + hd * 64 + lane];
                } else {
                    const int h = hd >> 2; const float cs = ROT[t * 128 + lane], sn = ROT[t * 128 + 64 + lane];
                    const float x1 = (float)ur[512 + h * 128 + lane], x2 = (float)ur[512 + h * 128 + 64 + lane];
                    q[lane] = (x1 * cs - x2 * sn) * 0.08838834764831845f; q[64 + lane] = (x2 * cs + x1 * sn) * 0.08838834764831845f;
                    if (PASS == 2) { const float y1 = (float)ur[h * 128 + lane], y2 = (float)ur[h * 128 + 64 + lane]; q[128 + lane] = y1 * cs - y2 * sn; q[192 + lane] = y2 * cs + y1 * sn; }
                    q[256 + lane] = (float)ur[1024 + hd * 64 + lane];
                }
            }
            WAVE_SYNC();
#pragma unroll 1
            for (int s = 0; s < SUB; ++s) {
                const LAS f32x4* q = (const LAS f32x4*)(wl + s * 384);
                const float vv = wl[s * 384 + 256 + lane];
                const float dec = (MX == MX_MAMBA) ? wl[s * 384 + 320] : gam;
                float o0 = 0.f, o1 = 0.f, o2 = 0.f, o3 = 0.f;
#pragma unroll
                for (int k4 = 0; k4 < 32; ++k4) { const f32x4 a4 = q[k4];
                    if (MX == MX_HGRN) { S[4 * k4] = a4.x * (S[4 * k4] - vv) + vv; S[4 * k4 + 1] = a4.y * (S[4 * k4 + 1] - vv) + vv; S[4 * k4 + 2] = a4.z * (S[4 * k4 + 2] - vv) + vv; S[4 * k4 + 3] = a4.w * (S[4 * k4 + 3] - vv) + vv; }
                    else { S[4 * k4] = S[4 * k4] * dec + a4.x * vv; S[4 * k4 + 1] = S[4 * k4 + 1] * dec + a4.y * vv; S[4 * k4 + 2] = S[4 * k4 + 2] * dec + a4.z * vv; S[4 * k4 + 3] = S[4 * k4 + 3] * dec + a4.w * vv; }
                    if (PASS == 2) { const f32x4 q4 = q[32 + k4]; o0 += S[4 * k4] * q4.x; o1 += S[4 * k4 + 1] * q4.y; o2 += S[4 * k4 + 2] * q4.z; o3 += S[4 * k4 + 3] * q4.w; } }
                if (PASS == 2) { const int p = c * CH + sub * SUB + s, t = dir ? T - 1 - p : p; outp[((size_t)b * T + t) * ldo + ocol] = (h16)((o0 + o1) + (o2 + o3)); }
            }
            WAVE_SYNC();
        }
        if (PASS == 1) {
#pragma unroll
            for (int q = 0; q < 128; ++q) slot[q * 64 + lane] = S[q];
            if (MX == MX_MAMBA) { if (lane == 0) DEC[slotid] = dprod; }
            if (MX == MX_HGRN) { DEC[(size_t)slotid * 128 + lane] = D0; DEC[(size_t)slotid * 128 + 64 + lane] = D1; }
        }
    }
}
template <int MX>
__device__ __forceinline__ void diag_cross(Ctx& C) {
    constexpr int CH = MXC<MX>::CH, NH = MXC<MX>::NH;
    const int T = C.T, NC = T / CH, nchains = C.nseq * 2 * NH;
    const float* DEC = (const float*)(C.ws + WS_DEC);
    for (int idx = C.gtid; idx < nchains * 8192; idx += C.ngt) {
        const int chain = idx >> 13, e = idx & 8191, hd = chain % NH; int r = chain / NH; const int dir = r & 1, b = r >> 1;
        float gch = 1.f;
        if (MX == MX_RET) { const float lg = -__expf(IN(I_RETLD)[(C.j * 2 + dir) * 4 + (hd >> 2)]); gch = __expf(lg * (float)CH); }
        float carry = 0.f;
#pragma unroll 4
        for (int c = 0; c < NC; ++c) {
            const int slotid = ((b * 2 + dir) * NC + c) * NH + hd;
            float* p = (float*)(C.ws + WS_ST) + (size_t)slotid * 8192 + e;
            const float sl = *p; *p = carry;
            const float d = (MX == MX_HGRN) ? DEC[(size_t)slotid * 128 + (e >> 6)] : (MX == MX_MAMBA) ? DEC[slotid] : gch;
            carry = d * carry + sl;
        }
    }
}

constexpr int RQ_OFF = 0, RK_OFF = 17408, RV_OFF = 36864, RM_OFF = 73728;
struct RetQK { h16x8 x1, x2; f32x4 c0, c1, s0, s1; };
struct RetV { h16x8 x[4]; };
__device__ __forceinline__ RetQK ret_load_qk(Ctx& C, int colbase, int b, int dir, int p0) {
    const int T = C.T, m = C.tid >> 3, i0 = (C.tid & 7) * 8;
    const int p = p0 + m, t = dir ? T - 1 - p : p; const size_t tok = (size_t)b * T + t;
    const h16* U = (const h16*)(C.ws + WS_U); const float* ROT = (const float*)(C.ws + WS_ROT);
    RetQK r; r.x1 = *(const h16x8*)(U + tok * LDD_ + colbase + i0); r.x2 = *(const h16x8*)(U + tok * LDD_ + colbase + 64 + i0);
    r.c0 = *(const f32x4*)(ROT + t * 128 + i0); r.c1 = *(const f32x4*)(ROT + t * 128 + i0 + 4); r.s0 = *(const f32x4*)(ROT + t * 128 + 64 + i0); r.s1 = *(const f32x4*)(ROT + t * 128 + 64 + i0 + 4);
    return r;
}
__device__ __forceinline__ void ret_put_qk(Ctx& C, LAS h16* dst, bool transposed, float scale, float lg2, int wbase, const RetQK& r) {
    const int m = C.tid >> 3, i0 = (C.tid & 7) * 8;
    const float cs[8] = {r.c0.x, r.c0.y, r.c0.z, r.c0.w, r.c1.x, r.c1.y, r.c1.z, r.c1.w}, sn[8] = {r.s0.x, r.s0.y, r.s0.z, r.s0.w, r.s1.x, r.s1.y, r.s1.z, r.s1.w};
    const float sc = transposed ? scale * exp2f((float)(wbase - m) * lg2) : scale;
    h16x8 y1, y2;
#pragma unroll
    for (int e = 0; e < 8; ++e) { const float a = (float)r.x1[e], bb = (float)r.x2[e]; y1[e] = (h16)((a * cs[e] - bb * sn[e]) * sc); y2[e] = (h16)((bb * cs[e] + a * sn[e]) * sc); }
    if (!transposed) { *(LAS h16x8*)(dst + m * 136 + i0) = y1; *(LAS h16x8*)(dst + m * 136 + 64 + i0) = y2; }
    else {
#pragma unroll
        for (int e = 0; e < 8; ++e) { dst[(i0 + e) * 72 + m] = y1[e]; dst[(64 + i0 + e) * 72 + m] = y2[e]; } }
}
__device__ __forceinline__ RetV ret_load_vt(Ctx& C, int h, int b, int dir, int p0) {
    const int T = C.T; const h16* U = (const h16*)(C.ws + WS_U); RetV r;
#pragma unroll
    for (int q = 0; q < 4; ++q) { const int it = C.tid + 512 * q, m = it >> 5, cb = it & 31;
        const int p = p0 + m, t = dir ? T - 1 - p : p; const size_t tok = (size_t)b * T + t;
        r.x[q] = *(const h16x8*)(U + tok * LDD_ + 1024 + h * 256 + cb * 8); }
    return r;
}
__device__ __forceinline__ void ret_put_vt(Ctx& C, LAS h16* Vt, const RetV& r) {
#pragma unroll
    for (int q = 0; q < 4; ++q) { const int it = C.tid + 512 * q, m = it >> 5, cb = it & 31;
#pragma unroll
        for (int e = 0; e < 8; ++e) Vt[(cb * 8 + e) * 72 + m] = r.x[q][e]; }
}
__device__ __forceinline__ void ret_mfma_pass1(Ctx& C) {
    const int T = C.T, NCH = T / 256, nunits = C.nseq * 2 * NCH * 4, lane = C.lane, w = C.wave, fr = lane & 15, fq = lane >> 4;
    LAS h16* Kt = (LAS h16*)(C.lds + RK_OFF); LAS h16* Vt = (LAS h16*)(C.lds + RV_OFF);
    for (int unit = blockIdx.x; unit < nunits; unit += gridDim.x) {
        const int h = unit & 3; int r = unit >> 2; const int c = r % NCH; r /= NCH; const int dir = r & 1, b = r >> 1;
        const float lg2 = -__expf(IN(I_RETLD)[(C.j * 2 + dir) * 4 + h]) * 1.4426950408889634f;
        f32x4 acc[8][2];
#pragma unroll
        for (int mt = 0; mt < 8; ++mt) { acc[mt][0] = (f32x4){0.f, 0.f, 0.f, 0.f}; acc[mt][1] = (f32x4){0.f, 0.f, 0.f, 0.f}; }
        RetQK kq = ret_load_qk(C, 512 + h * 128, b, dir, c * 256); RetV vr = ret_load_vt(C, h, b, dir, c * 256);
#pragma unroll 1
        for (int jb = 0; jb < 4; ++jb) {
            __syncthreads();
            ret_put_qk(C, Kt, true, 0.08838834764831845f, lg2, 255 - 64 * jb, kq);
            ret_put_vt(C, Vt, vr);
            __syncthreads();
            if (jb < 3) { kq = ret_load_qk(C, 512 + h * 128, b, dir, c * 256 + 64 * (jb + 1)); vr = ret_load_vt(C, h, b, dir, c * 256 + 64 * (jb + 1)); }
#pragma unroll
            for (int ks = 0; ks < 2; ++ks) {
                const h16x8 b0 = *(const LAS h16x8*)(Vt + (32 * w + fr) * 72 + ks * 32 + fq * 8), b1 = *(const LAS h16x8*)(Vt + (32 * w + 16 + fr) * 72 + ks * 32 + fq * 8);
#pragma unroll
                for (int mt = 0; mt < 8; ++mt) { const h16x8 a = *(const LAS h16x8*)(Kt + (16 * mt + fr) * 72 + ks * 32 + fq * 8);
                    acc[mt][0] = __builtin_amdgcn_mfma_f32_16x16x32_f16(a, b0, acc[mt][0], 0, 0, 0); acc[mt][1] = __builtin_amdgcn_mfma_f32_16x16x32_f16(a, b1, acc[mt][1], 0, 0, 0); }
            }
        }
        float* Sg = (float*)(C.ws + WS_ST) + (size_t)unit * 32768;
#pragma unroll
        for (int mt = 0; mt < 8; ++mt)
#pragma unroll
            for (int nt = 0; nt < 2; ++nt) *(f32x4*)(Sg + (size_t)(32 * w + 16 * nt + fr) * 128 + 16 * mt + fq * 4) = acc[mt][nt];
    }
}
__device__ __forceinline__ void ret_mfma_cross(Ctx& C) {
    const int T = C.T, NCH = T / 256, nchains = C.nseq * 2 * 4;
    for (int idx = C.gtid; idx < nchains * 32768; idx += C.ngt) {
        const int chain = idx >> 15, e = idx & 32767, h = chain & 3, dir = (chain >> 2) & 1, b = chain >> 3;
        const float gch = __expf(-__expf(IN(I_RETLD)[(C.j * 2 + dir) * 4 + h]) * 256.f);
        float carry = 0.f;
#pragma unroll 4
        for (int c = 0; c < NCH; ++c) { float* p = (float*)(C.ws + WS_ST) + (size_t)((((b * 2 + dir) * NCH + c) * 4) + h) * 32768 + e; const float sl = *p; *p = carry; carry = gch * carry + sl; }
    }
}
__device__ __forceinline__ void ret_mfma_pass2(Ctx& C) {
    const int T = C.T, NCH = T / 256, nunits = C.nseq * 2 * NCH * 4, lane = C.lane, w = C.wave, fr = lane & 15, fq = lane >> 4;
    LAS h16* Qs = (LAS h16*)(C.lds + RQ_OFF); LAS h16* Ks = (LAS h16*)(C.lds + RK_OFF); LAS h16* Vt = (LAS h16*)(C.lds + RV_OFF); LAS h16* Ms = (LAS h16*)(C.lds + RM_OFF);
    for (int unit = blockIdx.x; unit < nunits; unit += gridDim.x) {
        const int h = unit & 3; int r = unit >> 2; const int c = r % NCH; r /= NCH; const int dir = r & 1, b = r >> 1;
        const float lg2 = -__expf(IN(I_RETLD)[(C.j * 2 + dir) * 4 + h]) * 1.4426950408889634f;
        const float* Sg = (const float*)(C.ws + WS_ST) + (size_t)unit * 32768;
        h16x8 sf[2][4];
#pragma unroll
        for (int nt = 0; nt < 2; ++nt)
#pragma unroll
            for (int ks = 0; ks < 4; ++ks) { const float* p = Sg + (size_t)(32 * w + 16 * nt + fr) * 128 + ks * 32 + fq * 8; const f32x4 a = *(const f32x4*)p, bb = *(const f32x4*)(p + 4);
                sf[nt][ks][0] = (h16)a.x; sf[nt][ks][1] = (h16)a.y; sf[nt][ks][2] = (h16)a.z; sf[nt][ks][3] = (h16)a.w; sf[nt][ks][4] = (h16)bb.x; sf[nt][ks][5] = (h16)bb.y; sf[nt][ks][6] = (h16)bb.z; sf[nt][ks][7] = (h16)bb.w; }
        h16* outp; int ldo; if (dir == 0) { outp = (h16*)(C.ws + WS_MIX) + 512; ldo = MIXW; } else { outp = (h16*)(C.ws + WS_O); ldo = 1024; }
        RetQK qq = ret_load_qk(C, h * 128, b, dir, c * 256), kq = ret_load_qk(C, 512 + h * 128, b, dir, c * 256); RetV vr = ret_load_vt(C, h, b, dir, c * 256);
#pragma unroll 1
        for (int ib = 0; ib < 4; ++ib) {
            f32x4 acc[4][2];
#pragma unroll
            for (int mt = 0; mt < 4; ++mt) { acc[mt][0] = (f32x4){0.f, 0.f, 0.f, 0.f}; acc[mt][1] = (f32x4){0.f, 0.f, 0.f, 0.f}; }
#pragma unroll 1
            for (int jb = 0; jb <= ib; ++jb) {
                __syncthreads();
                if (jb == 0) ret_put_qk(C, Qs, false, 1.f, lg2, 0, qq);
                ret_put_qk(C, Ks, false, 0.08838834764831845f, lg2, 0, kq);
                ret_put_vt(C, Vt, vr);
                __syncthreads();
                {
                    const int njb = (jb < ib) ? jb + 1 : 0, nib = (jb < ib) ? ib : ib + 1;
                    if (nib < 4) { kq = ret_load_qk(C, 512 + h * 128, b, dir, c * 256 + 64 * njb); vr = ret_load_vt(C, h, b, dir, c * 256 + 64 * njb);
                        if (njb == 0) qq = ret_load_qk(C, h * 128, b, dir, c * 256 + 64 * nib); }
                }
                {
                    const int gm = w >> 1, gn = w & 1;
                    f32x4 g0 = (f32x4){0.f, 0.f, 0.f, 0.f}, g1 = (f32x4){0.f, 0.f, 0.f, 0.f};
#pragma unroll
                    for (int ks = 0; ks < 4; ++ks) { const h16x8 a = *(const LAS h16x8*)(Qs + (16 * gm + fr) * 136 + ks * 32 + fq * 8);
                        const h16x8 k0 = *(const LAS h16x8*)(Ks + (32 * gn + fr) * 136 + ks * 32 + fq * 8), k1 = *(const LAS h16x8*)(Ks + (32 * gn + 16 + fr) * 136 + ks * 32 + fq * 8);
                        g0 = __builtin_amdgcn_mfma_f32_16x16x32_f16(a, k0, g0, 0, 0, 0); g1 = __builtin_amdgcn_mfma_f32_16x16x32_f16(a, k1, g1, 0, 0, 0); }
#pragma unroll
                    for (int jj = 0; jj < 4; ++jj) { const int l = 16 * gm + fq * 4 + jj, Lg = 64 * ib + l;
                        const int m0 = 32 * gn + fr, M0 = 64 * jb + m0, M1 = M0 + 16;
                        Ms[l * 72 + m0] = (h16)((M0 <= Lg) ? g0[jj] * exp2f((float)(Lg - M0) * lg2) : 0.f);
                        Ms[l * 72 + m0 + 16] = (h16)((M1 <= Lg) ? g1[jj] * exp2f((float)(Lg - M1) * lg2) : 0.f); }
                }
                __syncthreads();
#pragma unroll
                for (int ks = 0; ks < 2; ++ks) {
                    const h16x8 b0 = *(const LAS h16x8*)(Vt + (32 * w + fr) * 72 + ks * 32 + fq * 8), b1 = *(const LAS h16x8*)(Vt + (32 * w + 16 + fr) * 72 + ks * 32 + fq * 8);
#pragma unroll
                    for (int mt = 0; mt < 4; ++mt) { const h16x8 a = *(const LAS h16x8*)(Ms + (16 * mt + fr) * 72 + ks * 32 + fq * 8);
                        acc[mt][0] = __builtin_amdgcn_mfma_f32_16x16x32_f16(a, b0, acc[mt][0], 0, 0, 0); acc[mt][1] = __builtin_amdgcn_mfma_f32_16x16x32_f16(a, b1, acc[mt][1], 0, 0, 0); }
                }
            }
            f32x4 ac2[4][2];
#pragma unroll
            for (int mt = 0; mt < 4; ++mt) { ac2[mt][0] = (f32x4){0.f, 0.f, 0.f, 0.f}; ac2[mt][1] = (f32x4){0.f, 0.f, 0.f, 0.f}; }
#pragma unroll
            for (int ks = 0; ks < 4; ++ks)
#pragma unroll
                for (int mt = 0; mt < 4; ++mt) { const h16x8 a = *(const LAS h16x8*)(Qs + (16 * mt + fr) * 136 + ks * 32 + fq * 8);
                    ac2[mt][0] = __builtin_amdgcn_mfma_f32_16x16x32_f16(a, sf[0][ks], ac2[mt][0], 0, 0, 0); ac2[mt][1] = __builtin_amdgcn_mfma_f32_16x16x32_f16(a, sf[1][ks], ac2[mt][1], 0, 0, 0); }
#pragma unroll
            for (int mt = 0; mt < 4; ++mt)
#pragma unroll
                for (int jj = 0; jj < 4; ++jj) { const int Lg = 64 * ib + 16 * mt + fq * 4 + jj; const float rs = exp2f((float)(Lg + 1) * lg2);
                    const int p = c * 256 + Lg, t = dir ? T - 1 - p : p; h16* op = outp + ((size_t)b * T + t) * ldo + h * 256 + 32 * w + fr;
                    op[0] = (h16)(acc[mt][0][jj] + ac2[mt][0][jj] * rs); op[16] = (h16)(acc[mt][1][jj] + ac2[mt][1][jj] * rs); }
        }
    }
}

typedef short s16x4 __attribute__((ext_vector_type(4)));
typedef __bf16 b16x8 __attribute__((ext_vector_type(8)));
typedef unsigned u32x2 __attribute__((ext_vector_type(2)));
typedef float f32x2_t __attribute__((ext_vector_type(2)));
typedef __bf16 bf16x2_t __attribute__((ext_vector_type(2)));
__device__ __forceinline__ unsigned cvt_pk_bf16(float lo, float hi) { const f32x2_t v = {lo, hi}; const bf16x2_t b = __builtin_convertvector(v, bf16x2_t); return __builtin_bit_cast(unsigned, b); }
__device__ __forceinline__ s16x4 cvt4_bf16(f32x4 v) { const unsigned a = cvt_pk_bf16(v.x, v.y), b = cvt_pk_bf16(v.z, v.w); s16x4 r; r[0] = (short)(a & 0xffff); r[1] = (short)(a >> 16); r[2] = (short)(b & 0xffff); r[3] = (short)(b >> 16); return r; }
constexpr int HQ_OFF = 0, HK_OFF = 4352, HT_OFF = 8704, HV_OFF = 13824, HE8_OFF = 16384, HE15_OFF = 16896, HWAVE_LDS = 18432;
template <int PASS>
__device__ __forceinline__ void hgrn_mfma(Ctx& C) {
    const int lane = C.lane, T = C.T, NC = T / CH_H, j = C.j, fr = lane & 15, fq = lane >> 4;
    const int nunits = C.nseq * 2 * NC * 8;
    const h16* U = (const h16*)(C.ws + WS_U);
    float* DEC = (float*)(C.ws + WS_DEC);
    LAS unsigned char* wl = C.lds + C.wave * HWAVE_LDS;
    LAS unsigned short* QB = (LAS unsigned short*)(wl + HQ_OFF); LAS unsigned short* KB = (LAS unsigned short*)(wl + HK_OFF);
    LAS unsigned short* KT = (LAS unsigned short*)(wl + HT_OFF); LAS unsigned short* VT = (LAS unsigned short*)(wl + HV_OFF);
    LAS float* E8 = (LAS float*)(wl + HE8_OFF); LAS float* E15 = (LAS float*)(wl + HE15_OFF);
    for (int unit = C.gw; unit < nunits; unit += C.ngw) {
        const int hd = unit & 7; int r_ = unit >> 3; const int c = r_ % NC; r_ /= NC; const int dir = r_ & 1, b = r_ >> 1;
        float* Sg = (float*)(C.ws + WS_ST) + (size_t)unit * 8192;
        float lb0 = 0.f, lb1 = 0.f;
        if (j == 1) { const float* lbp = IN(I_HGLB); const int f0 = hd * 128 + lane;
            lb0 = sigm(lbp[(dir * 2 + 1) * 1024 + f0] - lbp[(dir * 2 + 0) * 1024 + f0]); lb1 = sigm(lbp[(dir * 2 + 1) * 1024 + f0 + 64] - lbp[(dir * 2 + 0) * 1024 + f0 + 64]); }
        f32x4 S[8][4];
#pragma unroll
        for (int mt = 0; mt < 8; ++mt)
#pragma unroll
            for (int nt = 0; nt < 4; ++nt) S[mt][nt] = (PASS == 1) ? (f32x4){0.f, 0.f, 0.f, 0.f} : *(const f32x4*)(Sg + (size_t)(16 * nt + fr) * 128 + 16 * mt + 4 * fq);
        float dlog0 = 0.f, dlog1 = 0.f;
        h16* outp; int ldo; if (dir == 0) { outp = (h16*)(C.ws + WS_MIX); ldo = MIXW; } else { outp = (h16*)(C.ws + WS_O); ldo = 512; }
#pragma unroll 1
        for (int sb = 0; sb < CH_H / 16; ++sb) {
            const int p0 = c * CH_H + sb * 16;
            {
                unsigned pk[8];
#pragma unroll
                for (int r = 0; r < 16; r += 2) { const int pa = p0 + r, ta = dir ? T - 1 - pa : pa, tb = dir ? ta - 1 : ta + 1;
                    const float va = (float)U[((size_t)b * T + ta) * LDC_ + 3072 + hd * 64 + lane], vb = (float)U[((size_t)b * T + tb) * LDC_ + 3072 + hd * 64 + lane];
                    pk[r >> 1] = cvt_pk_bf16(va, vb); }
#pragma unroll
                for (int q = 0; q < 4; ++q) *(LAS u32x2*)(VT + lane * 20 + 4 * q) = (u32x2){pk[2 * q], pk[2 * q + 1]};
            }
#pragma unroll 1
            for (int ch = 0; ch < 2; ++ch) {
                const int k = lane + 64 * ch; const float lb = ch ? lb1 : lb0;
                float bb[16], kv[16]; float run = 0.f;
#pragma unroll
                for (int r = 0; r < 16; ++r) { const int pp = p0 + r, t = dir ? T - 1 - pp : pp;
                    const float x = (float)U[((size_t)b * T + t) * LDC_ + 1024 + dir * 1024 + hd * 128 + k];
                    const float om = (1.f - lb) / (1.f + __expf(x));
                    const float ff = lb + (1.f - lb) / (1.f + __expf(-x));
                    kv[r] = om; run += __logf(ff); bb[r] = run; }
                const float b8 = bb[8], b15 = bb[15];
                unsigned pk[8];
#pragma unroll
                for (int r = 0; r < 16; r += 2) {
                    const float ka = kv[r] * __expf(b8 - bb[r]), kb2 = kv[r + 1] * __expf(b8 - bb[r + 1]);
                    const unsigned pkk = cvt_pk_bf16(ka, kb2); pk[r >> 1] = pkk;
                    if (PASS == 2) {
                        const int pa = p0 + r, ta = dir ? T - 1 - pa : pa, tb = dir ? ta - 1 : ta + 1;
                        const float qa = (float)U[((size_t)b * T + ta) * LDC_ + hd * 128 + k] * __expf(bb[r] - b8), qb = (float)U[((size_t)b * T + tb) * LDC_ + hd * 128 + k] * __expf(bb[r + 1] - b8);
                        const unsigned pkq = cvt_pk_bf16(qa, qb);
                        QB[r * 136 + k] = (unsigned short)(pkq & 0xffff); QB[(r + 1) * 136 + k] = (unsigned short)(pkq >> 16);
                        KB[r * 136 + k] = (unsigned short)(pkk & 0xffff); KB[(r + 1) * 136 + k] = (unsigned short)(pkk >> 16);
                    }
                }
#pragma unroll
                for (int q = 0; q < 4; ++q) *(LAS u32x2*)(KT + k * 20 + 4 * q) = (u32x2){pk[2 * q], pk[2 * q + 1]};
                E8[k] = __expf(b8); E15[k] = __expf(b15 - b8);
                if (ch == 0) dlog0 += b15; else dlog1 += b15;
            }
            WAVE_SYNC();
#pragma unroll
            for (int mt = 0; mt < 8; ++mt) { const f32x4 e4 = *(const LAS f32x4*)(E8 + 16 * mt + 4 * fq);
#pragma unroll
                for (int nt = 0; nt < 4; ++nt) S[mt][nt] = S[mt][nt] * e4; }
            s16x4 vt[4];
#pragma unroll
            for (int nt = 0; nt < 4; ++nt) vt[nt] = *(const LAS s16x4*)(VT + (16 * nt + fr) * 20 + 4 * fq);
            if (PASS == 2) {
                f32x4 oT[4];
#pragma unroll
                for (int nt = 0; nt < 4; ++nt) oT[nt] = (f32x4){0.f, 0.f, 0.f, 0.f};
#pragma unroll
                for (int mt = 0; mt < 8; ++mt) { const s16x4 qf = *(const LAS s16x4*)(QB + fr * 136 + 16 * mt + 4 * fq);
#pragma unroll
                    for (int nt = 0; nt < 4; ++nt) oT[nt] = __builtin_amdgcn_mfma_f32_16x16x16bf16_1k(cvt4_bf16(S[mt][nt]), qf, oT[nt], 0, 0, 0); }
                f32x4 sT = (f32x4){0.f, 0.f, 0.f, 0.f};
#pragma unroll
                for (int ks = 0; ks < 4; ++ks) { const b16x8 ka = *(const LAS b16x8*)(KB + fr * 136 + 32 * ks + 8 * fq), qb = *(const LAS b16x8*)(QB + fr * 136 + 32 * ks + 8 * fq);
                    sT = __builtin_amdgcn_mfma_f32_16x16x32_bf16(ka, qb, sT, 0, 0, 0); }
#pragma unroll
                for (int jj = 0; jj < 4; ++jj) if (4 * fq + jj > fr) sT[jj] = 0.f;
                const s16x4 sb4 = cvt4_bf16(sT);
#pragma unroll
                for (int nt = 0; nt < 4; ++nt) oT[nt] = __builtin_amdgcn_mfma_f32_16x16x16bf16_1k(vt[nt], sb4, oT[nt], 0, 0, 0);
                const int pp = p0 + fr, t = dir ? T - 1 - pp : pp; h16* op = outp + ((size_t)b * T + t) * ldo + hd * 64 + 4 * fq;
#pragma unroll
                for (int nt = 0; nt < 4; ++nt) { h16x4 w; w[0] = (h16)oT[nt][0]; w[1] = (h16)oT[nt][1]; w[2] = (h16)oT[nt][2]; w[3] = (h16)oT[nt][3]; *(h16x4*)(op + 16 * nt) = w; }
            }
#pragma unroll
            for (int mt = 0; mt < 8; ++mt) { const s16x4 kf = *(const LAS s16x4*)(KT + (16 * mt + fr) * 20 + 4 * fq); const f32x4 e4 = *(const LAS f32x4*)(E15 + 16 * mt + 4 * fq);
#pragma unroll
                for (int nt = 0; nt < 4; ++nt) { S[mt][nt] = __builtin_amdgcn_mfma_f32_16x16x16bf16_1k(kf, vt[nt], S[mt][nt], 0, 0, 0); S[mt][nt] = S[mt][nt] * e4; } }
            WAVE_SYNC();
        }
        if (PASS == 1) {
#pragma unroll
            for (int mt = 0; mt < 8; ++mt)
#pragma unroll
                for (int nt = 0; nt < 4; ++nt) *(f32x4*)(Sg + (size_t)(16 * nt + fr) * 128 + 16 * mt + 4 * fq) = S[mt][nt];
            DEC[(size_t)unit * 128 + lane] = __expf(dlog0); DEC[(size_t)unit * 128 + 64 + lane] = __expf(dlog1);
        }
    }
}
__device__ __forceinline__ void hgrn_cross(Ctx& C) {
    const int T = C.T, NC = T / CH_H, nchains = C.nseq * 2 * 8;
    const float* DEC = (const float*)(C.ws + WS_DEC);
    for (int idx = C.gtid; idx < nchains * 8192; idx += C.ngt) {
        const int chain = idx >> 13, e = idx & 8191, hd = chain & 7, dir = (chain >> 3) & 1, b = chain >> 4;
        float carry = 0.f;
#pragma unroll 4
        for (int c = 0; c < NC; ++c) { const int slotid = ((b * 2 + dir) * NC + c) * 8 + hd; float* p = (float*)(C.ws + WS_ST) + (size_t)slotid * 8192 + e;
            const float sl = *p; *p = carry; carry = DEC[(size_t)slotid * 128 + (e & 127)] * carry + sl; }
    }
}
__device__ __forceinline__ void mamba_final(Ctx& C) {
    const int lane = C.lane, j = C.j, c0 = lane * 16;
    const h16* U = (const h16*)(C.ws + WS_U); h16* MIX = (h16*)(C.ws + WS_MIX); const h16* O = (const h16*)(C.ws + WS_O); const h16* XS = (const h16*)(C.ws + WS_ST + 32 * MiB);
    const float dsk = IN(I_SSMD)[j * 16 + (lane >> 2)];
    for (int tok = C.gw; tok < MG; tok += C.ngw) {
        float y[16]; float ss = 0.f;
#pragma unroll
        for (int hf = 0; hf < 2; ++hf) {
            const int c = c0 + hf * 8;
            const h16x8 xs = *(const h16x8*)(XS + (size_t)tok * 1024 + c), yf = *(const h16x8*)(MIX + (size_t)tok * MIXW + 512 + c), yb = *(const h16x8*)(O + (size_t)tok * 1024 + c), z = *(const h16x8*)(U + (size_t)tok * LDB_ + c);
#pragma unroll
            for (int e = 0; e < 8; ++e) { const float v = ((float)yf[e] + (float)yb[e] + (float)xs[e] * dsk) * silu((float)z[e]); y[hf * 8 + e] = v; ss += v * v; }
        }
#pragma unroll
        for (int o = 1; o < 32; o <<= 1) ss += __shfl_xor(ss, o);
        const float rstd = rsqrtf(ss * (1.f / 512.f) + 1e-5f);
#pragma unroll
        for (int hf = 0; hf < 2; ++hf) { h16x8 w;
#pragma unroll
            for (int e = 0; e < 8; ++e) w[e] = (h16)(y[hf * 8 + e] * rstd * IN(I_SSMNW)[j * 1024 + c0 + hf * 8 + e]);
            *(h16x8*)(MIX + (size_t)tok * MIXW + 512 + c0 + hf * 8) = w; }
    }
}
__device__ __forceinline__ void hgrn_final(Ctx& C) {
    const int lane = C.lane, j = C.j, c0 = lane * 8;
    const h16* U = (const h16*)(C.ws + WS_U); h16* MIX = (h16*)(C.ws + WS_MIX); const h16* O = (const h16*)(C.ws + WS_O);
    for (int tok = C.gw; tok < MG; tok += C.ngw) {
        const h16x8 of = *(const h16x8*)(MIX + (size_t)tok * MIXW + c0), ob = *(const h16x8*)(O + (size_t)tok * 512 + c0), gg = *(const h16x8*)(U + (size_t)tok * LDC_ + 3584 + c0);
        float o[8], ss = 0.f;
#pragma unroll
        for (int e = 0; e < 8; ++e) { o[e] = (float)of[e] + (float)ob[e]; ss += o[e] * o[e]; }
        ss += __shfl_xor(ss, 1); ss += __shfl_xor(ss, 2); ss += __shfl_xor(ss, 4);
        const float rstd = rsqrtf(ss * (1.f / 64.f) + 1e-5f);
        h16x8 w;
#pragma unroll
        for (int e = 0; e < 8; ++e) w[e] = (h16)(o[e] * rstd * IN(I_HGNW)[j * 512 + c0 + e] * sigm((float)gg[e]));
        *(h16x8*)(MIX + (size_t)tok * MIXW + c0) = w;
    }
}
__device__ __forceinline__ void ret_final(Ctx& C) {
    const int lane = C.lane, j = C.j, c0 = lane * 16;
    const h16* U = (const h16*)(C.ws + WS_U); h16* MIX = (h16*)(C.ws + WS_MIX); const h16* O = (const h16*)(C.ws + WS_O);
    for (int tok = C.gw; tok < MG; tok += C.ngw) {
        float o[16], s = 0.f;
#pragma unroll
        for (int hf = 0; hf < 2; ++hf) { const h16x8 of = *(const h16x8*)(MIX + (size_t)tok * MIXW + 512 + c0 + hf * 8), ob = *(const h16x8*)(O + (size_t)tok * 1024 + c0 + hf * 8);
#pragma unroll
            for (int e = 0; e < 8; ++e) { o[hf * 8 + e] = (float)of[e] + (float)ob[e]; s += o[hf * 8 + e]; } }
#pragma unroll
        for (int q = 1; q < 16; q <<= 1) s += __shfl_xor(s, q);
        const float mean = s * (1.f / 256.f); float v2 = 0.f;
#pragma unroll
        for (int e = 0; e < 16; ++e) { o[e] -= mean; v2 += o[e] * o[e]; }
#pragma unroll
        for (int q = 1; q < 16; q <<= 1) v2 += __shfl_xor(v2, q);
        const float rstd = rsqrtf(v2 * (1.f / 256.f) + 1e-5f);
#pragma unroll
        for (int hf = 0; hf < 2; ++hf) { const h16x8 gg = *(const h16x8*)(U + (size_t)tok * LDD_ + 2048 + c0 + hf * 8); h16x8 w;
#pragma unroll
            for (int e = 0; e < 8; ++e) { const int cc = c0 + hf * 8 + e; w[e] = (h16)((o[hf * 8 + e] * rstd * IN(I_RETGW)[j * 1024 + cc] + IN(I_RETGB)[j * 1024 + cc]) * silu((float)gg[e])); }
            *(h16x8*)(MIX + (size_t)tok * MIXW + 512 + c0 + hf * 8) = w; }
    }
}

template <class Epi> __device__ __forceinline__ void run_gemm(Ctx& C, const h16* A, const h16* Bt, int N, int K, const Epi& E) {
    pg8::Gemm g{A, Bt, MG, N, K}; pg8::StaticOrder S; S.init(MG, N, (int)gridDim.x, (int)blockIdx.x);
    pg8::gemm_phase<Epi, pg8::StaticOrder>(C.lds, g, S, E, C.tid);
}

__global__ void __launch_bounds__(NTHR, 2) mega(Args args) {
    extern __shared__ __attribute__((aligned(16))) unsigned char lds_raw[];
    cg::grid_group grid = cg::this_grid();
    Ctx C;
#pragma unroll
    for (int i = 0; i < 32; ++i) C.in[i] = args.in[i];
    C.lds = (LAS unsigned char*)lds_raw; C.tid = threadIdx.x; C.lane = C.tid & 63; C.wave = __builtin_amdgcn_readfirstlane(C.tid >> 6);
    C.gw = blockIdx.x * NWAVES + C.wave; C.ngw = gridDim.x * NWAVES; C.gtid = blockIdx.x * NTHR + C.tid; C.ngt = gridDim.x * NTHR; C.ws = args.ws;
    h16* HN = (h16*)(C.ws + WS_HN); h16* MIX = (h16*)(C.ws + WS_MIX); h16* U = (h16*)(C.ws + WS_U);
    volatile LAS unsigned* bst = (volatile LAS unsigned*)(C.lds + LDS_BYTES - 16);
    if (threadIdx.x < 4) bst[threadIdx.x] = 0u;
    __syncthreads();
    const XcdBarrier xbar = xcd_barrier_post((unsigned*)(C.ws + WS_BAR), bst);
#define SYNC() xcd_barrier(xbar)
#ifndef PH
#define PH 0xFFFF
#endif
#ifndef DUP
#define DUP 0
#endif
#define P_(b, ...) do { for (int rep_ = 0; rep_ < 1 + ((DUP >> (b)) & 1); ++rep_) if (PH & (1 << (b))) { int t_ = threadIdx.x; asm volatile("" : "+v"(t_)); C.tid = t_; C.lane = t_ & 63; C.wave = __builtin_amdgcn_readfirstlane(t_ >> 6); C.gw = blockIdx.x * NWAVES + C.wave; C.gtid = blockIdx.x * NTHR + t_; __VA_ARGS__; } } while (0)
#pragma unroll 1
    for (int layer = 0; layer < 4; ++layer) {
        C.layer = layer; C.j = layer >> 1;
        P_(0, phase_weights(C)); if (layer == 0) grid.sync(); else SYNC();
#pragma unroll 1
        for (int grp = 0; grp < 2; ++grp) {
            C.grp = grp; C.nseq = grp == 0 ? 2 : 1; C.T = grp == 0 ? 8192 : 16384;
            C.hdst = args.out + (size_t)grp * MG * D; C.hsrc = (layer == 0) ? args.in[grp == 0 ? I_XP : I_XS] : C.hdst;
            P_(1, phase_norm(C, C.hsrc, IN(I_LNMIX) + layer * D, HN)); SYNC();
            if ((layer & 1) == 0) {
                P_(2, run_gemm(C, HN, (const h16*)(C.ws + W_IN1), LDA_, D, pg8::EpiF16<0>{U, LDA_})); SYNC();
                P_(3, rwkv_pre(C)); SYNC();
                P_(4, rwkv_scan<1>(C)); SYNC();
                P_(5, rwkv_cross(C)); SYNC();
                P_(6, rwkv_scan<2>(C)); SYNC();
                P_(7, rwkv_final(C)); SYNC();
                P_(2, run_gemm(C, HN, (const h16*)(C.ws + W_IN2), LDB_, D, pg8::EpiF16<0>{U, LDB_})); SYNC();
                P_(8, mamba_pre(C)); SYNC();
                P_(9, mamba_mfma_pass1(C)); SYNC();
                P_(5, mamba_mfma_cross(C)); SYNC();
                P_(9, mamba_mfma_pass2(C)); SYNC();
                P_(10, mamba_final(C)); SYNC();
            } else {
                P_(2, run_gemm(C, HN, (const h16*)(C.ws + W_IN1), LDC_, D, pg8::EpiF16<0>{U, LDC_})); SYNC();
                P_(11, hgrn_mfma<1>(C)); SYNC();
                P_(5, hgrn_cross(C)); SYNC();
                P_(11, hgrn_mfma<2>(C)); SYNC();
                P_(12, hgrn_final(C)); SYNC();
                P_(2, run_gemm(C, HN, (const h16*)(C.ws + W_IN2), LDD_, D, pg8::EpiF16<0>{U, LDD_})); SYNC();
                P_(13, ret_mfma_pass1(C)); SYNC();
                P_(5, ret_mfma_cross(C)); SYNC();
                P_(13, ret_mfma_pass2(C)); SYNC();
                P_(14, ret_final(C)); SYNC();
            }
            P_(15, run_gemm(C, MIX, (const h16*)(C.ws + W_OUT), D, MIXW, pg8::EpiRes{C.hsrc, C.hdst, D})); SYNC();
            P_(1, phase_norm(C, C.hdst, IN(I_LNFFN) + layer * D, HN)); SYNC();
            P_(2, run_gemm(C, HN, (const h16*)(C.ws + W_F1), FF, D, pg8::EpiF16<1>{U, FF})); SYNC();
            P_(15, run_gemm(C, U, (const h16*)(C.ws + W_F2), D, FF, pg8::EpiRes{C.hdst, C.hdst, D})); SYNC();
        }
    }
    P_(1, phase_final_norm(C, args.out, IN(I_LNFINAL)));
}

extern "C" void kernel_launch(void* const* d_in, const int* in_sizes, int n_in, void* d_out, int out_size, void* d_ws, size_t ws_size, hipStream_t stream) {
    static int grid = 0;
    if (grid == 0) {
        if (n_in != 32 || ws_size < WS_END) { fprintf(stderr, "kernel_launch: unexpected n_in %d or ws_size %zu (< %zu)\n", n_in, ws_size, (size_t)WS_END); grid = -1; return; }
        int dev = 0, cus = 0, per_cu = 0;
        hipGetDevice(&dev); hipDeviceGetAttribute(&cus, hipDeviceAttributeMultiprocessorCount, dev);
        if (hipFuncSetAttribute((const void*)mega, hipFuncAttributeMaxDynamicSharedMemorySize, LDS_BYTES) != hipSuccess) { fprintf(stderr, "kernel_launch: hipFuncSetAttribute failed\n"); grid = -1; return; }
        if (hipOccupancyMaxActiveBlocksPerMultiprocessor(&per_cu, (const void*)mega, NTHR, LDS_BYTES) != hipSuccess || per_cu < 1) { fprintf(stderr, "kernel_launch: occupancy query says %d\n", per_cu); per_cu = 1; }
        (void)hipGetLastError();
        grid = cus * per_cu;
    }
    if (grid < 0) return;
    if (hipMemsetAsync((char*)d_ws + WS_BAR, 0, XCD_BAR_WORDS * 4, stream) != hipSuccess) { fprintf(stderr, "kernel_launch: memset failed\n"); return; }
    Args a{};
    for (int i = 0; i < 32; ++i) a.in[i] = (const float*)d_in[i];
    a.out = (float*)d_out; a.ws = (unsigned char*)d_ws;
    void* params[] = {&a};
    hipError_t e = hipLaunchCooperativeKernel((const void*)mega, dim3(grid), dim3(NTHR), params, LDS_BYTES, stream);
    if (e != hipSuccess) fprintf(stderr, "kernel_launch: cooperative launch failed: %s (grid %d)\n", hipGetErrorString(e), grid);
}
```
